# Optimizing an MI355X kernel written in HIP

```python
import math
import jax, jax.numpy as jnp
from jax import lax
import numpy as np


D_MODEL = 2048
BATCH = 1
SEQ = 8192
DEPTH = 4

N_MIXERS = 3
D_FF = 5632
FFN_RES = 0.5
NORM_EPS = 1e-6
NEG = -1e30
N_MOD = 9

MOBA_HEADS = 16
MOBA_HEAD_DIM = D_MODEL // MOBA_HEADS
MOBA_BLOCK = 256
MOBA_TOPK = 3
MOBA_QCHUNK = 64

POOL_WINDOWS = (2, 4, 8, 16)
POOL_GROUP = D_MODEL // len(POOL_WINDOWS)

SWA_HEAD_DIM = 64
SWA_Q_HEADS = D_MODEL // SWA_HEAD_DIM
SWA_KV_HEADS = SWA_Q_HEADS // 8
SWA_WINDOW = 128

N_A = (DEPTH + 2) // 3
N_B = (DEPTH + 1) // 3
N_C = DEPTH // 3

kernel_name = "hybrid_moba_pool_swa_macaron_adaln"


def rms_norm(x, g):
    xf = x.astype(jnp.float32)
    y = xf * lax.rsqrt(jnp.mean(xf * xf, axis=-1, keepdims=True) + NORM_EPS)
    return (y * g.astype(jnp.float32)).astype(x.dtype)


def modulate(h, shift, scale):
    return h * (1.0 + scale[:, None, :]) + shift[:, None, :]


def alibi_slopes(n):
    return jnp.asarray([2.0 ** (-8.0 * (i + 1) / n) for i in range(n)], jnp.float32)


def swiglu(h, w_gate, w_up, w_down):
    return (jax.nn.silu(h @ w_gate) * (h @ w_up)) @ w_down


def moba_attention(h, w_qkv, w_o):
    B, T, _ = h.shape
    H, dh, BS, QC = MOBA_HEADS, MOBA_HEAD_DIM, MOBA_BLOCK, MOBA_QCHUNK
    q, k, v = jnp.split(h @ w_qkv, 3, axis=-1)
    Tp = -(-T // BS) * BS
    pad = Tp - T

    def heads(a):
        a = jnp.pad(a, ((0, 0), (0, pad), (0, 0)))
        return a.reshape(B, Tp, H, dh).transpose(0, 2, 1, 3)

    q, k, v = heads(q), heads(k), heads(v)
    NB = Tp // BS
    kb = k.reshape(B, H, NB, BS, dh)
    vb = v.reshape(B, H, NB, BS, dh)
    kmean = jnp.mean(kb.astype(jnp.float32), axis=3)
    gate = jnp.einsum('bhtd,bhnd->bhtn', q.astype(jnp.float32), kmean)
    qblk = jnp.arange(Tp) // BS
    past = jnp.arange(NB)[None, :] < qblk[:, None]
    gate = jnp.where(past, gate, NEG)
    kk = min(MOBA_TOPK, NB)
    _, sel = lax.top_k(gate, kk)
    sel_valid = sel < qblk[None, None, :, None]
    slopes = alibi_slopes(H)
    scale = dh ** -0.5
    b_ix = jnp.arange(B)[:, None, None, None]
    h_ix = jnp.arange(H)[None, :, None, None]

    def chunk(ci):
        t0 = ci * QC
        qc = lax.dynamic_slice_in_dim(q, t0, QC, axis=2)
        sc = lax.dynamic_slice_in_dim(sel, t0, QC, axis=2)
        vc = lax.dynamic_slice_in_dim(sel_valid, t0, QC, axis=2)
        tpos = t0 + jnp.arange(QC)
        ksel = kb[b_ix, h_ix, sc]
        vsel = vb[b_ix, h_ix, sc]
        spos = sc[..., None] * BS + jnp.arange(BS)
        s_sel = jnp.einsum('bhqd,bhqnkd->bhqnk', qc, ksel,
                           preferred_element_type=jnp.float32) * scale
        s_sel = s_sel - slopes[None, :, None, None, None] * (
            tpos[None, None, :, None, None] - spos).astype(jnp.float32)
        s_sel = jnp.where(vc[..., None], s_sel, NEG)
        ob = t0 // BS
        kown = lax.dynamic_slice_in_dim(kb, ob, 1, axis=2)[:, :, 0]
        vown = lax.dynamic_slice_in_dim(vb, ob, 1, axis=2)[:, :, 0]
        dist = tpos[:, None] - (ob * BS + jnp.arange(BS))[None, :]
        s_own = jnp.einsum('bhqd,bhkd->bhqk', qc, kown,
                           preferred_element_type=jnp.float32) * scale
        s_own = s_own - slopes[None, :, None, None] * dist.astype(jnp.float32)
        s_own = jnp.where(dist >= 0, s_own, NEG)
        s_all = jnp.concatenate([s_sel.reshape(B, H, QC, kk * BS), s_own], axis=-1)
        p = jax.nn.softmax(s_all, axis=-1).astype(v.dtype)
        p_sel = p[..., :kk * BS].reshape(B, H, QC, kk, BS)
        p_own = p[..., kk * BS:]
        return (jnp.einsum('bhqnk,bhqnkd->bhqd', p_sel, vsel)
                + jnp.einsum('bhqk,bhkd->bhqd', p_own, vown))

    outs = lax.map(chunk, jnp.arange(Tp // QC))
    o = outs.transpose(1, 0, 3, 2, 4).reshape(B, Tp, H * dh)[:, :T]
    return o @ w_o


def pool_mixer(h, w_pool, pool_scale):
    B, T, D = h.shape
    G = POOL_GROUP
    hf = h.astype(jnp.float32)
    cs = jnp.concatenate([jnp.zeros((B, 1, D), jnp.float32), lax.cumsum(hf, axis=1)], axis=1)
    t = jnp.arange(T)
    outs = []
    for gi, w in enumerate(POOL_WINDOWS):
        csg = cs[..., gi * G:(gi + 1) * G]
        lo = jnp.concatenate([jnp.zeros((B, w - 1, G), jnp.float32), csg[:, :T - w + 1]], axis=1)
        cnt = jnp.minimum(t + 1, w).astype(jnp.float32)
        outs.append((csg[:, 1:] - lo) / cnt[None, :, None] - hf[..., gi * G:(gi + 1) * G])
    pooled = jnp.stack(outs, axis=2).astype(h.dtype)
    mixed = jnp.einsum('btgi,gio->btgo', pooled, w_pool).reshape(B, T, D)
    return mixed * pool_scale


def swa_sink_attention(h, w_qkv, w_o, sinks):
    B, T, _ = h.shape
    Hq, Hkv, dh, W = SWA_Q_HEADS, SWA_KV_HEADS, SWA_HEAD_DIM, SWA_WINDOW
    G = Hq // Hkv
    NBq = T // W
    qkv = h @ w_qkv
    q = qkv[..., :Hq * dh].reshape(B, NBq, W, Hkv, G, dh)
    k = qkv[..., Hq * dh:(Hq + Hkv) * dh].reshape(B, NBq, W, Hkv, dh)
    v = qkv[..., (Hq + Hkv) * dh:].reshape(B, NBq, W, Hkv, dh)

    def band(a):
        prev = jnp.pad(a, ((0, 0), (1, 0), (0, 0), (0, 0), (0, 0)))[:, :-1]
        return jnp.concatenate([prev, a], axis=2)

    kband, vband = band(k), band(v)
    s = jnp.einsum('bnqkgd,bnskd->bkgnqs', q, kband,
                   preferred_element_type=jnp.float32) * (dh ** -0.5)
    dist = (jnp.arange(W)[:, None] + W) - jnp.arange(2 * W)[None, :]
    kpos = jnp.arange(NBq)[:, None] * W - W + jnp.arange(2 * W)[None, :]
    valid = ((dist >= 0) & (dist < W))[None] & (kpos >= 0)[:, None, :]
    slopes = alibi_slopes(Hq).reshape(Hkv, G)
    s = s - slopes[None, :, :, None, None, None] * dist.astype(jnp.float32)
    s = jnp.where(valid, s, NEG)
    sink = jnp.broadcast_to(sinks.astype(jnp.float32).reshape(1, Hkv, G, 1, 1, 1), s.shape[:-1] + (1,))
    p = jax.nn.softmax(jnp.concatenate([s, sink], axis=-1), axis=-1)[..., :-1]
    o = jnp.einsum('bkgnqs,bnskd->bnqkgd', p.astype(h.dtype), vband).reshape(B, T, Hq * dh)
    return o @ w_o


def setup_inputs(seed: int = 0) -> dict:
    key = jax.random.key(seed)
    ks = jax.random.split(key, 16)
    D, F, G = D_MODEL, D_FF, POOL_GROUP
    swa_qkv_out = (SWA_Q_HEADS + 2 * SWA_KV_HEADS) * SWA_HEAD_DIM
    nrm = jax.random.normal
    return {
        'x': nrm(ks[0], (BATCH, SEQ, D), jnp.float32),
        'c': nrm(ks[1], (BATCH, D), jnp.float32),
        'norm_g': 1.0 + 0.02 * nrm(ks[2], (DEPTH, 3, D), jnp.float32),
        'ada_w': nrm(ks[3], (DEPTH, D, N_MOD * D), jnp.float32) * (0.5 * D ** -0.5),
        'ada_b': 0.01 * nrm(ks[4], (DEPTH, N_MOD * D), jnp.float32),
        'ffn_w_gate': nrm(ks[5], (DEPTH, 2, D, F), jnp.float32) * D ** -0.5,
        'ffn_w_up': nrm(ks[6], (DEPTH, 2, D, F), jnp.float32) * D ** -0.5,
        'ffn_w_down': nrm(ks[7], (DEPTH, 2, F, D), jnp.float32) * F ** -0.5,
        'moba_w_qkv': nrm(ks[8], (N_A, D, 3 * D), jnp.float32) * D ** -0.5,
        'moba_w_o': nrm(ks[9], (N_A, D, D), jnp.float32) * D ** -0.5,
        'pool_w': nrm(ks[10], (N_B, len(POOL_WINDOWS), G, G), jnp.float32) * G ** -0.5,
        'pool_scale': 1.0 + 0.02 * nrm(ks[11], (N_B, D), jnp.float32),
        'swa_w_qkv': nrm(ks[12], (N_C, D, swa_qkv_out), jnp.float32) * D ** -0.5,
        'swa_w_o': nrm(ks[13], (N_C, SWA_Q_HEADS * SWA_HEAD_DIM, D), jnp.float32) * (SWA_Q_HEADS * SWA_HEAD_DIM) ** -0.5,
        'swa_sinks': 0.5 * nrm(ks[14], (N_C, SWA_Q_HEADS), jnp.float32),
        'final_g': 1.0 + 0.02 * nrm(ks[15], (D,), jnp.float32),
    }


def reference(x, c, norm_g, ada_w, ada_b, ffn_w_gate, ffn_w_up, ffn_w_down,
              moba_w_qkv, moba_w_o, pool_w, pool_scale,
              swa_w_qkv, swa_w_o, swa_sinks, final_g):
    cs = jax.nn.silu(c)
    for i in range(DEPTH):
        mod = cs @ ada_w[i] + ada_b[i]
        sh1, sc1, g1, sh2, sc2, g2, sh3, sc3, g3 = jnp.split(mod, N_MOD, axis=-1)
        h = modulate(rms_norm(x, norm_g[i, 0]), sh1, sc1)
        x = x + FFN_RES * g1[:, None, :] * swiglu(h, ffn_w_gate[i, 0], ffn_w_up[i, 0], ffn_w_down[i, 0])
        h = modulate(rms_norm(x, norm_g[i, 1]), sh2, sc2)
        kind, j = i % N_MIXERS, i // N_MIXERS
        if kind == 0:
            y = moba_attention(h, moba_w_qkv[j], moba_w_o[j])
        elif kind == 1:
            y = pool_mixer(h, pool_w[j], pool_scale[j])
        else:
            y = swa_sink_attention(h, swa_w_qkv[j], swa_w_o[j], swa_sinks[j])
        x = x + g2[:, None, :] * y
        h = modulate(rms_norm(x, norm_g[i, 2]), sh3, sc3)
        x = x + FFN_RES * g3[:, None, :] * swiglu(h, ffn_w_gate[i, 1], ffn_w_up[i, 1], ffn_w_down[i, 1])
    return rms_norm(x, final_g)
```

```cpp
#include <hip/hip_runtime.h>
#include <stdint.h>
#include <stdio.h>

typedef unsigned short bf16_t;
typedef short bf16x8 __attribute__((ext_vector_type(8)));
typedef short s16x4 __attribute__((ext_vector_type(4)));
typedef float f32x4 __attribute__((ext_vector_type(4)));

constexpr int T = 8192, D = 2048, F = 5632, F2 = 11264, DEPTH = 4, NMOD = 9 * 2048;
constexpr float EPS = 1e-6f;
constexpr float LOG2E = 1.4426950408889634f;

__device__ __forceinline__ bf16_t f2bf(float f) { unsigned u = __builtin_bit_cast(unsigned, f); return (bf16_t)((u + 0x7fffu + ((u >> 16) & 1u)) >> 16); }
__device__ __forceinline__ float bf2f(bf16_t b) { return __builtin_bit_cast(float, (unsigned)b << 16); }
__device__ __forceinline__ float wave_sum(float v) {
#pragma unroll
    for (int o = 1; o < 64; o <<= 1) v += __shfl_xor(v, o);
    return v;
}

__global__ __launch_bounds__(256) void k_mod(const float* __restrict__ c, const float* __restrict__ ada_w, const float* __restrict__ ada_b, float* __restrict__ mod) {
    __shared__ float cs[D];
    const int l = blockIdx.y, j = blockIdx.x * 256 + threadIdx.x;
    for (int i = threadIdx.x; i < D; i += 256) { const float v = c[i]; cs[i] = v / (1.f + __expf(-v)); }
    __syncthreads();
    const float* w = ada_w + (size_t)l * D * NMOD + j;
    float a0 = 0.f, a1 = 0.f, a2 = 0.f, a3 = 0.f;
    for (int k = 0; k < D; k += 4) {
        a0 += cs[k] * w[(size_t)k * NMOD]; a1 += cs[k + 1] * w[(size_t)(k + 1) * NMOD];
        a2 += cs[k + 2] * w[(size_t)(k + 2) * NMOD]; a3 += cs[k + 3] * w[(size_t)(k + 3) * NMOD];
    }
    mod[l * NMOD + j] = (a0 + a1) + (a2 + a3) + ada_b[l * NMOD + j];
}
__global__ void k_vecs(const float* __restrict__ mod, const float* __restrict__ norm_g, const float* __restrict__ pool_scale, float* __restrict__ gs, float* __restrict__ cres) {
    const int idx = blockIdx.x * 256 + threadIdx.x;
    if (idx >= DEPTH * 3 * D) return;
    const int c = idx % D, sub = idx / D, l = sub / 3, s = sub % 3;
    const float sc = mod[l * NMOD + (3 * s + 1) * D + c], gt = mod[l * NMOD + (3 * s + 2) * D + c];
    gs[idx] = norm_g[idx] * (1.f + sc);
    float cr = gt * (s == 1 ? 1.f : 0.5f);
    if (s == 1 && (l % 3) == 1) cr *= pool_scale[(l / 3) * D + c];
    cres[idx] = cr;
}
__device__ __forceinline__ int drow(int n, int mode, int row_off) { return mode == 0 ? n + row_off : ((n >> 7) * 256 + (mode == 2 ? 128 : 0) + (n & 127)); }
__global__ __launch_bounds__(256) void k_convT(const float* __restrict__ W, int K, int N, bf16_t* __restrict__ Wt, int mode, int row_off) {
    __shared__ float t[64][65];
    const int n0 = blockIdx.x * 64, k0 = blockIdx.y * 64, tid = threadIdx.x;
#pragma unroll
    for (int i = 0; i < 16; ++i) { const int kk = i * 4 + (tid >> 6), nn = tid & 63; t[kk][nn] = W[(size_t)(k0 + kk) * N + n0 + nn]; }
    __syncthreads();
#pragma unroll
    for (int i = 0; i < 16; ++i) { const int nn = i * 4 + (tid >> 6), kk = tid & 63; Wt[(size_t)drow(n0 + nn, mode, row_off) * K + k0 + kk] = f2bf(t[kk][nn]); }
}
__global__ __launch_bounds__(256) void k_bias(const float* __restrict__ sh, const bf16_t* __restrict__ Wt, int K, int N, float* __restrict__ bias) {
    const int n = blockIdx.x * 4 + (threadIdx.x >> 6), lane = threadIdx.x & 63;
    if (n >= N) return;
    float a = 0.f;
    for (int k = lane * 8; k < K; k += 512) {
        const bf16x8 w = *(const bf16x8*)(Wt + (size_t)n * K + k);
#pragma unroll
        for (int j = 0; j < 8; ++j) a += sh[k + j] * bf2f((bf16_t)w[j]);
    }
    a = wave_sum(a);
    if (lane == 0) bias[n] = a;
}
__global__ __launch_bounds__(256) void k_rowstat(const float* __restrict__ x, float* __restrict__ rstd, const float* __restrict__ gs, bf16_t* __restrict__ ap) {
    const int t = blockIdx.x * 4 + (threadIdx.x >> 6), lane = threadIdx.x & 63;
    float ss = 0.f;
    for (int c = lane * 4; c < D; c += 256) { const f32x4 v = *(const f32x4*)(x + (size_t)t * D + c); ss += (v[0] * v[0] + v[1] * v[1]) + (v[2] * v[2] + v[3] * v[3]);
        if (ap) { const f32x4 g = *(const f32x4*)(gs + c); bf16_t* o = ap + (size_t)t * D + c; o[0] = f2bf(v[0] * g[0]); o[1] = f2bf(v[1] * g[1]); o[2] = f2bf(v[2] * g[2]); o[3] = f2bf(v[3] * g[3]); } }
    ss = wave_sum(ss);
    if (lane == 0) rstd[t] = 1.0f / sqrtf(ss * (1.0f / D) + EPS);
}

struct EpiGU { const float* rstd; const float* bias; bf16_t* act;
    __device__ __forceinline__ void operator()(int row, int n0, int cl, float v0, float v1) const {
        const float r = rstd[row]; const float g = r * v0 + bias[n0 + cl], u = r * v1 + bias[n0 + 128 + cl];
        act[(size_t)row * F + (n0 >> 1) + cl] = f2bf(g / (1.f + __expf(-g)) * u); } };
struct EpiRes { const float* xin; float* xout; bf16_t* ap; const float* cres; const float* gsn; int coff;
    __device__ __forceinline__ void each(int row, int col, float v) const { col += coff; const size_t o = (size_t)row * D + col; const float xn = xin[o] + cres[col] * v; xout[o] = xn; ap[o] = f2bf(xn * gsn[col]); }
    __device__ __forceinline__ void operator()(int row, int n0, int cl, float v0, float v1) const { each(row, n0 + cl, v0); each(row, n0 + 128 + cl, v1); } };
struct EpiQKV { const float* rstd; const float* bias; bf16_t* q; bf16_t* k; bf16_t* v; bf16_t* vt; int nq, nk;
    __device__ __forceinline__ void each(int row, int col, float a) const { const float val = rstd[row] * a + bias[col]; const bf16_t b = f2bf(val);
        if (col < nq) q[(size_t)row * nq + col] = b; else if (col < nq + nk) k[(size_t)row * nk + col - nq] = b; else { const int c = col - nq - nk; v[(size_t)row * nk + c] = b; vt[(size_t)c * T + row] = b; } }
    __device__ __forceinline__ void operator()(int row, int n0, int cl, float v0, float v1) const { each(row, n0 + cl, v0); each(row, n0 + 128 + cl, v1); } };

template <class Epi>
__global__ __launch_bounds__(256) void k_gemm(const bf16_t* __restrict__ A, int lda, const bf16_t* __restrict__ Bt, int ldb, int K, Epi epi) {
    __shared__ __attribute__((aligned(16))) bf16_t As[128][40];
    __shared__ __attribute__((aligned(16))) bf16_t Bs[256][40];
    const int tid = threadIdx.x, wid = tid >> 6, lane = tid & 63, lq = lane & 15, quad = lane >> 4, wr = wid >> 1, wc = wid & 1;
    const int m0 = blockIdx.y * 128, n0 = blockIdx.x * 256;
    f32x4 acc[4][8];
#pragma unroll
    for (int i = 0; i < 4; ++i)
#pragma unroll
        for (int j = 0; j < 8; ++j) acc[i][j] = (f32x4){0.f, 0.f, 0.f, 0.f};
    for (int k0 = 0; k0 < K; k0 += 32) {
#pragma unroll
        for (int i = 0; i < 2; ++i) { const int c = tid + i * 256, r = c >> 2, cc = (c & 3) * 8; *(bf16x8*)&As[r][cc] = *(const bf16x8*)(A + (size_t)(m0 + r) * lda + k0 + cc); }
#pragma unroll
        for (int i = 0; i < 4; ++i) { const int c = tid + i * 256, r = c >> 2, cc = (c & 3) * 8; *(bf16x8*)&Bs[r][cc] = *(const bf16x8*)(Bt + (size_t)(n0 + r) * ldb + k0 + cc); }
        __syncthreads();
        bf16x8 a[4], b[8];
#pragma unroll
        for (int mi = 0; mi < 4; ++mi) a[mi] = *(const bf16x8*)&As[wr * 64 + mi * 16 + lq][quad * 8];
#pragma unroll
        for (int ni = 0; ni < 8; ++ni) b[ni] = *(const bf16x8*)&Bs[(ni >> 2) * 128 + wc * 64 + (ni & 3) * 16 + lq][quad * 8];
#pragma unroll
        for (int mi = 0; mi < 4; ++mi)
#pragma unroll
            for (int ni = 0; ni < 8; ++ni) acc[mi][ni] = __builtin_amdgcn_mfma_f32_16x16x32_bf16(a[mi], b[ni], acc[mi][ni], 0, 0, 0);
        __syncthreads();
    }
#pragma unroll
    for (int mi = 0; mi < 4; ++mi)
#pragma unroll
        for (int ni = 0; ni < 4; ++ni)
#pragma unroll
            for (int i = 0; i < 4; ++i) epi(m0 + wr * 64 + mi * 16 + quad * 4 + i, n0, wc * 64 + ni * 16 + lq, acc[mi][ni][i], acc[mi][ni + 4][i]);
}

__global__ void k_kmean(const bf16_t* __restrict__ Kb, float* __restrict__ kmean) {
    const int idx = blockIdx.x * 256 + threadIdx.x, n = idx / D, c = idx % D;
    float s = 0.f;
    for (int r = 0; r < 256; ++r) s += bf2f(Kb[(size_t)(n * 256 + r) * D + c]);
    kmean[idx] = s * (1.0f / 256.0f);
}
__global__ __launch_bounds__(256) void k_topk(const bf16_t* __restrict__ Q, const float* __restrict__ kmean, unsigned* __restrict__ sel) {
    const int gw = blockIdx.x * 4 + (threadIdx.x >> 6), lane = threadIdx.x & 63, h = gw & 15, t = gw >> 4, qblk = t >> 8;
    const float q0 = bf2f(Q[(size_t)t * D + h * 128 + lane * 2]), q1 = bf2f(Q[(size_t)t * D + h * 128 + lane * 2 + 1]);
    float v0 = -INFINITY, v1 = -INFINITY, v2 = -INFINITY; int i0 = -1, i1 = -1, i2 = -1;
    for (int n = 0; n < qblk; ++n) {
        const float* km = kmean + (size_t)n * D + h * 128 + lane * 2;
        const float g = wave_sum(q0 * km[0] + q1 * km[1]);
        if (g > v0) { v2 = v1; i2 = i1; v1 = v0; i1 = i0; v0 = g; i0 = n; }
        else if (g > v1) { v2 = v1; i2 = i1; v1 = g; i1 = n; }
        else if (g > v2) { v2 = g; i2 = n; }
    }
    unsigned m = 0u; if (i0 >= 0) m |= 1u << i0; if (i1 >= 0) m |= 1u << i1; if (i2 >= 0) m |= 1u << i2;
    if (lane == 0) sel[t * 16 + h] = m;
}
__global__ __launch_bounds__(256) void k_moba_attn(const bf16_t* __restrict__ Q, const bf16_t* __restrict__ Kb, const bf16_t* __restrict__ VT, const unsigned* __restrict__ sel, bf16_t* __restrict__ O) {
    const int wid = threadIdx.x >> 6, lane = threadIdx.x & 63, lq = lane & 15, quad = lane >> 4;
    const int gw = blockIdx.x * 4 + wid, h = gw & 15, rg = gw >> 4, t0 = rg * 16, qblk = t0 >> 8, tq = t0 + lq;
    const float slope2 = exp2f(-(float)(h + 1) * 0.5f) * LOG2E, sc2 = 0.08838834764831845f * LOG2E;
    bf16x8 qf[4];
#pragma unroll
    for (int kk = 0; kk < 4; ++kk) qf[kk] = *(const bf16x8*)(Q + (size_t)tq * D + h * 128 + kk * 32 + quad * 8);
    const unsigned mymask = sel[tq * 16 + h];
    unsigned um = mymask; um |= __shfl_xor(um, 1); um |= __shfl_xor(um, 2); um |= __shfl_xor(um, 4); um |= __shfl_xor(um, 8);
    um = __builtin_amdgcn_readfirstlane(um) | (1u << qblk);
    float m = -1e30f, l = 0.f; f32x4 o[8];
#pragma unroll
    for (int dt = 0; dt < 8; ++dt) o[dt] = (f32x4){0.f, 0.f, 0.f, 0.f};
    for (int j = 0; j <= qblk; ++j) {
        if (!((um >> j) & 1u)) continue;
        const bool own = (j == qblk), rowsel = own || ((mymask >> j) & 1u);
        const int nsteps = own ? ((t0 + 15 - j * 256) / 32 + 1) : 8;
        for (int st = 0; st < nsteps; ++st) {
            const int kb = j * 256 + st * 32;
            f32x4 s0 = (f32x4){0.f, 0.f, 0.f, 0.f}, s1 = (f32x4){0.f, 0.f, 0.f, 0.f};
#pragma unroll
            for (int kk = 0; kk < 4; ++kk) {
                const bf16x8 a0 = *(const bf16x8*)(Kb + (size_t)(kb + lq) * D + h * 128 + kk * 32 + quad * 8);
                const bf16x8 a1 = *(const bf16x8*)(Kb + (size_t)(kb + 16 + lq) * D + h * 128 + kk * 32 + quad * 8);
                s0 = __builtin_amdgcn_mfma_f32_16x16x32_bf16(a0, qf[kk], s0, 0, 0, 0);
                s1 = __builtin_amdgcn_mfma_f32_16x16x32_bf16(a1, qf[kk], s1, 0, 0, 0);
            }
            float p[8]; float mx = -INFINITY;
#pragma unroll
            for (int i = 0; i < 4; ++i) {
                const int tk0 = kb + quad * 4 + i, tk1 = tk0 + 16;
                float a = s0[i] * sc2 - slope2 * (float)(tq - tk0); if (!rowsel || tk0 > tq) a = -INFINITY;
                float b = s1[i] * sc2 - slope2 * (float)(tq - tk1); if (!rowsel || tk1 > tq) b = -INFINITY;
                p[i] = a; p[4 + i] = b; mx = fmaxf(mx, fmaxf(a, b));
            }
            mx = fmaxf(mx, __shfl_xor(mx, 16)); mx = fmaxf(mx, __shfl_xor(mx, 32));
            const float mn = fmaxf(m, mx), alpha = exp2f(m - mn); m = mn;
            float ps = 0.f;
#pragma unroll
            for (int i = 0; i < 8; ++i) { p[i] = exp2f(p[i] - mn); ps += p[i]; }
            l = l * alpha + ps;
            bf16x8 pb;
#pragma unroll
            for (int i = 0; i < 8; ++i) pb[i] = (short)f2bf(p[i]);
#pragma unroll
            for (int dt = 0; dt < 8; ++dt) {
                const bf16_t* vp = VT + (size_t)(h * 128 + dt * 16 + lq) * T + kb + quad * 4;
                const s16x4 x0 = *(const s16x4*)vp, x1 = *(const s16x4*)(vp + 16);
                const bf16x8 va = (bf16x8){x0[0], x0[1], x0[2], x0[3], x1[0], x1[1], x1[2], x1[3]};
                o[dt] = o[dt] * alpha;
                o[dt] = __builtin_amdgcn_mfma_f32_16x16x32_bf16(va, pb, o[dt], 0, 0, 0);
            }
        }
    }
    l += __shfl_xor(l, 16); l += __shfl_xor(l, 32);
    const float inv = 1.0f / l;
#pragma unroll
    for (int dt = 0; dt < 8; ++dt) { bf16_t* op = O + (size_t)tq * D + h * 128 + dt * 16 + quad * 4;
#pragma unroll
        for (int i = 0; i < 4; ++i) op[i] = f2bf(o[dt][i] * inv); }
}
__global__ __launch_bounds__(256) void k_swa_attn(const bf16_t* __restrict__ Q, const bf16_t* __restrict__ Kb, const bf16_t* __restrict__ VT, const float* __restrict__ sinks, bf16_t* __restrict__ O) {
    const int wid = threadIdx.x >> 6, lane = threadIdx.x & 63, lq = lane & 15, quad = lane >> 4;
    const int gw = blockIdx.x * 4 + wid, hq = gw & 31, rg = gw >> 5, t0 = rg * 16, hk = hq >> 3, tq = t0 + lq;
    const float slope2 = exp2f(-(float)(hq + 1) * 0.25f) * LOG2E, sc2 = 0.125f * LOG2E, sink2 = sinks[hq] * LOG2E;
    bf16x8 qf[2];
#pragma unroll
    for (int kk = 0; kk < 2; ++kk) qf[kk] = *(const bf16x8*)(Q + (size_t)tq * D + hq * 64 + kk * 32 + quad * 8);
    float p[5][8]; float mx = sink2;
#pragma unroll
    for (int st = 0; st < 5; ++st) {
        const int kb = t0 - 128 + st * 32;
        f32x4 s0 = (f32x4){0.f, 0.f, 0.f, 0.f}, s1 = (f32x4){0.f, 0.f, 0.f, 0.f};
        int r0 = kb + lq, r1 = kb + 16 + lq; r0 = r0 < 0 ? 0 : (r0 > T - 1 ? T - 1 : r0); r1 = r1 < 0 ? 0 : (r1 > T - 1 ? T - 1 : r1);
#pragma unroll
        for (int kk = 0; kk < 2; ++kk) {
            const bf16x8 a0 = *(const bf16x8*)(Kb + (size_t)r0 * 256 + hk * 64 + kk * 32 + quad * 8);
            const bf16x8 a1 = *(const bf16x8*)(Kb + (size_t)r1 * 256 + hk * 64 + kk * 32 + quad * 8);
            s0 = __builtin_amdgcn_mfma_f32_16x16x32_bf16(a0, qf[kk], s0, 0, 0, 0);
            s1 = __builtin_amdgcn_mfma_f32_16x16x32_bf16(a1, qf[kk], s1, 0, 0, 0);
        }
#pragma unroll
        for (int i = 0; i < 4; ++i) {
            const int tk0 = kb + quad * 4 + i, tk1 = tk0 + 16, d0 = tq - tk0, d1 = tq - tk1;
            const float a = (tk0 >= 0 && d0 >= 0 && d0 < 128) ? s0[i] * sc2 - slope2 * (float)d0 : -INFINITY;
            const float b = (tk1 >= 0 && d1 >= 0 && d1 < 128) ? s1[i] * sc2 - slope2 * (float)d1 : -INFINITY;
            p[st][i] = a; p[st][4 + i] = b; mx = fmaxf(mx, fmaxf(a, b));
        }
    }
    mx = fmaxf(mx, __shfl_xor(mx, 16)); mx = fmaxf(mx, __shfl_xor(mx, 32));
    float l = 0.f;
#pragma unroll
    for (int st = 0; st < 5; ++st)
#pragma unroll
        for (int i = 0; i < 8; ++i) { p[st][i] = exp2f(p[st][i] - mx); l += p[st][i]; }
    l += __shfl_xor(l, 16); l += __shfl_xor(l, 32);
    l += exp2f(sink2 - mx);
    f32x4 o[4];
#pragma unroll
    for (int dt = 0; dt < 4; ++dt) o[dt] = (f32x4){0.f, 0.f, 0.f, 0.f};
#pragma unroll
    for (int st = 0; st < 5; ++st) {
        const int kb = t0 - 128 + st * 32;
        bf16x8 pb;
#pragma unroll
        for (int i = 0; i < 8; ++i) pb[i] = (short)f2bf(p[st][i]);
        int c0 = kb + quad * 4, c1 = c0 + 16; c0 = c0 < 0 ? 0 : (c0 > T - 4 ? T - 4 : c0); c1 = c1 < 0 ? 0 : (c1 > T - 4 ? T - 4 : c1);
#pragma unroll
        for (int dt = 0; dt < 4; ++dt) {
            const bf16_t* vp = VT + (size_t)(hk * 64 + dt * 16 + lq) * T;
            const s16x4 x0 = *(const s16x4*)(vp + c0), x1 = *(const s16x4*)(vp + c1);
            const bf16x8 va = (bf16x8){x0[0], x0[1], x0[2], x0[3], x1[0], x1[1], x1[2], x1[3]};
            o[dt] = __builtin_amdgcn_mfma_f32_16x16x32_bf16(va, pb, o[dt], 0, 0, 0);
        }
    }
    const float inv = 1.0f / l;
#pragma unroll
    for (int dt = 0; dt < 4; ++dt) { bf16_t* op = O + (size_t)tq * D + hq * 64 + dt * 16 + quad * 4;
#pragma unroll
        for (int i = 0; i < 4; ++i) op[i] = f2bf(o[dt][i] * inv); }
}
__global__ void k_pool(const float* __restrict__ x, const float* __restrict__ rstd, const float* __restrict__ gs, bf16_t* __restrict__ pooled) {
    const size_t idx = (size_t)blockIdx.x * 256 + threadIdx.x; const int t = (int)(idx / D), c = (int)(idx % D);
    const int w = 2 << (c >> 9); const int lo = t - w + 1 < 0 ? 0 : t - w + 1;
    float s = 0.f;
    for (int r = lo; r <= t; ++r) s += x[(size_t)r * D + c] * rstd[r];
    const float cur = x[(size_t)t * D + c] * rstd[t];
    pooled[idx] = f2bf(gs[c] * (s / (float)(t - lo + 1) - cur));
}
__global__ void k_final(const float* __restrict__ x, const float* __restrict__ rstd, const float* __restrict__ g, float* __restrict__ out) {
    const size_t idx = (size_t)blockIdx.x * 256 + threadIdx.x; const int t = (int)(idx / D), c = (int)(idx % D);
    out[idx] = x[idx] * rstd[t] * g[c];
}

static inline size_t al256(size_t x) { return (x + 255) & ~(size_t)255; }
extern "C" void kernel_launch(void* const* d_in, const int* in_sizes, int n_in, void* d_out, int out_size, void* d_ws, size_t ws_size, hipStream_t stream) {
    const float* x_in = (const float*)d_in[0]; const float* c_in = (const float*)d_in[1]; const float* norm_g = (const float*)d_in[2];
    const float* ada_w = (const float*)d_in[3]; const float* ada_b = (const float*)d_in[4];
    const float* w_gate = (const float*)d_in[5]; const float* w_up = (const float*)d_in[6]; const float* w_down = (const float*)d_in[7];
    const float* moba_qkv = (const float*)d_in[8]; const float* moba_o = (const float*)d_in[9];
    const float* pool_w = (const float*)d_in[10]; const float* pool_scale = (const float*)d_in[11];
    const float* swa_qkv = (const float*)d_in[12]; const float* swa_o = (const float*)d_in[13]; const float* swa_sinks = (const float*)d_in[14];
    const float* final_g = (const float*)d_in[15];
    float* out = (float*)d_out;
    char* p = (char*)d_ws; size_t off = 0;
    auto take = [&](size_t bytes) { char* r = p + off; off = al256(off + bytes); return r; };
    float* MOD = (float*)take((size_t)DEPTH * NMOD * 4);
    float* GS = (float*)take((size_t)DEPTH * 3 * D * 4);
    float* CRES = (float*)take((size_t)DEPTH * 3 * D * 4);
    float* BIAS = (float*)take((size_t)DEPTH * 3 * F2 * 4);
    float* RSTD = (float*)take((size_t)T * 4);
    float* KMEAN = (float*)take((size_t)32 * D * 4);
    unsigned* SEL = (unsigned*)take((size_t)T * 16 * 4);
    bf16_t* WGU = (bf16_t*)take((size_t)DEPTH * 2 * F2 * D * 2);
    bf16_t* WD = (bf16_t*)take((size_t)DEPTH * 2 * D * F * 2);
    bf16_t* MQKV = (bf16_t*)take((size_t)2 * 3 * D * D * 2);
    bf16_t* MO = (bf16_t*)take((size_t)2 * D * D * 2);
    bf16_t* PW = (bf16_t*)take((size_t)D * 512 * 2);
    bf16_t* SQKV = (bf16_t*)take((size_t)2560 * D * 2);
    bf16_t* SO = (bf16_t*)take((size_t)D * D * 2);
    float* X = (float*)take((size_t)T * D * 4);
    bf16_t* AP = (bf16_t*)take((size_t)T * D * 2);
    bf16_t* ACT = (bf16_t*)take((size_t)T * F * 2);
    bf16_t* QB = (bf16_t*)take((size_t)T * D * 2);
    bf16_t* KB = (bf16_t*)take((size_t)T * D * 2);
    bf16_t* VB = (bf16_t*)take((size_t)T * D * 2);
    bf16_t* VTB = (bf16_t*)take((size_t)T * D * 2);
    bf16_t* AO = (bf16_t*)take((size_t)T * D * 2);
    if (off > ws_size) { fprintf(stderr, "workspace too small: need %zu have %zu\n", off, ws_size); return; }

    k_mod<<<dim3(NMOD / 256, DEPTH), 256, 0, stream>>>(c_in, ada_w, ada_b, MOD);
    k_vecs<<<DEPTH * 3 * D / 256, 256, 0, stream>>>(MOD, norm_g, pool_scale, GS, CRES);
    for (int l = 0; l < DEPTH; ++l)
        for (int f = 0; f < 2; ++f) {
            const size_t wi = (size_t)(l * 2 + f);
            k_convT<<<dim3(F / 64, D / 64), 256, 0, stream>>>(w_gate + wi * D * F, D, F, WGU + wi * F2 * D, 1, 0);
            k_convT<<<dim3(F / 64, D / 64), 256, 0, stream>>>(w_up + wi * D * F, D, F, WGU + wi * F2 * D, 2, 0);
            k_convT<<<dim3(D / 64, F / 64), 256, 0, stream>>>(w_down + wi * F * D, F, D, WD + wi * D * F, 0, 0);
        }
    for (int j = 0; j < 2; ++j) {
        k_convT<<<dim3(3 * D / 64, D / 64), 256, 0, stream>>>(moba_qkv + (size_t)j * D * 3 * D, D, 3 * D, MQKV + (size_t)j * 3 * D * D, 0, 0);
        k_convT<<<dim3(D / 64, D / 64), 256, 0, stream>>>(moba_o + (size_t)j * D * D, D, D, MO + (size_t)j * D * D, 0, 0);
    }
    for (int g = 0; g < 4; ++g) k_convT<<<dim3(512 / 64, 512 / 64), 256, 0, stream>>>(pool_w + (size_t)g * 512 * 512, 512, 512, PW, 0, g * 512);
    k_convT<<<dim3(2560 / 64, D / 64), 256, 0, stream>>>(swa_qkv, D, 2560, SQKV, 0, 0);
    k_convT<<<dim3(D / 64, D / 64), 256, 0, stream>>>(swa_o, D, D, SO, 0, 0);
    for (int l = 0; l < DEPTH; ++l)
        for (int s = 0; s < 3; ++s) {
            const int sub = l * 3 + s, kind = l % 3, j = l / 3; const float* sh = MOD + (size_t)l * NMOD + (3 * s) * D; float* b = BIAS + (size_t)sub * F2;
            if (s != 1) k_bias<<<F2 / 4, 256, 0, stream>>>(sh, WGU + (size_t)(l * 2 + (s >> 1)) * F2 * D, D, F2, b);
            else if (kind == 0) k_bias<<<3 * D / 4, 256, 0, stream>>>(sh, MQKV + (size_t)j * 3 * D * D, D, 3 * D, b);
            else if (kind == 2) k_bias<<<2560 / 4, 256, 0, stream>>>(sh, SQKV, D, 2560, b);
        }
    k_rowstat<<<T / 4, 256, 0, stream>>>(x_in, RSTD, GS, AP);
    const float* xcur = x_in;
    for (int l = 0; l < DEPTH; ++l)
        for (int s = 0; s < 3; ++s) {
            const int sub = l * 3 + s, kind = l % 3, j = l / 3;
            const float* bias = BIAS + (size_t)sub * F2; const float* cres = CRES + (size_t)sub * D; const float* gsn = GS + (size_t)(sub < 11 ? sub + 1 : 0) * D;
            if (s != 1) {
                const size_t wi = (size_t)(l * 2 + (s >> 1));
                EpiGU e1{RSTD, bias, ACT};
                k_gemm<EpiGU><<<dim3(F2 / 256, T / 128), 256, 0, stream>>>(AP, D, WGU + wi * F2 * D, D, D, e1);
                EpiRes e2{xcur, X, AP, cres, gsn, 0};
                k_gemm<EpiRes><<<dim3(D / 256, T / 128), 256, 0, stream>>>(ACT, F, WD + wi * D * F, F, F, e2);
            } else if (kind == 0) {
                EpiQKV e1{RSTD, bias, QB, KB, VB, VTB, D, D};
                k_gemm<EpiQKV><<<dim3(3 * D / 256, T / 128), 256, 0, stream>>>(AP, D, MQKV + (size_t)j * 3 * D * D, D, D, e1);
                k_kmean<<<32 * D / 256, 256, 0, stream>>>(KB, KMEAN);
                k_topk<<<T * 16 / 4, 256, 0, stream>>>(QB, KMEAN, SEL);
                k_moba_attn<<<(T / 16) * 16 / 4, 256, 0, stream>>>(QB, KB, VTB, SEL, AO);
                EpiRes e2{xcur, X, AP, cres, gsn, 0};
                k_gemm<EpiRes><<<dim3(D / 256, T / 128), 256, 0, stream>>>(AO, D, MO + (size_t)j * D * D, D, D, e2);
            } else if (kind == 1) {
                k_pool<<<(unsigned)((size_t)T * D / 256), 256, 0, stream>>>(xcur, RSTD, GS + (size_t)sub * D, AO);
                for (int g = 0; g < 4; ++g) { EpiRes e2{xcur, X, AP, cres, gsn, g * 512};
                    k_gemm<EpiRes><<<dim3(512 / 256, T / 128), 256, 0, stream>>>(AO + g * 512, D, PW + (size_t)g * 512 * 512, 512, 512, e2); }
            } else {
                EpiQKV e1{RSTD, bias, QB, KB, VB, VTB, D, 256};
                k_gemm<EpiQKV><<<dim3(2560 / 256, T / 128), 256, 0, stream>>>(AP, D, SQKV, D, D, e1);
                k_swa_attn<<<(T / 16) * 32 / 4, 256, 0, stream>>>(QB, KB, VTB, swa_sinks, AO);
                EpiRes e2{xcur, X, AP, cres, gsn, 0};
                k_gemm<EpiRes><<<dim3(D / 256, T / 128), 256, 0, stream>>>(AO, D, SO, D, D, e2);
            }
            xcur = X;
            k_rowstat<<<T / 4, 256, 0, stream>>>(X, RSTD, nullptr, nullptr);
        }
    k_final<<<(unsigned)((size_t)T * D / 256), 256, 0, stream>>>(X, RSTD, final_g, out);
}
```

```cpp
#include <hip/hip_runtime.h>
#include <cstdio>
#include <cstdint>
#include <cmath>

constexpr int T = 8192, D = 2048, F = 5632, F2 = 11264, DEPTH = 4, NMOD = 9 * 2048;
constexpr float EPS = 1e-6f;
constexpr float LOG2E = 1.4426950408889634f;

namespace pg8 {
#define PG8_LAS __attribute__((address_space(3)))
typedef unsigned short bf16_t;
typedef short bf16x8 __attribute__((ext_vector_type(8)));
typedef float f32x4 __attribute__((ext_vector_type(4)));
typedef unsigned u32x4 __attribute__((ext_vector_type(4)));
typedef unsigned u32x2 __attribute__((ext_vector_type(2)));
constexpr int BM = 256, BK = 64, HALF = 128, HTB = HALF * BK * 2  , STAGE_BYTES = 8 * HTB, NXCD = 8, WGM = 8;

__host__ __device__ __forceinline__ int lds_byte(int r, int c) { const int st = (r >> 4) * 2 + (c >> 5), rr = r & 15, cc = c & 31, ob = rr * 64 + cc * 2; return st * 1024 + (ob ^ (((ob >> 9) & 1) << 5)); }
__host__ __device__ __forceinline__ void stage_rc(int b, int& R, int& C) { const int st = b / 1024, sb = b % 1024, swz = sb ^ (((sb >> 9) & 1) << 5); R = (st >> 1) * 16 + swz / 64; C = (st & 1) * 32 + (swz % 64) / 2; }
__host__ __device__ __forceinline__ int perm32(int rho) { const int n = rho >> 4, i = rho & 15; return 8 * (i >> 2) + 4 * n + (i & 3); }

struct Unit { int pm, pn; };
struct Gemm { const bf16_t* A; const bf16_t* Bt; int M, N, K, lda, grouped, ta, tb; };

struct StaticOrder {
    int nM, nN, nwg, G, c;
    __host__ __device__ void init(int M, int N, int G_, int c_) { nM = M / BM; nN = N / BM; nwg = nM * nN; G = G_; c = c_; }
    __host__ __device__ bool next(int i, Unit& u) const {
        const long L = (long)i * G + c; if (L >= nwg) return false;
        int wgid = (int)L; { const int q = nwg / NXCD, r = nwg % NXCD, xcd = wgid % NXCD, off = wgid / NXCD; wgid = (xcd < r ? xcd * (q + 1) : r * (q + 1) + (xcd - r) * q) + off; }
        const int nig = WGM * nN, gid = wgid / nig, fm = gid * WGM, gsz = (nM - fm) < WGM ? (nM - fm) : WGM;
        u.pm = fm + ((wgid % nig) % gsz); u.pn = (wgid % nig) / gsz; return true;
    }
    __device__ __forceinline__ void a_ready(const Unit&) const {}
    __device__ __forceinline__ void done(const Unit&) const {}
};

typedef float f32x2_t __attribute__((ext_vector_type(2))); typedef __bf16 bf16x2_t __attribute__((ext_vector_type(2)));
__device__ __forceinline__ unsigned cvt_pk_bf16(float lo, float hi) { const f32x2_t v = {lo, hi}; const bf16x2_t b = __builtin_convertvector(v, bf16x2_t); return __builtin_bit_cast(unsigned, b); }

__device__ __forceinline__ void load_rstd(const float* ss, int rowb, int fq, float (&rs)[2][4]) {
#pragma unroll
    for (int ai = 0; ai < 2; ++ai)
#pragma unroll
        for (int m = 0; m < 4; ++m) {
            const f32x4* p = (const f32x4*)(ss + (size_t)(rowb + ai * HALF + m * 16) * 32 + fq * 8);
            const f32x4 a = p[0], b = p[1];
            float s = ((a[0] + a[1]) + (a[2] + a[3])) + ((b[0] + b[1]) + (b[2] + b[3]));
            s += __shfl_xor(s, 16); s += __shfl_xor(s, 32);
            rs[ai][m] = __builtin_amdgcn_rsqf(s * (1.0f / D) + EPS);
        }
}
__device__ __forceinline__ float silu_mul(float g, float u) { return g * __builtin_amdgcn_rcpf(1.0f + __expf(-g)) * u; }

struct EpiGU {
    static constexpr bool PERM = true, AFTER_DRAIN = false;
    const float* ss; const float* bias; bf16_t* act;
    __device__ __forceinline__ void operator()(const f32x4 (&acc)[2][2][4][2], const Unit& u, int wr, int wc, int fr, int fq) const {
        const int cb = u.pn * BM + wc * 32 + 8 * fq, jcol = u.pn * HALF + wc * 32 + 8 * fq;
        f32x4 bg[2], bu[2];
#pragma unroll
        for (int n = 0; n < 2; ++n) { bg[n] = *(const f32x4*)(bias + cb + 4 * n); bu[n] = *(const f32x4*)(bias + cb + HALF + 4 * n); }
        float rs[2][4]; load_rstd(ss, u.pm * BM + wr * 64 + fr, fq, rs);
        asm volatile("" : "+v"(bg[0]), "+v"(bg[1]), "+v"(bu[0]), "+v"(bu[1]));
#pragma unroll
        for (int ai = 0; ai < 2; ++ai)
#pragma unroll
            for (int m = 0; m < 4; ++m) {
                const float r = rs[ai][m]; const int row = u.pm * BM + ai * HALF + wr * 64 + m * 16 + fr;
                float g[8], v[8], e[8];
#pragma unroll
                for (int n = 0; n < 2; ++n)
#pragma unroll
                    for (int i = 0; i < 4; ++i) { g[n * 4 + i] = fmaf(acc[ai][0][m][n][i], r, bg[n][i]); v[n * 4 + i] = fmaf(acc[ai][1][m][n][i], r, bu[n][i]); }
#pragma unroll
                for (int i = 0; i < 8; ++i) e[i] = __builtin_amdgcn_exp2f(g[i] * (-LOG2E));
#pragma unroll
                for (int i = 0; i < 8; ++i) e[i] = __builtin_amdgcn_rcpf(1.0f + e[i]);
#pragma unroll
                for (int i = 0; i < 8; ++i) e[i] = (g[i] * e[i]) * v[i];
                u32x4 w; w.x = cvt_pk_bf16(e[0], e[1]); w.y = cvt_pk_bf16(e[2], e[3]); w.z = cvt_pk_bf16(e[4], e[5]); w.w = cvt_pk_bf16(e[6], e[7]);
                *(u32x4*)(act + ((size_t)((row >> 8) * (F / 64) + (jcol >> 6)) * 256 + (row & 255)) * 64 + (jcol & 63)) = w;
            }
    }
};
struct EpiRes {
    static constexpr bool PERM = true, AFTER_DRAIN = false;
    bf16_t* x; const float* cres; float* ss;
    __device__ __forceinline__ void operator()(const f32x4 (&acc)[2][2][4][2], const Unit& u, int wr, int wc, int fr, int fq) const {
        const int col0 = u.pn * BM + wc * 32 + 8 * fq;
        const size_t off0 = ((size_t)(u.pm * (D / 64) + (col0 >> 6)) * 256 + wr * 64 + fr) * 64 + (col0 & 63);
        f32x4 cr[2][2];
#pragma unroll
        for (int bj = 0; bj < 2; ++bj)
#pragma unroll
            for (int n = 0; n < 2; ++n) cr[bj][n] = *(const f32x4*)(cres + col0 + bj * HALF + n * 4);
        u32x4 xb[3][2];
#define EPIRES_OFF(g, bj) (off0 + (size_t)(((g) >> 2) * HALF + ((g) & 3) * 16) * 64 + (size_t)(bj) * (2 * 256 * 64))
#define EPIRES_LOAD(buf, g) do { _Pragma("unroll") for (int bj = 0; bj < 2; ++bj) xb[buf][bj] = *(const u32x4*)(x + EPIRES_OFF(g, bj)); } while (0)
        EPIRES_LOAD(0, 0); EPIRES_LOAD(1, 1); EPIRES_LOAD(2, 2);
#pragma unroll
        for (int g = 0; g < 8; ++g) {
            const int ai = g >> 2, m = g & 3;
            const int row_ = u.pm * BM + ai * HALF + wr * 64 + m * 16 + fr;
            float sq = 0.f;
#pragma unroll
            for (int bj = 0; bj < 2; ++bj) {
                u32x4 xs;
#pragma unroll
                for (int n = 0; n < 2; ++n) {
                    const unsigned p0 = xb[g % 3][bj][2 * n], p1 = xb[g % 3][bj][2 * n + 1];
                    const f32x4 xo = {__builtin_bit_cast(float, p0 << 16), __builtin_bit_cast(float, p0 & 0xFFFF0000u), __builtin_bit_cast(float, p1 << 16), __builtin_bit_cast(float, p1 & 0xFFFF0000u)};
                    const f32x4 xn = xo + cr[bj][n] * acc[ai][bj][m][n];
                    sq += (xn[0] * xn[0] + xn[1] * xn[1]) + (xn[2] * xn[2] + xn[3] * xn[3]);
                    if (n == 0) { xs.x = cvt_pk_bf16(xn[0], xn[1]); xs.y = cvt_pk_bf16(xn[2], xn[3]); } else { xs.z = cvt_pk_bf16(xn[0], xn[1]); xs.w = cvt_pk_bf16(xn[2], xn[3]); }
                }
                *(u32x4*)(x + EPIRES_OFF(g, bj)) = xs;
            }
            sq += __shfl_xor(sq, 16); sq += __shfl_xor(sq, 32);
            if (fq == 0) ss[(size_t)row_ * 32 + u.pn * 4 + wc] = sq;
            if (g + 3 < 8) EPIRES_LOAD(g % 3, g + 3);
        }
#undef EPIRES_LOAD
#undef EPIRES_OFF
    }
};
struct EpiQKV {
    static constexpr bool PERM = true, AFTER_DRAIN = false;
    const float* ss; const float* bias; bf16_t* qkv; bf16_t* vt; float* kmp; unsigned* kmax; int nq, nk, hm;
    __device__ __forceinline__ void operator()(const f32x4 (&acc)[2][2][4][2], const Unit& u, int wr, int wc, int fr, int fq) const {
        const int ct = u.pn * BM; const int cb = ct + wc * 32 + 8 * fq;
        f32x4 bv[2][2];
#pragma unroll
        for (int bj = 0; bj < 2; ++bj)
#pragma unroll
            for (int n = 0; n < 2; ++n) bv[bj][n] = *(const f32x4*)(bias + cb + bj * HALF + 4 * n);
        float rs[2][4]; load_rstd(ss, u.pm * BM + wr * 64 + fr, fq, rs);
        asm volatile("" : "+v"(bv[0][0]), "+v"(bv[0][1]), "+v"(bv[1][0]), "+v"(bv[1][1]));
        const int region = ct < nq ? 0 : (ct < nq + nk ? 1 : 2);
        bf16_t* base = qkv + (size_t)region * ((size_t)T * D); const int ld = region == 0 ? nq : nk;
        const int lc = cb - (region == 0 ? 0 : (region == 1 ? nq : nq + nk));
        const bool do_km = (region == 1) && (kmp != nullptr), do_vt = (region == 2) && (vt != nullptr);
        f32x4 csum[2][2];
#pragma unroll
        for (int bj = 0; bj < 2; ++bj)
#pragma unroll
            for (int n = 0; n < 2; ++n) csum[bj][n] = (f32x4){0.f, 0.f, 0.f, 0.f};
        float kmx[2] = {0.f, 0.f};
#pragma unroll
        for (int ai = 0; ai < 2; ++ai)
#pragma unroll
            for (int m = 0; m < 4; ++m) {
                const float r = rs[ai][m]; const int row = u.pm * BM + ai * HALF + wr * 64 + m * 16 + fr;
#pragma unroll
                for (int bj = 0; bj < 2; ++bj) {
                    const f32x4 v0 = acc[ai][bj][m][0] * r + bv[bj][0], v1 = acc[ai][bj][m][1] * r + bv[bj][1];
                    csum[bj][0] += v0; csum[bj][1] += v1;
                    if (do_km) kmx[bj] = fmaxf(kmx[bj], fmaxf(fmaxf(fmaxf(fabsf(v0[0]), fabsf(v0[1])), fmaxf(fabsf(v0[2]), fabsf(v0[3]))), fmaxf(fmaxf(fabsf(v1[0]), fabsf(v1[1])), fmaxf(fabsf(v1[2]), fabsf(v1[3])))));
                    u32x4 w; w.x = cvt_pk_bf16(v0[0], v0[1]); w.y = cvt_pk_bf16(v0[2], v0[3]); w.z = cvt_pk_bf16(v1[0], v1[1]); w.w = cvt_pk_bf16(v1[2], v1[3]);
                    if (hm) *(u32x4*)(base + ((size_t)((lc + bj * HALF) >> 7) * T + row) * 128 + ((lc + bj * HALF) & 127)) = w;
                    else *(u32x4*)(base + (size_t)row * ld + lc + bj * HALF) = w;
                    if (do_vt) {
                        bf16_t* tp = vt + (size_t)(lc + bj * HALF) * T + row;
                        tp[0] = (bf16_t)(w.x & 0xffffu); tp[(size_t)T] = (bf16_t)(w.x >> 16); tp[(size_t)2 * T] = (bf16_t)(w.y & 0xffffu); tp[(size_t)3 * T] = (bf16_t)(w.y >> 16);
                        tp[(size_t)4 * T] = (bf16_t)(w.z & 0xffffu); tp[(size_t)5 * T] = (bf16_t)(w.z >> 16); tp[(size_t)6 * T] = (bf16_t)(w.w & 0xffffu); tp[(size_t)7 * T] = (bf16_t)(w.w >> 16);
                    }
                }
            }
        if (do_km) {
#pragma unroll
            for (int bj = 0; bj < 2; ++bj) {
                float mx = kmx[bj];
#pragma unroll
                for (int o = 1; o < 64; o <<= 1) mx = fmaxf(mx, __shfl_xor(mx, o));
                if (fr == 0 && fq == 0) atomicMax(kmax + ((ct - nq) >> 7) + bj, __float_as_uint(mx));
            }
#pragma unroll
            for (int bj = 0; bj < 2; ++bj)
#pragma unroll
                for (int n = 0; n < 2; ++n) {
                    f32x4 c = csum[bj][n];
#pragma unroll
                    for (int o = 1; o < 16; o <<= 1) { c[0] += __shfl_xor(c[0], o); c[1] += __shfl_xor(c[1], o); c[2] += __shfl_xor(c[2], o); c[3] += __shfl_xor(c[3], o); }
                    if (fr == 0) *(f32x4*)(kmp + ((size_t)wr * 32 + u.pm) * D + lc + bj * HALF + 4 * n) = c;
                }
        }
    }
};

template <class Epi, class Sched, bool ALIGN_EPI>
__device__ __forceinline__ void gemm_phase(PG8_LAS unsigned char* lds, const Gemm g, const Sched& S, const Epi& E, const int tid) {
    const int wid = __builtin_amdgcn_readfirstlane(tid >> 6), lane = tid & 63, wr = wid >> 2, wc = wid & 3, fr = lane & 15, fq = lane >> 4;
    const int K = g.K, nt = K / BK, lda = g.lda;
    unsigned voffA[2], voffB[2];
#pragma unroll
    for (int i = 0; i < 2; ++i) { int R, C; stage_rc(tid * 16 + i * 8192, R, C); const int Rb = Epi::PERM ? ((R & ~31) + perm32(R & 31)) : R;
        voffA[i] = (unsigned)(R * (g.ta ? BK : lda) + C) * 2u; voffB[i] = (unsigned)(Rb * (g.tb ? BK : K) + C) * 2u; }
    const size_t kstepA = g.ta ? (size_t)BM * BK * 2 : (size_t)(BK * 2), kstepB = g.tb ? (size_t)BM * BK * 2 : (size_t)(BK * 2);
    const size_t hstepA = g.ta ? (size_t)HALF * BK * 2 : (size_t)HALF * lda * 2, hstepB = g.tb ? (size_t)HALF * BK * 2 : (size_t)HALF * K * 2;
    const size_t tstepA = g.ta ? (size_t)(K / BK) * BM * BK * 2 : 2 * hstepA, tstepB = g.tb ? (size_t)(K / BK) * BM * BK * 2 : 2 * hstepB;
    const unsigned ldsw = (unsigned)wid * 1024u;
    const int aoff = lds_byte(wr * 64 + fr, fq * 8), boff = lds_byte(wc * 32 + fr, fq * 8);
#define PG8_ACOL(u_) (g.grouped ? (size_t)((u_).pn >> 1) * (size_t)K * 2 : (size_t)0)
#define PG8_SA(b, h) (((b) * 2 + (h)) * HTB)
#define PG8_SB(b, h) ((4 + (b) * 2 + (h)) * HTB)
#define PG8_STAGE(bufoff, gbase, voff) do { _Pragma("unroll") for (int _i = 0; _i < 2; ++_i) \
        __builtin_amdgcn_global_load_lds((const unsigned*)((const char*)(gbase) + (voff)[_i]), (PG8_LAS unsigned*)(lds + (bufoff) + ldsw + _i * 8192), 16, 0, 0); } while (0)
#define PG8_LDA(dst, b, h) do { _Pragma("unroll") for (int m = 0; m < 4; ++m) _Pragma("unroll") for (int k = 0; k < 2; ++k) dst[m][k] = *(const PG8_LAS bf16x8*)(lds + PG8_SA(b, h) + aoff + m * 2048 + k * 1024); } while (0)
#define PG8_LDB(dst, b, h) do { _Pragma("unroll") for (int n = 0; n < 2; ++n) _Pragma("unroll") for (int k = 0; k < 2; ++k) dst[n][k] = *(const PG8_LAS bf16x8*)(lds + PG8_SB(b, h) + boff + n * 2048 + k * 1024); } while (0)
#define PG8_MMA(ai, bj, At, Bt) do { __builtin_amdgcn_s_setprio(1); _Pragma("unroll") for (int m = 0; m < 4; ++m) _Pragma("unroll") for (int n = 0; n < 2; ++n) _Pragma("unroll") for (int k = 0; k < 2; ++k) \
        acc[ai][bj][m][n] = __builtin_amdgcn_mfma_f32_16x16x32_bf16(Bt[n][k], At[m][k], acc[ai][bj][m][n], 0, 0, 0); __builtin_amdgcn_s_setprio(0); } while (0)
#define PG8_WAIT_V(n) asm volatile("s_waitcnt vmcnt(" #n ")" ::: "memory")
#define PG8_WAIT_L(n) asm volatile("s_waitcnt lgkmcnt(" #n ")" ::: "memory")
#define PG8_BAR __builtin_amdgcn_s_barrier()
#define PG8_SCHED __builtin_amdgcn_sched_barrier(0)
    Unit cur, nxt; int ui = 0;
    if (!S.next(0, cur)) return;
    f32x4 acc[2][2][4][2];
#pragma unroll
    for (int a = 0; a < 2; ++a)
#pragma unroll
        for (int b = 0; b < 2; ++b)
#pragma unroll
            for (int m = 0; m < 4; ++m)
#pragma unroll
                for (int n = 0; n < 2; ++n) acc[a][b][m][n] = (f32x4){0.f, 0.f, 0.f, 0.f};
    bf16x8 At[4][2], B0[2][2], B1[2][2];
    const char* cA = (const char*)g.A + (size_t)cur.pm * tstepA + PG8_ACOL(cur); const char* cB = (const char*)g.Bt + (size_t)cur.pn * tstepB;
    S.a_ready(cur);
    PG8_STAGE(PG8_SB(0, 0), cB, voffB); PG8_STAGE(PG8_SB(0, 1), cB + hstepB, voffB); PG8_STAGE(PG8_SA(0, 0), cA, voffA); PG8_STAGE(PG8_SA(0, 1), cA + hstepA, voffA);
    if (wr == 1) PG8_BAR;
    PG8_WAIT_V(2); PG8_BAR;
    PG8_STAGE(PG8_SB(1, 0), cB + kstepB, voffB); PG8_STAGE(PG8_SA(1, 0), cA + kstepA, voffA); PG8_STAGE(PG8_SB(1, 1), cB + hstepB + kstepB, voffB);
    PG8_WAIT_V(6); PG8_BAR;
    for (;;) {
        const bool has_next = S.next(ui + 1, nxt);
        const char* nA = has_next ? (const char*)g.A + (size_t)nxt.pm * tstepA + PG8_ACOL(nxt) : cA; const char* nB = has_next ? (const char*)g.Bt + (size_t)nxt.pn * tstepB : cB;
        for (int t = 0; t < nt; t += 2) {
            const bool last = (t == nt - 2);
            const char* a1 = cA + (size_t)(t + 1) * kstepA;
            const char* a2 = last ? nA : cA + (size_t)(t + 2) * kstepA; const char* b2 = last ? nB : cB + (size_t)(t + 2) * kstepB;
            const char* a3 = a2 + kstepA; const char* b3 = b2 + kstepB;
            if (last && has_next) S.a_ready(nxt);
            PG8_LDB(B0, 0, 0); PG8_LDB(B1, 0, 1); PG8_SCHED; PG8_LDA(At, 0, 0); PG8_STAGE(PG8_SA(1, 1), a1 + hstepA, voffA);
            PG8_WAIT_V(8); PG8_WAIT_L(0); PG8_BAR; PG8_MMA(0, 0, At, B0); PG8_MMA(0, 1, At, B1); PG8_BAR; PG8_SCHED;
            PG8_LDA(At, 0, 1); PG8_STAGE(PG8_SB(0, 0), b2, voffB); PG8_STAGE(PG8_SB(0, 1), b2 + hstepB, voffB); PG8_STAGE(PG8_SA(0, 0), a2, voffA);
            PG8_WAIT_V(8); PG8_WAIT_L(0); PG8_BAR; PG8_MMA(1, 0, At, B0); PG8_MMA(1, 1, At, B1); PG8_BAR; PG8_SCHED;
            PG8_LDB(B0, 1, 0); PG8_LDB(B1, 1, 1); PG8_SCHED; PG8_LDA(At, 1, 0); PG8_STAGE(PG8_SA(0, 1), a2 + hstepA, voffA);
            PG8_WAIT_V(8); PG8_WAIT_L(0); PG8_BAR; PG8_MMA(0, 0, At, B0); PG8_MMA(0, 1, At, B1); PG8_BAR; PG8_SCHED;
            PG8_LDA(At, 1, 1); PG8_STAGE(PG8_SB(1, 0), b3, voffB); PG8_STAGE(PG8_SB(1, 1), b3 + hstepB, voffB); PG8_STAGE(PG8_SA(1, 0), a3, voffA);
            PG8_WAIT_V(8); PG8_WAIT_L(0); PG8_BAR; PG8_MMA(1, 0, At, B0); PG8_MMA(1, 1, At, B1); PG8_BAR; PG8_SCHED;
        }
        if constexpr (ALIGN_EPI) { if (wr == 0) PG8_BAR; }
        E(acc, cur, wr, wc, fr, fq); S.done(cur);
        if (!has_next) break;
#pragma unroll
        for (int a = 0; a < 2; ++a)
#pragma unroll
            for (int b = 0; b < 2; ++b)
#pragma unroll
                for (int m = 0; m < 4; ++m)
#pragma unroll
                    for (int n = 0; n < 2; ++n) acc[a][b][m][n] = (f32x4){0.f, 0.f, 0.f, 0.f};
        cur = nxt; cA = nA; cB = nB; ++ui;
        if constexpr (ALIGN_EPI) { if (wr == 1) PG8_BAR; }
    }
    PG8_WAIT_V(0);
    if constexpr (!ALIGN_EPI) { if (wr == 0) PG8_BAR; }
    PG8_BAR;
#undef PG8_ACOL
#undef PG8_SA
#undef PG8_SB
#undef PG8_STAGE
#undef PG8_LDA
#undef PG8_LDB
#undef PG8_MMA
#undef PG8_WAIT_V
#undef PG8_WAIT_L
#undef PG8_BAR
#undef PG8_SCHED
}
}
#define GAS __attribute__((address_space(1)))
#define LAS __attribute__((address_space(3)))
typedef unsigned short bf16;
typedef unsigned v4u __attribute__((ext_vector_type(4)));
typedef float f32x4 __attribute__((ext_vector_type(4)));
typedef short bf16x8 __attribute__((ext_vector_type(8)));
typedef GAS unsigned gu32;
typedef GAS unsigned long long gu64;
#define RLX_AGENT __ATOMIC_RELAXED, __HIP_MEMORY_SCOPE_AGENT
#define LDS_WAIT() asm volatile("s_waitcnt lgkmcnt(0)" ::: "memory")
#define VM_WAIT() asm volatile("s_waitcnt vmcnt(0)" ::: "memory")
__device__ __forceinline__ unsigned long long rt() { return __builtin_amdgcn_s_memrealtime(); }
__device__ __forceinline__ unsigned f2bf(float f) { unsigned u = __builtin_bit_cast(unsigned, f); return (u + 0x7fffu + ((u >> 16) & 1u)) >> 16; }
__device__ __forceinline__ unsigned pk2(float lo, float hi) { return f2bf(lo) | (f2bf(hi) << 16); }

#define XB_TMO      128
#define XB_XCNT(j)  (256  + 64 * (j))
#define XB_XSUB(j)  (1280 + 64 * (j))
#define XB_XGEN(j)  (2304 + 64 * (j))
#define XB_TOP      3328
#define XB_TOPGEN   3392
#define XCD_BAR_WORDS 3456
#define XB_SPIN_CAP (1u << 18)

__device__ __forceinline__ unsigned xb_ld(unsigned* p)              { return __hip_atomic_load(p, __ATOMIC_RELAXED, __HIP_MEMORY_SCOPE_AGENT); }
__device__ __forceinline__ unsigned xb_add(unsigned* p, unsigned v) { return __hip_atomic_fetch_add(p, v, __ATOMIC_RELAXED, __HIP_MEMORY_SCOPE_AGENT); }
__device__ __forceinline__ unsigned xb_xcc_id() { return (unsigned)__builtin_amdgcn_s_getreg((3 << 11) | 20) & 0xFu; }
#define XB_SPIN(cond, bar) do { unsigned _sp = 0; while (cond) { __builtin_amdgcn_s_sleep(1); \
    if ((++_sp & 255u) == 0u) { if (xb_ld(&(bar)[XB_TMO])) break; if (_sp > XB_SPIN_CAP) { atomicAdd(&(bar)[XB_TMO], 1u); break; } } } } while (0)

struct XcdBarrier {
    unsigned* bar; unsigned x;
    volatile LAS unsigned* st;
};

__device__ __forceinline__ XcdBarrier xcd_barrier_post(unsigned* bar, volatile LAS unsigned* st) {
    XcdBarrier b; b.bar = bar; b.x = xb_xcc_id(); b.st = st;
    if (threadIdx.x == 0) (void)xb_add(&bar[XB_XCNT(b.x)], 1u);
    return b;
}
__device__ __forceinline__ void xcd_barrier_complete(unsigned* bar, unsigned x, unsigned& nloc, unsigned& nx) {
    const unsigned G = gridDim.x * gridDim.y * gridDim.z;
    unsigned sum, cnt, mine, sp = 0u;
    for (;;) {
        sum = 0u; cnt = 0u; mine = 0u;
#pragma unroll
        for (unsigned j = 0; j < 16; ++j) { const unsigned c = xb_ld(&bar[XB_XCNT(j)]); sum += c; cnt += (c > 0u) ? 1u : 0u; mine = (j == x) ? c : mine; }
        if (sum == G) break;
        __builtin_amdgcn_s_sleep(1);
        if ((++sp & 255u) == 0u) { if (xb_ld(&bar[XB_TMO])) break; if (sp > XB_SPIN_CAP) { atomicAdd(&bar[XB_TMO], 1u); break; } }
    }
    nloc = mine > 0u ? mine : 1u; nx = cnt > 0u ? cnt : 1u;
}

__device__ __forceinline__ void xcd_barrier(const XcdBarrier& b) {
    asm volatile("s_waitcnt vmcnt(0)" ::: "memory");
    __syncthreads();
    if (threadIdx.x == 0) {
        unsigned* bar = b.bar;
        __builtin_amdgcn_s_waitcnt(0);
        unsigned nloc = b.st[0], nx = b.st[1];
        if (nloc == 0u) { xcd_barrier_complete(bar, b.x, nloc, nx); b.st[0] = nloc; b.st[1] = nx; }
        const unsigned old = xb_add(&bar[XB_XSUB(b.x)], 1u);
        const unsigned gen = old / nloc;
        if (old + 1u == (gen + 1u) * nloc) {
            __builtin_amdgcn_fence(__ATOMIC_RELEASE, "agent");
            asm volatile("s_waitcnt vmcnt(0)" ::: "memory");
            const unsigned og = xb_add(&bar[XB_TOP], 1u);
            const unsigned tg = og / nx;
            if (og + 1u == (tg + 1u) * nx) xb_add(&bar[XB_TOPGEN], 1u);
            else XB_SPIN(xb_ld(&bar[XB_TOPGEN]) == tg, bar);
            __builtin_amdgcn_fence(__ATOMIC_ACQUIRE, "agent");
            xb_add(&bar[XB_XGEN(b.x)], 1u);
            asm volatile("s_waitcnt vmcnt(0)" ::: "memory");
        } else {
            XB_SPIN(xb_ld(&bar[XB_XGEN(b.x)]) == gen, bar);
            __builtin_amdgcn_fence(__ATOMIC_ACQUIRE, "agent");
            asm volatile("s_waitcnt vmcnt(0)" ::: "memory");
        }
    }
    __syncthreads();
}

namespace mb {
typedef unsigned short bf16_t;
typedef short bf16x8 __attribute__((ext_vector_type(8)));
typedef short s16x4 __attribute__((ext_vector_type(4)));
typedef float f32x16 __attribute__((ext_vector_type(16)));
typedef float f32x4 __attribute__((ext_vector_type(4)));
typedef unsigned u32x4 __attribute__((ext_vector_type(4)));
constexpr int HD = 128, PITCH = 128, OPITCH = 128;
constexpr float SCALE = 0.08838834764831845f;
constexpr float THR = 8.f;
constexpr int NW = 8, QBLK = 32, KVBLK = 64, QB = NW * QBLK;
constexpr int SHM_V = KVBLK * HD * 2, SHM_K = KVBLK * HD * 2;
constexpr int LDS_BYTES = 2 * SHM_V + 2 * SHM_K + NW * 64 * 4;

#define KSWZ(row, colB) ((row) * 256 + ((colB) ^ (((row) & 7) << 4)))
#define SBAR() __builtin_amdgcn_sched_barrier(0)
__device__ __forceinline__ int v_st(int k, int c) { const int kk = (k & ~0xC) | ((k & 4) << 1) | ((k & 8) >> 1); return ((kk >> 3) * 4 + (c >> 5)) * 512 + ((kk & 7) * 32 + (c & 31)) * 2; }
__device__ __forceinline__ int v_rd_base(int lane) { return ((lane & 3) << 3) | (((lane >> 2) & 3) << 6) | (((lane >> 4) & 1) << 5) | (((lane >> 5) & 1) << 8); }
constexpr int v_rd_off(int d0, int ks, int half) { return d0 * 512 + ks * 4096 + half * 2048; }
__device__ __forceinline__ int crow(int r, int hi) { return (r & 3) + 8 * (r >> 2) + 4 * hi; }
__device__ __forceinline__ unsigned cvtpk(float lo, float hi) { unsigned r; asm volatile("v_cvt_pk_bf16_f32 %0, %1, %2" : "=v"(r) : "v"(lo), "v"(hi)); return r; }
__device__ __forceinline__ bf16x8 load8(const bf16_t* p) { return *reinterpret_cast<const bf16x8*>(p); }

__device__ __forceinline__ void bias_tile(f32x16& p0, f32x16& p1, float ab) {
#pragma unroll
    for (int r = 0; r < 16; ++r) { const int c = (r & 3) + 8 * (r >> 2); p0[r] = fmaf(ab, (float)c, p0[r]); p1[r] = fmaf(ab, (float)(c + 32), p1[r]); }
}
__device__ __forceinline__ void causal_tile(f32x16& p0, f32x16& p1, int dq) {
    const float NEG = -__builtin_inff();
#pragma unroll
    for (int r = 0; r < 16; ++r) { const int c = (r & 3) + 8 * (r >> 2); if (dq - c < 0) p0[r] = NEG; if (dq - c - 32 < 0) p1[r] = NEG; }
}
__device__ __forceinline__ void partialSM(f32x16& p0, f32x16& p1, float& m_reg, float& mn, float& alpha, float off, float abh) {
    float pmax = p0[0]; for (int r = 1; r < 16; ++r) pmax = fmaxf(pmax, p0[r]); for (int r = 0; r < 16; ++r) pmax = fmaxf(pmax, p1[r]);
    pmax += abh;
    { auto rr = __builtin_amdgcn_permlane32_swap(__float_as_uint(pmax), __float_as_uint(pmax), false, false);
      pmax = fmaxf(__uint_as_float(rr[0]), __uint_as_float(rr[1])); }
    pmax += off;
    constexpr float C2 = 1.4426950408889634f * SCALE;
    if (__builtin_expect(__all((pmax - m_reg) * SCALE <= THR), 1)) { mn = m_reg; alpha = 1.f; }
    else { mn = fmaxf(m_reg, pmax); alpha = __builtin_amdgcn_exp2f((m_reg - mn) * C2); m_reg = mn; }
    const float mnL = ((off + abh) - mn) * C2;
    for (int r = 0; r < 16; ++r) p0[r] = fmaf(p0[r], C2, mnL); for (int r = 0; r < 16; ++r) p1[r] = fmaf(p1[r], C2, mnL);
    for (int r = 0; r < 16; ++r) p0[r] = __builtin_amdgcn_exp2f(p0[r]);
}
__device__ __forceinline__ void finishSM(f32x16& p0, f32x16& p1, float alpha, float& l_reg, bf16x8& pa0, bf16x8& pa1, bf16x8& pa2, bf16x8& pa3) {
    for (int r = 0; r < 16; ++r) p1[r] = __builtin_amdgcn_exp2f(p1[r]);
    float ps = 0; for (int r = 0; r < 16; ++r) ps += p0[r]; for (int r = 0; r < 16; ++r) ps += p1[r];
    { auto rr = __builtin_amdgcn_permlane32_swap(__float_as_uint(ps), __float_as_uint(ps), false, false);
      ps = __uint_as_float(rr[0]) + __uint_as_float(rr[1]); }
    l_reg = l_reg * alpha + ps;
#define PK4(P, B_, OUT) do { unsigned a0 = cvtpk(P[B_+0], P[B_+1]), a1 = cvtpk(P[B_+2], P[B_+3]);                          \
        unsigned b0 = cvtpk(P[B_+4], P[B_+5]), b1 = cvtpk(P[B_+6], P[B_+7]);                                             \
        auto r0 = __builtin_amdgcn_permlane32_swap(a0, b0, false, false); auto r1 = __builtin_amdgcn_permlane32_swap(a1, b1, false, false); \
        u32x4 w = {r0[0], r1[0], r0[1], r1[1]}; OUT = *reinterpret_cast<bf16x8*>(&w); } while (0)
    PK4(p0, 0, pa0); PK4(p0, 8, pa1); PK4(p1, 0, pa2); PK4(p1, 8, pa3);
#undef PK4
}
template <int KB>
__device__ __forceinline__ void qkt(f32x16& p0, f32x16& p1, const char* K_lds, int r32, int hi, const bf16x8* qr) {
    p0 = f32x16{}; p1 = f32x16{};
    const char* kb[4];
#pragma unroll
    for (int dd = 0; dd < 4; ++dd) kb[dd] = K_lds + KB * SHM_K + KSWZ(r32, (dd * 16 + hi * 8) * 2);
#pragma unroll
    for (int d0 = 0; d0 < 8; ++d0) { const char* a = kb[d0 & 3] + (d0 >> 2) * 128;
        bf16x8 b0 = *reinterpret_cast<const bf16x8*>(a);
        bf16x8 b1 = *reinterpret_cast<const bf16x8*>(a + 32 * 256);
        p0 = __builtin_amdgcn_mfma_f32_32x32x16_bf16(b0, qr[d0], p0, 0, 0, 0);
        p1 = __builtin_amdgcn_mfma_f32_32x32x16_bf16(b1, qr[d0], p1, 0, 0, 0); }
}
template <int VB>
__device__ __forceinline__ void pv_tile(f32x16* o, int vb0, bf16x8 pa0, bf16x8 pa1, bf16x8 pa2, bf16x8 pa3) {
#define TRRD(dst, off) asm volatile("ds_read_b64_tr_b16 %0, %1 offset:%2" : "=&v"(dst) : "v"(vb0), "i"(off) : "memory")
#define PV_D0(d0) do { s16x4 l0, l1, l2, l3, h0, h1, h2, h3; constexpr int b_ = VB * SHM_V + v_rd_off(d0, 0, 0);     \
        TRRD(l0, b_); TRRD(h0, b_ + 2048); TRRD(l1, b_ + 4096); TRRD(h1, b_ + 6144); TRRD(l2, b_ + 8192); TRRD(h2, b_ + 10240); TRRD(l3, b_ + 12288); TRRD(h3, b_ + 14336); \
        asm volatile("s_waitcnt lgkmcnt(0)" ::: "memory"); SBAR();   \
        o[d0] = __builtin_amdgcn_mfma_f32_32x32x16_bf16(pa0, (bf16x8){l0[0], l0[1], l0[2], l0[3], h0[0], h0[1], h0[2], h0[3]}, o[d0], 0, 0, 0);   \
        o[d0] = __builtin_amdgcn_mfma_f32_32x32x16_bf16(pa1, (bf16x8){l1[0], l1[1], l1[2], l1[3], h1[0], h1[1], h1[2], h1[3]}, o[d0], 0, 0, 0);   \
        o[d0] = __builtin_amdgcn_mfma_f32_32x32x16_bf16(pa2, (bf16x8){l2[0], l2[1], l2[2], l2[3], h2[0], h2[1], h2[2], h2[3]}, o[d0], 0, 0, 0);   \
        o[d0] = __builtin_amdgcn_mfma_f32_32x32x16_bf16(pa3, (bf16x8){l3[0], l3[1], l3[2], l3[3], h3[0], h3[1], h3[2], h3[3]}, o[d0], 0, 0, 0); } while (0)
    PV_D0(0); PV_D0(1); PV_D0(2); PV_D0(3);
#undef PV_D0
#undef TRRD
}

struct BlockRef { const bf16_t* Q; const bf16_t* K; const bf16_t* V; bf16_t* O; const int* rowtab; float* ML; int* LOC; int P0; float ab; int jlo; int item256; };
struct Seam { bf16x8 qr[8]; bf16x8 st_v0, st_v1, st_k0, st_k1; };
#define ROWP(p, k0) ((const char*)(p) + (size_t)(k0) * (PITCH * 2))
#define VMW() asm volatile("s_waitcnt vmcnt(0)" ::: "memory")
#define VMWN(n) asm volatile("s_waitcnt vmcnt(%0)" :: "i"(n) : "memory")
#define SLOAD_H(Kp, Vp, k0) do { const char* vp_ = ROWP(Vp, k0); const char* kp_ = ROWP(Kp, k0);                                   \
                         S.st_v0 = *(const bf16x8*)(vp_ + loff); S.st_v1 = *(const bf16x8*)(vp_ + 32 * PITCH * 2 + loff);          \
                         S.st_k0 = *(const bf16x8*)(kp_ + loff); S.st_k1 = *(const bf16x8*)(kp_ + 32 * PITCH * 2 + loff); } while (0)
#define SWRITE_HK(bf) do { *(bf16x8*)(K_lds + (bf) * SHM_K + kws) = S.st_k0; *(bf16x8*)(K_lds + (bf) * SHM_K + kws + 32 * 256) = S.st_k1; } while (0)
#define SWRITE_HV(bf) do { *(bf16x8*)(V_lds + (bf) * SHM_V + vst0) = S.st_v0; *(bf16x8*)(V_lds + (bf) * SHM_V + vst1) = S.st_v1; } while (0)
#define SWRITE_H(bf) do { SWRITE_HV(bf); SWRITE_HK(bf); } while (0)
__device__ __forceinline__ int fresh_lane() { int l; asm volatile("v_mbcnt_lo_u32_b32 %0, -1, 0\n\tv_mbcnt_hi_u32_b32 %0, -1, %0" : "=v"(l)); return l; }
__device__ __forceinline__ void moba_prime(const BlockRef& cur, char* lds, Seam& S, const int wid) {
    const int lane = fresh_lane(), tid = wid * 64 + lane, r32 = lane & 31, hi = lane >> 5;
    const int sr = tid >> 4, sc = (tid & 15) * 8, kws = KSWZ(sr, sc * 2); char* K_lds = lds + 2 * SHM_V;
    const int rid = cur.rowtab[wid * QBLK + r32], pos = rid >= 0 ? (rid & 0xFFFF) : 0;
    const unsigned loff = (unsigned)(sr * PITCH + sc) * 2u, qoff = (unsigned)(pos * PITCH + hi * 8) * 2u;
#pragma unroll
    for (int d0 = 0; d0 < 8; ++d0) S.qr[d0] = *(const bf16x8*)((const char*)cur.Q + d0 * 32 + qoff);
    SLOAD_H(cur.K, cur.V, cur.jlo * KVBLK); VMW(); SWRITE_HK(0);
    __syncthreads();
}
__device__ __forceinline__ void moba_block(const BlockRef& cur, const BlockRef& nxt, char* lds, Seam& S, const int wid, const int pend_ent, const int pend_idx, int* nxt_rt, int* idx_slot) {
    const int lane = fresh_lane(), tid = wid * 64 + lane, r32 = lane & 31, hi = lane >> 5;
    const int j_lo = cur.jlo; constexpr int NT = 4;
    const int rid = cur.rowtab[wid * QBLK + r32], pos = rid >= 0 ? (rid & 0xFFFF) : 0;
    const int qlo = cur.P0 + wid * QBLK, qm = pos - 4 * hi;
    const float ab = cur.ab, abh = cur.ab * (float)(4 * hi);
    const unsigned mymask = rid >= 0 ? 0xFFFFFFFFu : 0u;
    char* V_lds = lds; char* K_lds = lds + 2 * SHM_V;
    float* ws = (float*)(lds + 2 * SHM_V + 2 * SHM_K) + wid * 64; float* li_l = ws, * al_l = ws + 32;
    float m_reg = -1e30f, l_reg = 0; f32x16 o[4] = {};
    const int sr = tid >> 4, sc = (tid & 15) * 8, vst0 = v_st(sr, sc), vst1 = v_st(32 + sr, sc), kws = KSWZ(sr, sc * 2);
    const unsigned loff = (unsigned)(sr * PITCH + sc) * 2u, qoff = (unsigned)(pos * PITCH + hi * 8) * 2u;
    const int vb0 = (int)(uintptr_t)V_lds + v_rd_base(lane);
    const bf16_t* Kh = cur.K; const bf16_t* Vh = cur.V;
#define RESC(a) do { if (__any((a) < 1.f)) { if (hi == 0) al_l[r32] = (a); asm volatile("s_waitcnt lgkmcnt(0)" ::: "memory");              \
                     for (int d_ = 0; d_ < 4; ++d_) for (int r = 0; r < 16; ++r) o[d_][r] *= al_l[crow(r, hi)]; } } while (0)
#define KBASE(t) ((j_lo + (t)) * KVBLK)
#define BMASK(P0_, P1_, t, OFF_) do { const int kb_ = KBASE(t); const int dq_ = qm - kb_; bias_tile(P0_, P1_, ab);                                   \
        if (kb_ >= cur.P0) { if (kb_ + KVBLK - 1 > qlo) causal_tile(P0_, P1_, dq_); OFF_ = -ab * (float)(dq_ + 4 * hi); }                          \
        else { OFF_ = ((mymask >> (kb_ >> 8)) & 1u) ? -ab * (float)(dq_ + 4 * hi) : -__builtin_inff(); } } while (0)
    constexpr int NQL = 8;
#define SEAM_K0() do { VMWN(NQL); SWRITE_HK(0); SBAR(); } while (0)
    f32x16 pA0, pA1, pB0, pB1; float mnA, mnB, alA, alB, offA, offB; bf16x8 pa0, pa1, pa2, pa3;
    SWRITE_HV(0); SBAR();
    SLOAD_H(Kh, Vh, KBASE(1));
    SBAR(); qkt<0>(pA0, pA1, K_lds, r32, hi, S.qr);
    BMASK(pA0, pA1, 0, offA); partialSM(pA0, pA1, m_reg, mnA, alA, offA, abh);
    VMW(); SWRITE_H(1);
    SBAR(); SLOAD_H(Kh, Vh, KBASE(2)); SBAR();
    if (tid < 256) nxt_rt[tid] = pend_ent;
    if (tid == 0) *idx_slot = pend_idx;
    __syncthreads();
#define HALF_STEP(PX0, PX1, mnX, alX, offX, PY0, PY1, alY, t, KB, VB, SB) do {                                               \
        SBAR(); qkt<KB>(PX0, PX1, K_lds, r32, hi, S.qr);                                                                      \
        finishSM(PY0, PY1, alY, l_reg, pa0, pa1, pa2, pa3); SBAR();                                                           \
        pv_tile<VB>(o, vb0, pa0, pa1, pa2, pa3); BMASK(PX0, PX1, (t), offX); partialSM(PX0, PX1, m_reg, mnX, alX, offX, abh);      \
        __syncthreads();                                                                                                      \
        if ((t) + 1 < NT) { VMW(); SWRITE_H(SB); SBAR(); if ((t) + 2 < NT) { SLOAD_H(Kh, Vh, KBASE((t) + 2)); SBAR(); } }      \
        RESC(alX); __syncthreads(); } while (0)
    for (int t = 1; t + 1 < NT; t += 2) {
        HALF_STEP(pB0, pB1, mnB, alB, offB, pA0, pA1, alA, t, 1, 0, 0);
        HALF_STEP(pA0, pA1, mnA, alA, offA, pB0, pB1, alB, t + 1, 0, 1, 1);
    }
    SBAR(); qkt<1>(pB0, pB1, K_lds, r32, hi, S.qr); SBAR();
    SLOAD_H(nxt.K, nxt.V, nxt.jlo * KVBLK); SBAR();
    { const int ridn = nxt.rowtab[wid * QBLK + r32], posn = ridn >= 0 ? (ridn & 0xFFFF) : 0; const unsigned qoffn = (unsigned)(posn * PITCH + hi * 8) * 2u;
#pragma unroll
    for (int d0 = 0; d0 < 8; ++d0) S.qr[d0] = *(const bf16x8*)((const char*)nxt.Q + d0 * 32 + qoffn); }
    SBAR();
    finishSM(pA0, pA1, alA, l_reg, pa0, pa1, pa2, pa3); SBAR();
    pv_tile<0>(o, vb0, pa0, pa1, pa2, pa3);
    BMASK(pB0, pB1, NT - 1, offB); partialSM(pB0, pB1, m_reg, mnB, alB, offB, abh); __syncthreads(); RESC(alB);
    finishSM(pB0, pB1, alB, l_reg, pa0, pa1, pa2, pa3); SBAR(); pv_tile<1>(o, vb0, pa0, pa1, pa2, pa3);
    SBAR(); SEAM_K0();
    if (hi == 0) li_l[r32] = l_reg; asm volatile("s_waitcnt lgkmcnt(0)" ::: "memory");
    float rli[16];
#pragma unroll
    for (int r = 0; r < 16; ++r) rli[r] = __builtin_amdgcn_rcpf(li_l[crow(r, hi)]);
    const unsigned ooff = (unsigned)((wid * QBLK + 4 * hi) * OPITCH + r32) * 2u;
#pragma unroll
    for (int r = 0; r < 16; ++r) { const int orc = (r & 3) + 8 * (r >> 2);
#pragma unroll
        for (int d0 = 0; d0 < 4; ++d0) { const float v = o[d0][r] * rli[r];
            const float vn = __shfl_xor(v, 1);
            if ((r32 & 1) == 0) *(unsigned*)((char*)cur.O + (size_t)(orc * OPITCH + d0 * 32) * 2 + ooff) = cvtpk(v, vn); } }
    if (hi == 0) { float2 mlv; mlv.x = m_reg; mlv.y = l_reg; *(float2*)(cur.ML + (wid * QBLK + r32) * 2) = mlv;
        if (rid >= 0) cur.LOC[pos * 4 + (rid >> 16)] = cur.item256 + wid * QBLK + r32; }
    __syncthreads();
#undef RESC
#undef KBASE
#undef BMASK
#undef SEAM_K0
#undef HALF_STEP
}
struct UnitRef { const bf16_t* Q; const bf16_t* K; const bf16_t* V; bf16_t* O; float* ML; int* LOC; const int* seg; const int* cnt; float ab; int n; int c; int L; int unit512; };
__device__ __forceinline__ void moba_unit(const UnitRef& u, char* lds, int* rowtab, int* cq, float* wscr, int* idx_slot, const int pend_idx, const int wid) {
    const int lane = fresh_lane(), tid = wid * 64 + lane, r32 = lane & 31, hi = lane >> 5;
    char* V_lds = lds; char* K_lds = lds + 4 * SHM_V;
    const int sr = tid >> 4, sc = (tid & 15) * 8, vst0 = v_st(sr, sc), vst1 = v_st(32 + sr, sc), kws = KSWZ(sr, sc * 2);
    const unsigned loff = (unsigned)(sr * PITCH + sc) * 2u;
    bf16x8 kv[4][4];
#pragma unroll
    for (int t = 0; t < 4; ++t) { const char* vp_ = ROWP(u.V, u.n * 256 + t * 64); const char* kp_ = ROWP(u.K, u.n * 256 + t * 64);
        kv[t][0] = *(const bf16x8*)(vp_ + loff); kv[t][1] = *(const bf16x8*)(vp_ + 32 * PITCH * 2 + loff);
        kv[t][2] = *(const bf16x8*)(kp_ + loff); kv[t][3] = *(const bf16x8*)(kp_ + 32 * PITCH * 2 + loff); }
    if (tid < 32) cq[tid] = (tid > u.n) ? u.cnt[tid] : 0;
    __syncthreads();
    {
        const int sidx = u.c * 512 + tid; int ent = -1;
        if (sidx < 256) ent = (u.n * 256 + sidx) | (3 << 16);
        else { const int g = sidx - 256;
            if (g < u.L) { int acc = 0, qx = u.n + 1;
                while (qx < 31 && g >= acc + cq[qx]) { acc += cq[qx]; ++qx; }
                ent = u.seg[qx * 256 + (g - acc)]; } }
        rowtab[tid] = ent;
    }
#pragma unroll
    for (int t = 0; t < 4; ++t) {
        *(bf16x8*)(V_lds + t * SHM_V + vst0) = kv[t][0]; *(bf16x8*)(V_lds + t * SHM_V + vst1) = kv[t][1];
        *(bf16x8*)(K_lds + t * SHM_K + kws) = kv[t][2]; *(bf16x8*)(K_lds + t * SHM_K + kws + 32 * 256) = kv[t][3]; }
    if (tid == 0) *idx_slot = pend_idx;
    __syncthreads();
    int nr = 256 + u.L - u.c * 512; nr = nr > 512 ? 512 : nr;
    const int ngroups = (nr + 31) >> 5;
    float* li_l = wscr + wid * 64; float* al_l = li_l + 32;
    const int vb0 = (int)(uintptr_t)V_lds + v_rd_base(lane);
    const float ab = u.ab, abh = u.ab * (float)(4 * hi);
#define URESC(a) do { if (__any((a) < 1.f)) { if (hi == 0) al_l[r32] = (a); asm volatile("s_waitcnt lgkmcnt(0)" ::: "memory");              \
                     for (int d_ = 0; d_ < 4; ++d_) for (int r = 0; r < 16; ++r) o[d_][r] *= al_l[crow(r, hi)]; } } while (0)
#define UMASK(P0_, P1_, t, OFF_) do { const int kb_ = u.n * 256 + (t) * KVBLK; const int dq_ = qm - kb_; bias_tile(P0_, P1_, ab);                       \
        if (own) { if (kb_ + KVBLK - 1 > qlo) causal_tile(P0_, P1_, dq_); OFF_ = -ab * (float)(dq_ + 4 * hi); }                                        \
        else OFF_ = rid >= 0 ? -ab * (float)(dq_ + 4 * hi) : -__builtin_inff(); } while (0)
#pragma unroll 1
    for (int grp = wid; grp < ngroups; grp += NW) {
        const int rid = rowtab[grp * 32 + r32], pos = rid >= 0 ? (rid & 0xFFFF) : 0;
        const bool own = (u.c == 0) && (grp < 8);
        const int qlo = u.n * 256 + grp * 32, qm = pos - 4 * hi;
        const unsigned qoff = (unsigned)(pos * PITCH + hi * 8) * 2u;
        bf16x8 qr[8];
#pragma unroll
        for (int d0 = 0; d0 < 8; ++d0) qr[d0] = *(const bf16x8*)((const char*)u.Q + d0 * 32 + qoff);
        float m_reg = -1e30f, l_reg = 0; f32x16 o[4] = {};
        f32x16 pA0, pA1, pB0, pB1; float mnA, mnB, alA, alB, offA, offB; bf16x8 pa0, pa1, pa2, pa3;
        const int nt = own ? (grp >> 1) + 1 : 4;
#define UFIN(P0_, P1_, al_, VB_) do { finishSM(P0_, P1_, al_, l_reg, pa0, pa1, pa2, pa3); pv_tile<VB_>(o, vb0, pa0, pa1, pa2, pa3); } while (0)
        qkt<0>(pA0, pA1, K_lds, r32, hi, qr); UMASK(pA0, pA1, 0, offA); partialSM(pA0, pA1, m_reg, mnA, alA, offA, abh);
        if (nt > 1) qkt<1>(pB0, pB1, K_lds, r32, hi, qr);
        UFIN(pA0, pA1, alA, 0);
        if (nt > 1) {
            UMASK(pB0, pB1, 1, offB); partialSM(pB0, pB1, m_reg, mnB, alB, offB, abh); URESC(alB);
            if (nt > 2) qkt<2>(pA0, pA1, K_lds, r32, hi, qr);
            UFIN(pB0, pB1, alB, 1);
            if (nt > 2) {
                UMASK(pA0, pA1, 2, offA); partialSM(pA0, pA1, m_reg, mnA, alA, offA, abh); URESC(alA);
                if (nt > 3) qkt<3>(pB0, pB1, K_lds, r32, hi, qr);
                UFIN(pA0, pA1, alA, 2);
                if (nt > 3) { UMASK(pB0, pB1, 3, offB); partialSM(pB0, pB1, m_reg, mnB, alB, offB, abh); URESC(alB); UFIN(pB0, pB1, alB, 3); }
            }
        }
#undef UFIN
        if (hi == 0) li_l[r32] = l_reg; asm volatile("s_waitcnt lgkmcnt(0)" ::: "memory");
        float rli[16];
#pragma unroll
        for (int r = 0; r < 16; ++r) rli[r] = __builtin_amdgcn_rcpf(li_l[crow(r, hi)]);
        const unsigned ooff = (unsigned)((grp * 32 + 4 * hi) * OPITCH + r32) * 2u;
#pragma unroll
        for (int r = 0; r < 16; ++r) { const int orc = (r & 3) + 8 * (r >> 2);
#pragma unroll
            for (int d0 = 0; d0 < 4; ++d0) { const float v = o[d0][r] * rli[r];
                const float vn = __shfl_xor(v, 1);
                if ((r32 & 1) == 0) *(unsigned*)((char*)u.O + (size_t)(orc * OPITCH + d0 * 32) * 2 + ooff) = cvtpk(v, vn); } }
        if (hi == 0) { float2 mlv; mlv.x = m_reg; mlv.y = l_reg; *(float2*)(u.ML + (grp * 32 + r32) * 2) = mlv;
            if (rid >= 0) u.LOC[pos * 4 + (rid >> 16)] = u.unit512 + grp * 32 + r32; }
    }
#undef URESC
#undef UMASK
    __syncthreads();
}
#undef ROWP
#undef VMW
#undef VMWN
#undef SLOAD_H
#undef SWRITE_HK
#undef SWRITE_HV
#undef SWRITE_H
#undef KSWZ
#undef SBAR
}

constexpr int NWAVES = 8;
constexpr int RING_OFF = 0, RING_BYTES = 131072;
constexpr int LDSCTL_OFF = RING_BYTES, MISC_OFF = LDSCTL_OFF + 320;
constexpr int LDS_BYTES = 163840;
typedef pg8::bf16_t bf16_t;
typedef short s16x4 __attribute__((ext_vector_type(4)));
typedef unsigned u32x2 __attribute__((ext_vector_type(2)));
typedef unsigned u32x4 __attribute__((ext_vector_type(4)));
constexpr int KSPLIT = 16;

constexpr size_t CTL_BYTES = 65536;
constexpr size_t al256(size_t v) { return (v + 255) & ~(size_t)255; }
constexpr size_t O_ctl = 0;
constexpr size_t O_modp = O_ctl + CTL_BYTES;
constexpr size_t O_shv = O_modp + al256((size_t)KSPLIT * DEPTH * NMOD * 4);
constexpr size_t O_gs = O_shv + al256((size_t)DEPTH * 3 * D * 4);
constexpr size_t O_cres = O_gs + al256((size_t)DEPTH * 3 * D * 4);
constexpr size_t O_bias = O_cres + al256((size_t)DEPTH * 3 * D * 4);
constexpr size_t O_ss = O_bias + al256((size_t)DEPTH * 3 * F2 * 4);
constexpr size_t O_kmp = O_ss + al256((size_t)T * 32 * 4);
constexpr size_t O_sel = O_kmp + al256((size_t)2 * 32 * D * 4);
constexpr size_t O_wgu = O_sel + al256((size_t)T * 16 * 4);
constexpr size_t O_wd = O_wgu + al256((size_t)DEPTH * 2 * F2 * D * 2);
constexpr size_t O_mqkv = O_wd + al256((size_t)DEPTH * 2 * D * F * 2);
constexpr size_t O_mo = O_mqkv + al256((size_t)2 * 3 * D * D * 2);
constexpr size_t O_pw = O_mo + al256((size_t)2 * D * D * 2);
constexpr size_t O_sqkv = O_pw + al256((size_t)D * 512 * 2);
constexpr size_t O_so = O_sqkv + al256((size_t)2560 * D * 2);
constexpr size_t O_x = O_so + al256((size_t)D * D * 2);
constexpr size_t O_ap = O_x + al256((size_t)T * D * 4);
constexpr size_t O_act = O_ap + al256((size_t)T * D * 2);
constexpr size_t O_qb = O_act + al256((size_t)T * F * 2);
constexpr size_t O_kb = O_qb + al256((size_t)T * D * 2);
constexpr size_t O_vb = O_kb + al256((size_t)T * D * 2);
constexpr size_t O_vtb = O_vb + al256((size_t)T * D * 2);
constexpr size_t O_ao = O_vtb + al256((size_t)T * D * 2);
constexpr size_t O_biasp = O_ao + al256((size_t)T * D * 2);
constexpr int MB_MAXUNITS = 16 * (64 + 32);
constexpr size_t O_seg = O_biasp + al256((size_t)32 * DEPTH * 3 * F2 * 4);
constexpr size_t O_cnt = O_seg + al256((size_t)16 * 32 * 32 * 256 * 4);
constexpr size_t O_loc = O_cnt + al256((size_t)16 * 32 * 32 * 4);
constexpr size_t O_ml = O_loc + al256((size_t)16 * T * 4 * 4);
constexpr size_t O_part = O_ml + al256((size_t)MB_MAXUNITS * 512 * 2 * 4);
constexpr size_t WS_NEED = O_part + al256((size_t)MB_MAXUNITS * 512 * 128 * 2);
static_assert(O_kb == O_qb + (size_t)T * D * 2 && O_vb == O_kb + (size_t)T * D * 2, "q | k | v contiguous");
#define W_ctl ((unsigned*)(ws + O_ctl))
#define W_modp ((float*)(ws + O_modp))
#define W_shv ((float*)(ws + O_shv))
#define W_gs ((float*)(ws + O_gs))
#define W_cres ((float*)(ws + O_cres))
#define W_bias ((float*)(ws + O_bias))
#define W_ss ((float*)(ws + O_ss))
#define W_kmp ((float*)(ws + O_kmp))
#define W_sel ((unsigned*)(ws + O_sel))
#define W_wgu ((bf16_t*)(ws + O_wgu))
#define W_wd ((bf16_t*)(ws + O_wd))
#define W_mqkv ((bf16_t*)(ws + O_mqkv))
#define W_mo ((bf16_t*)(ws + O_mo))
#define W_pw ((bf16_t*)(ws + O_pw))
#define W_sqkv ((bf16_t*)(ws + O_sqkv))
#define W_so ((bf16_t*)(ws + O_so))
#define W_x ((bf16_t*)(ws + O_x))
#define XIDX(r_, c_) (((size_t)(((r_) >> 8) * (D / 64) + ((c_) >> 6)) * 256 + ((r_) & 255)) * 64 + ((c_) & 63))
#define W_ap ((bf16_t*)(ws + O_ap))
#define W_act ((bf16_t*)(ws + O_act))
#define W_qb ((bf16_t*)(ws + O_qb))
#define W_kb ((bf16_t*)(ws + O_kb))
#define W_vb ((bf16_t*)(ws + O_vb))
#define W_vtb ((bf16_t*)(ws + O_vtb))
#define W_ao ((bf16_t*)(ws + O_ao))
#define W_biasp ((float*)(ws + O_biasp))
#define W_seg ((int*)(ws + O_seg))
#define W_cnt ((int*)(ws + O_cnt))
#define W_loc ((int*)(ws + O_loc))
#define W_ml ((float*)(ws + O_ml))
#define W_part ((bf16_t*)(ws + O_part))
#define WS_FRESH() GAS unsigned char* wsg_ = (GAS unsigned char*)ws0; asm volatile("" : "+s"(wsg_)); unsigned char* ws = (unsigned char*)wsg_
#define FRESH_TID() int ftid; asm volatile("v_mbcnt_lo_u32_b32 %0, -1, 0\n\tv_mbcnt_hi_u32_b32 %0, -1, %0" : "=v"(ftid)); ftid += (wave << 6); const int flane = ftid & 63; (void)flane
struct Args { const float* in[16]; float* out; unsigned char* ws; };

__device__ __forceinline__ float wave_sum(float v) {
#pragma unroll
    for (int o = 1; o < 64; o <<= 1) v += __shfl_xor(v, o);
    return v;
}
__device__ __forceinline__ float bf2f(unsigned b) { return __builtin_bit_cast(float, b << 16); }

__device__ __forceinline__ void p0_transpose_item(const float* W, int K, int N, bf16_t* WT, int mode, int row_off, LAS float* scr, int item, int lane, const float* sh = nullptr, float* biasp = nullptr) {
    const int nblk = N / 32, kb = item / nblk, nb = item % nblk, k0 = 64 * kb, n0 = 32 * nb;
    const int r0 = mode == 0 ? n0 + row_off : ((n0 >> 7) * 256 + (mode == 2 ? 128 : 0) + (n0 & 127));
    const int hf = lane >> 5, nl = lane & 31;
    float w[32];
    const float* wp = W + (size_t)(k0 + hf) * N + n0 + nl;
#pragma unroll
    for (int i = 0; i < 32; ++i) w[i] = wp[(size_t)(2 * i) * N];
    if (sh) scr[2112 + lane] = sh[k0 + lane];
#pragma unroll
    for (int i = 0; i < 32; ++i) scr[(2 * i + hf) * 33 + nl] = w[i];
    LDS_WAIT(); asm volatile("" ::: "memory");
    if (sh) { float a0 = 0.f, a1 = 0.f;
#pragma unroll
        for (int i = 0; i < 32; i += 2) { a0 += scr[2112 + 2 * i + hf] * w[i]; a1 += scr[2112 + 2 * i + 2 + hf] * w[i + 1]; }
        float a = a0 + a1; a += __shfl_xor(a, 32);
        if (lane < 32) biasp[(size_t)kb * (DEPTH * 3 * F2) + r0 + nl] = a; }
    const int c = lane & 7;
#pragma unroll
    for (int j = 0; j < 4; ++j) { const int n = (lane >> 3) + 8 * j; const LAS float* s = scr + (8 * c) * 33 + n;
        v4u o; o.x = pk2(s[0 * 33], s[1 * 33]); o.y = pk2(s[2 * 33], s[3 * 33]); o.z = pk2(s[4 * 33], s[5 * 33]); o.w = pk2(s[6 * 33], s[7 * 33]);
        *(GAS v4u*)(WT + ((size_t)((r0 >> 8) * (K / 64) + kb) * 256 + ((r0 & 255) + n)) * 64 + 8 * c) = o; }
    LDS_WAIT(); asm volatile("" ::: "memory");
}
constexpr int CVT_GSB = 13312;
struct CvtD { const float* W; bf16_t* WT; const float* sh; float* bp; int N, KT, mode, roff, kb, nb; };
__device__ __forceinline__ void cvt_issue(const CvtD& d, int lane, LAS unsigned char* buf, LAS unsigned char* shb) {
    if (d.sh) {
        __builtin_amdgcn_global_load_lds((const unsigned*)((const char*)(d.sh + 64 * d.kb) + (unsigned)lane * 4u), (LAS unsigned*)shb, 4, 0, 0);
        __builtin_amdgcn_global_load_lds((const unsigned*)((const char*)(d.sh + 64 * d.kb) + (O_gs - O_shv) + (unsigned)lane * 4u), (LAS unsigned*)(shb + CVT_GSB), 4, 0, 0); }
    const float* base = d.W + (size_t)(64 * d.kb) * d.N + 32 * d.nb;
    const unsigned voff = (unsigned)((8 * (lane & 7)) * d.N + 4 * (lane >> 3)) * 4u;
#pragma unroll
    for (int i = 0; i < 8; ++i)
        __builtin_amdgcn_global_load_lds((const unsigned*)((const char*)(base + (size_t)i * d.N) + voff), (LAS unsigned*)(buf + i * 1024), 16, 0, 0);
}
__device__ __forceinline__ void cvt_fin(const CvtD& d, int lane, const LAS unsigned char* buf, const LAS unsigned char* shb) {
    const int n0 = 32 * d.nb, kb = d.kb;
    const int r0 = d.mode == 0 ? n0 + d.roff : ((n0 >> 7) * 256 + (d.mode == 2 ? 128 : 0) + (n0 & 127));
    const int c = lane & 7, nlo = lane >> 3;
    const LAS float* lp = (const LAS float*)buf + ((nlo >> 2) * 32 + c * 4 + (nlo & 3));
    float v[4][8];
#pragma unroll
    for (int j = 0; j < 4; ++j)
#pragma unroll
        for (int e = 0; e < 8; ++e) v[j][e] = lp[e * 256 + j * 64];
    if (d.sh) {
        const f32x4 s0 = *(const LAS f32x4*)(shb + c * 32), s1 = *(const LAS f32x4*)(shb + c * 32 + 16);
        float a[4];
#pragma unroll
        for (int j = 0; j < 4; ++j) { a[j] = ((v[j][0] * s0[0] + v[j][1] * s0[1]) + (v[j][2] * s0[2] + v[j][3] * s0[3])) + ((v[j][4] * s1[0] + v[j][5] * s1[1]) + (v[j][6] * s1[2] + v[j][7] * s1[3]));
            a[j] += __shfl_xor(a[j], 1); a[j] += __shfl_xor(a[j], 2); a[j] += __shfl_xor(a[j], 4); }
        const float av = c == 0 ? a[0] : (c == 1 ? a[1] : (c == 2 ? a[2] : a[3]));
        if (c < 4) d.bp[(size_t)kb * (DEPTH * 3 * F2) + r0 + nlo + 8 * c] = av;
        const f32x4 g0 = *(const LAS f32x4*)(shb + CVT_GSB + c * 32), g1 = *(const LAS f32x4*)(shb + CVT_GSB + c * 32 + 16);
#pragma unroll
        for (int j = 0; j < 4; ++j) { v[j][0] *= g0[0]; v[j][1] *= g0[1]; v[j][2] *= g0[2]; v[j][3] *= g0[3]; v[j][4] *= g1[0]; v[j][5] *= g1[1]; v[j][6] *= g1[2]; v[j][7] *= g1[3]; }
    }
#pragma unroll
    for (int j = 0; j < 4; ++j) {
        v4u o; o.x = pk2(v[j][0], v[j][1]); o.y = pk2(v[j][2], v[j][3]); o.z = pk2(v[j][4], v[j][5]); o.w = pk2(v[j][6], v[j][7]);
        *(GAS v4u*)((GAS char*)(d.WT + ((size_t)((r0 >> 8) * d.KT + kb) * 256 + (r0 & 255) + 8 * j) * 64) + (unsigned)(nlo * 64 + 8 * c) * 2u) = o; }
}
__device__ __forceinline__ void p0_mod_item(const float* c, const float* ada_w, float* modp, int item, int lane) {
    const int chunk = item % 72, l = (item / 72) % DEPTH, ks = item / (72 * DEPTH);
    const int j = chunk * 256 + lane * 4, kr = D / KSPLIT, k0 = ks * kr;
    const float* w = ada_w + ((size_t)l * D + k0) * NMOD + j;
    static_assert(D / KSPLIT == 128, "two silu(c) values per lane");
    const float cA = c[k0 + lane], cB = c[k0 + 64 + lane];
    const float sA = cA / (1.f + __expf(-cA)), sB = cB / (1.f + __expf(-cB));
    f32x4 a0 = {0.f, 0.f, 0.f, 0.f}, a1 = a0, a2 = a0, a3 = a0;
#pragma unroll 1
    for (int k = 0; k < kr; k += 16) {
        f32x4 wv[16];
#pragma unroll
        for (int i = 0; i < 16; ++i) wv[i] = *(const f32x4*)(w + (size_t)(k + i) * NMOD);
        const float sv = (k & 64) ? sB : sA;
#pragma unroll
        for (int i = 0; i < 16; i += 4) {
            const int r = (k & 63) + i;
            a0 += wv[i] * __builtin_bit_cast(float, __builtin_amdgcn_readlane(__builtin_bit_cast(int, sv), r)); a1 += wv[i + 1] * __builtin_bit_cast(float, __builtin_amdgcn_readlane(__builtin_bit_cast(int, sv), r + 1));
            a2 += wv[i + 2] * __builtin_bit_cast(float, __builtin_amdgcn_readlane(__builtin_bit_cast(int, sv), r + 2)); a3 += wv[i + 3] * __builtin_bit_cast(float, __builtin_amdgcn_readlane(__builtin_bit_cast(int, sv), r + 3));
        }
    }
    *(f32x4*)(modp + ((size_t)ks * DEPTH + l) * NMOD + j) = (a0 + a1) + (a2 + a3);
}

__device__ __forceinline__ void moba_attn_unit(const bf16_t* __restrict__ Q, const bf16_t* __restrict__ Kb, const bf16_t* __restrict__ VT, const unsigned* __restrict__ sel, bf16_t* __restrict__ O, int gw, int lane) {
    const int lq = lane & 15, quad = lane >> 4;
    const int h = gw & 15, rg = gw >> 4, t0 = rg * 16, qblk = t0 >> 8, tq = t0 + lq;
    const float slope2 = exp2f(-(float)(h + 1) * 0.5f) * LOG2E, sc2 = 0.08838834764831845f * LOG2E;
    bf16x8 qf[4];
#pragma unroll
    for (int kk = 0; kk < 4; ++kk) qf[kk] = *(const bf16x8*)(Q + (size_t)tq * D + h * 128 + kk * 32 + quad * 8);
    const unsigned mymask = sel[tq * 16 + h];
    unsigned um = mymask; um |= __shfl_xor(um, 1); um |= __shfl_xor(um, 2); um |= __shfl_xor(um, 4); um |= __shfl_xor(um, 8);
    um = __builtin_amdgcn_readfirstlane(um) | (1u << qblk);
    float m = -1e30f, l = 0.f; f32x4 o[8];
#pragma unroll
    for (int dt = 0; dt < 8; ++dt) o[dt] = (f32x4){0.f, 0.f, 0.f, 0.f};
    for (int j = 0; j <= qblk; ++j) {
        if (!((um >> j) & 1u)) continue;
        const bool own = (j == qblk), rowsel = own || ((mymask >> j) & 1u);
        const int nsteps = own ? ((t0 + 15 - j * 256) / 32 + 1) : 8;
        for (int st = 0; st < nsteps; ++st) {
            const int kb = j * 256 + st * 32;
            f32x4 s0 = (f32x4){0.f, 0.f, 0.f, 0.f}, s1 = (f32x4){0.f, 0.f, 0.f, 0.f};
#pragma unroll
            for (int kk = 0; kk < 4; ++kk) {
                const bf16x8 a0 = *(const bf16x8*)(Kb + (size_t)(kb + lq) * D + h * 128 + kk * 32 + quad * 8);
                const bf16x8 a1 = *(const bf16x8*)(Kb + (size_t)(kb + 16 + lq) * D + h * 128 + kk * 32 + quad * 8);
                s0 = __builtin_amdgcn_mfma_f32_16x16x32_bf16(a0, qf[kk], s0, 0, 0, 0);
                s1 = __builtin_amdgcn_mfma_f32_16x16x32_bf16(a1, qf[kk], s1, 0, 0, 0);
            }
            float p[8]; float mx = -INFINITY;
#pragma unroll
            for (int i = 0; i < 4; ++i) {
                const int tk0 = kb + quad * 4 + i, tk1 = tk0 + 16;
                float a = s0[i] * sc2 - slope2 * (float)(tq - tk0); if (!rowsel || tk0 > tq) a = -INFINITY;
                float b = s1[i] * sc2 - slope2 * (float)(tq - tk1); if (!rowsel || tk1 > tq) b = -INFINITY;
                p[i] = a; p[4 + i] = b; mx = fmaxf(mx, fmaxf(a, b));
            }
            mx = fmaxf(mx, __shfl_xor(mx, 16)); mx = fmaxf(mx, __shfl_xor(mx, 32));
            const float mn = fmaxf(m, mx), alpha = exp2f(m - mn); m = mn;
            float ps = 0.f;
#pragma unroll
            for (int i = 0; i < 8; ++i) { p[i] = exp2f(p[i] - mn); ps += p[i]; }
            l = l * alpha + ps;
            u32x4 pw; pw.x = pg8::cvt_pk_bf16(p[0], p[1]); pw.y = pg8::cvt_pk_bf16(p[2], p[3]); pw.z = pg8::cvt_pk_bf16(p[4], p[5]); pw.w = pg8::cvt_pk_bf16(p[6], p[7]);
            const bf16x8 pb = __builtin_bit_cast(bf16x8, pw);
#pragma unroll
            for (int dt = 0; dt < 8; ++dt) {
                const bf16_t* vp = VT + (size_t)(h * 128 + dt * 16 + lq) * T + kb + quad * 4;
                const s16x4 x0 = *(const s16x4*)vp, x1 = *(const s16x4*)(vp + 16);
                const bf16x8 va = (bf16x8){x0[0], x0[1], x0[2], x0[3], x1[0], x1[1], x1[2], x1[3]};
                o[dt] = o[dt] * alpha;
                o[dt] = __builtin_amdgcn_mfma_f32_16x16x32_bf16(va, pb, o[dt], 0, 0, 0);
            }
        }
    }
    l += __shfl_xor(l, 16); l += __shfl_xor(l, 32);
    const float inv = 1.0f / l;
#pragma unroll
    for (int dt = 0; dt < 8; ++dt) { u32x2 w; w.x = pg8::cvt_pk_bf16(o[dt][0] * inv, o[dt][1] * inv); w.y = pg8::cvt_pk_bf16(o[dt][2] * inv, o[dt][3] * inv);
        *(u32x2*)(O + (size_t)tq * D + h * 128 + dt * 16 + quad * 4) = w; }
}
__device__ __forceinline__ void swa_attn_unit(const bf16_t* __restrict__ Q, const bf16_t* __restrict__ Kb, const bf16_t* __restrict__ VT, const float* __restrict__ sinks, bf16_t* __restrict__ O, int gw, int lane) {
    const int lq = lane & 15, quad = lane >> 4;
    const int hq = gw & 31, rg = gw >> 5, t0 = rg * 16, hk = hq >> 3, tq = t0 + lq;
    const float slope2 = exp2f(-(float)(hq + 1) * 0.25f) * LOG2E, sc2 = 0.125f * LOG2E, sink2 = sinks[hq] * LOG2E;
    bf16x8 qf[2];
#pragma unroll
    for (int kk = 0; kk < 2; ++kk) qf[kk] = *(const bf16x8*)(Q + (size_t)tq * D + hq * 64 + kk * 32 + quad * 8);
    float p[5][8]; float mx = sink2;
#pragma unroll
    for (int st = 0; st < 5; ++st) {
        const int kb = t0 - 128 + st * 32;
        f32x4 s0 = (f32x4){0.f, 0.f, 0.f, 0.f}, s1 = (f32x4){0.f, 0.f, 0.f, 0.f};
        int r0 = kb + lq, r1 = kb + 16 + lq; r0 = r0 < 0 ? 0 : (r0 > T - 1 ? T - 1 : r0); r1 = r1 < 0 ? 0 : (r1 > T - 1 ? T - 1 : r1);
#pragma unroll
        for (int kk = 0; kk < 2; ++kk) {
            const bf16x8 a0 = *(const bf16x8*)(Kb + (size_t)r0 * 256 + hk * 64 + kk * 32 + quad * 8);
            const bf16x8 a1 = *(const bf16x8*)(Kb + (size_t)r1 * 256 + hk * 64 + kk * 32 + quad * 8);
            s0 = __builtin_amdgcn_mfma_f32_16x16x32_bf16(a0, qf[kk], s0, 0, 0, 0);
            s1 = __builtin_amdgcn_mfma_f32_16x16x32_bf16(a1, qf[kk], s1, 0, 0, 0);
        }
#pragma unroll
        for (int i = 0; i < 4; ++i) {
            const int tk0 = kb + quad * 4 + i, tk1 = tk0 + 16, d0 = tq - tk0, d1 = tq - tk1;
            const float a = (tk0 >= 0 && d0 >= 0 && d0 < 128) ? s0[i] * sc2 - slope2 * (float)d0 : -INFINITY;
            const float b = (tk1 >= 0 && d1 >= 0 && d1 < 128) ? s1[i] * sc2 - slope2 * (float)d1 : -INFINITY;
            p[st][i] = a; p[st][4 + i] = b; mx = fmaxf(mx, fmaxf(a, b));
        }
    }
    mx = fmaxf(mx, __shfl_xor(mx, 16)); mx = fmaxf(mx, __shfl_xor(mx, 32));
    float l = 0.f;
#pragma unroll
    for (int st = 0; st < 5; ++st)
#pragma unroll
        for (int i = 0; i < 8; ++i) { p[st][i] = exp2f(p[st][i] - mx); l += p[st][i]; }
    l += __shfl_xor(l, 16); l += __shfl_xor(l, 32);
    l += exp2f(sink2 - mx);
    f32x4 o[4];
#pragma unroll
    for (int dt = 0; dt < 4; ++dt) o[dt] = (f32x4){0.f, 0.f, 0.f, 0.f};
#pragma unroll
    for (int st = 0; st < 5; ++st) {
        const int kb = t0 - 128 + st * 32;
        u32x4 pw; pw.x = pg8::cvt_pk_bf16(p[st][0], p[st][1]); pw.y = pg8::cvt_pk_bf16(p[st][2], p[st][3]); pw.z = pg8::cvt_pk_bf16(p[st][4], p[st][5]); pw.w = pg8::cvt_pk_bf16(p[st][6], p[st][7]);
        const bf16x8 pb = __builtin_bit_cast(bf16x8, pw);
        int c0 = kb + quad * 4, c1 = c0 + 16; c0 = c0 < 0 ? 0 : (c0 > T - 4 ? T - 4 : c0); c1 = c1 < 0 ? 0 : (c1 > T - 4 ? T - 4 : c1);
#pragma unroll
        for (int dt = 0; dt < 4; ++dt) {
            const bf16_t* vp = VT + (size_t)(hk * 64 + dt * 16 + lq) * T;
            const s16x4 x0 = *(const s16x4*)(vp + c0), x1 = *(const s16x4*)(vp + c1);
            const bf16x8 va = (bf16x8){x0[0], x0[1], x0[2], x0[3], x1[0], x1[1], x1[2], x1[3]};
            o[dt] = __builtin_amdgcn_mfma_f32_16x16x32_bf16(va, pb, o[dt], 0, 0, 0);
        }
    }
    const float inv = 1.0f / l;
#pragma unroll
    for (int dt = 0; dt < 4; ++dt) { u32x2 w; w.x = pg8::cvt_pk_bf16(o[dt][0] * inv, o[dt][1] * inv); w.y = pg8::cvt_pk_bf16(o[dt][2] * inv, o[dt][3] * inv);
        *(u32x2*)(O + (size_t)tq * D + hq * 64 + dt * 16 + quad * 4) = w; }
}

__device__ __forceinline__ void swa_attn_unit2(const bf16_t* __restrict__ Q, const bf16_t* __restrict__ Kb, const bf16_t* __restrict__ VT, const float* __restrict__ sinks, bf16_t* __restrict__ O, int gw0, int gw1, int lane) {
    const int lq = lane & 15, quad = lane >> 4;
    int hq[2], t0[2], hk[2], tq[2]; float slope2[2], sink2[2];
    constexpr float sc2 = 0.125f * LOG2E;
#pragma unroll
    for (int w = 0; w < 2; ++w) { const int gw = w ? gw1 : gw0; hq[w] = gw & 31; t0[w] = (gw >> 5) * 16; hk[w] = hq[w] >> 3; tq[w] = t0[w] + lq;
        slope2[w] = exp2f(-(float)(hq[w] + 1) * 0.25f) * LOG2E; sink2[w] = sinks[hq[w]] * LOG2E; }
    bf16x8 qf[2][2];
#pragma unroll
    for (int w = 0; w < 2; ++w)
#pragma unroll
        for (int kk = 0; kk < 2; ++kk) qf[w][kk] = *(const bf16x8*)(Q + (size_t)tq[w] * D + hq[w] * 64 + kk * 32 + quad * 8);
    float p[2][5][8]; float mx[2] = {sink2[0], sink2[1]};
#pragma unroll
    for (int st = 0; st < 5; ++st) {
        bf16x8 ka[2][2];
        { const int kb = t0[0] - 128 + st * 32;
            int r0 = kb + lq, r1 = kb + 16 + lq; r0 = r0 < 0 ? 0 : (r0 > T - 1 ? T - 1 : r0); r1 = r1 < 0 ? 0 : (r1 > T - 1 ? T - 1 : r1);
#pragma unroll
            for (int kk = 0; kk < 2; ++kk) { ka[kk][0] = *(const bf16x8*)(Kb + (size_t)r0 * 256 + hk[0] * 64 + kk * 32 + quad * 8);
                ka[kk][1] = *(const bf16x8*)(Kb + (size_t)r1 * 256 + hk[0] * 64 + kk * 32 + quad * 8); } }
#pragma unroll
        for (int w = 0; w < 2; ++w) { const int kb = t0[w] - 128 + st * 32;
            f32x4 s0 = (f32x4){0.f, 0.f, 0.f, 0.f}, s1 = (f32x4){0.f, 0.f, 0.f, 0.f};
#pragma unroll
            for (int kk = 0; kk < 2; ++kk) { s0 = __builtin_amdgcn_mfma_f32_16x16x32_bf16(ka[kk][0], qf[w][kk], s0, 0, 0, 0); s1 = __builtin_amdgcn_mfma_f32_16x16x32_bf16(ka[kk][1], qf[w][kk], s1, 0, 0, 0); }
#pragma unroll
            for (int i = 0; i < 4; ++i) {
                const int tk0 = kb + quad * 4 + i, tk1 = tk0 + 16, d0 = tq[w] - tk0, d1 = tq[w] - tk1;
                const float a = (tk0 >= 0 && d0 >= 0 && d0 < 128) ? s0[i] * sc2 - slope2[w] * (float)d0 : -INFINITY;
                const float bq = (tk1 >= 0 && d1 >= 0 && d1 < 128) ? s1[i] * sc2 - slope2[w] * (float)d1 : -INFINITY;
                p[w][st][i] = a; p[w][st][4 + i] = bq; mx[w] = fmaxf(mx[w], fmaxf(a, bq));
            } }
    }
    float l[2];
#pragma unroll
    for (int w = 0; w < 2; ++w) { mx[w] = fmaxf(mx[w], __shfl_xor(mx[w], 16)); mx[w] = fmaxf(mx[w], __shfl_xor(mx[w], 32));
        float ls = 0.f;
#pragma unroll
        for (int st = 0; st < 5; ++st)
#pragma unroll
            for (int i = 0; i < 8; ++i) { p[w][st][i] = exp2f(p[w][st][i] - mx[w]); ls += p[w][st][i]; }
        ls += __shfl_xor(ls, 16); ls += __shfl_xor(ls, 32);
        l[w] = ls + exp2f(sink2[w] - mx[w]); }
    f32x4 o[2][4];
#pragma unroll
    for (int w = 0; w < 2; ++w)
#pragma unroll
        for (int dt = 0; dt < 4; ++dt) o[w][dt] = (f32x4){0.f, 0.f, 0.f, 0.f};
#pragma unroll
    for (int st = 0; st < 5; ++st) {
        s16x4 xv[4][2];
        { const int kb = t0[0] - 128 + st * 32;
            int c0 = kb + quad * 4, c1 = c0 + 16; c0 = c0 < 0 ? 0 : (c0 > T - 4 ? T - 4 : c0); c1 = c1 < 0 ? 0 : (c1 > T - 4 ? T - 4 : c1);
#pragma unroll
            for (int dt = 0; dt < 4; ++dt) { const bf16_t* vp = VT + (size_t)(hk[0] * 64 + dt * 16 + lq) * T; xv[dt][0] = *(const s16x4*)(vp + c0); xv[dt][1] = *(const s16x4*)(vp + c1); } }
#pragma unroll
        for (int w = 0; w < 2; ++w) {
            u32x4 pw; pw.x = pg8::cvt_pk_bf16(p[w][st][0], p[w][st][1]); pw.y = pg8::cvt_pk_bf16(p[w][st][2], p[w][st][3]); pw.z = pg8::cvt_pk_bf16(p[w][st][4], p[w][st][5]); pw.w = pg8::cvt_pk_bf16(p[w][st][6], p[w][st][7]);
            const bf16x8 pb = __builtin_bit_cast(bf16x8, pw);
#pragma unroll
            for (int dt = 0; dt < 4; ++dt) { const s16x4 x0 = xv[dt][0], x1 = xv[dt][1];
                const bf16x8 va = (bf16x8){x0[0], x0[1], x0[2], x0[3], x1[0], x1[1], x1[2], x1[3]};
                o[w][dt] = __builtin_amdgcn_mfma_f32_16x16x32_bf16(va, pb, o[w][dt], 0, 0, 0); } }
    }
#pragma unroll
    for (int w = 0; w < 2; ++w) { const float inv = 1.0f / l[w];
#pragma unroll
        for (int dt = 0; dt < 4; ++dt) { u32x2 wv; wv.x = pg8::cvt_pk_bf16(o[w][dt][0] * inv, o[w][dt][1] * inv); wv.y = pg8::cvt_pk_bf16(o[w][dt][2] * inv, o[w][dt][3] * inv);
            *(u32x2*)(O + (size_t)tq[w] * D + hq[w] * 64 + dt * 16 + quad * 4) = wv; } }
}

__device__ __forceinline__ void swa_attn_unit4(const bf16_t* __restrict__ Q, const bf16_t* __restrict__ Kb, const bf16_t* __restrict__ VT, const float* __restrict__ sinks, bf16_t* __restrict__ O, int gw0, int lane) {
    const int lq = lane & 15, quad = lane >> 4;
    const int hq0 = gw0 & 31, t0 = (gw0 >> 5) * 16, hk = hq0 >> 3, tq = t0 + lq;
    constexpr float sc2 = 0.125f * LOG2E;
    float slope2[4], sink2[4], m[4], l[4]; bf16x8 qf[4][2]; f32x4 o[4][4];
#pragma unroll
    for (int w = 0; w < 4; ++w) { slope2[w] = exp2f(-(float)(hq0 + w + 1) * 0.25f) * LOG2E; sink2[w] = sinks[hq0 + w] * LOG2E; m[w] = sink2[w]; l[w] = 0.f;
#pragma unroll
        for (int kk = 0; kk < 2; ++kk) qf[w][kk] = *(const bf16x8*)(Q + (size_t)tq * D + (hq0 + w) * 64 + kk * 32 + quad * 8);
#pragma unroll
        for (int dt = 0; dt < 4; ++dt) o[w][dt] = (f32x4){0.f, 0.f, 0.f, 0.f}; }
#define SWA4_LOAD(KA, XV, st_) do { const int kb_ = t0 - 128 + (st_) * 32;                                                                                             \
        int r0 = kb_ + lq, r1 = kb_ + 16 + lq; r0 = r0 < 0 ? 0 : (r0 > T - 1 ? T - 1 : r0); r1 = r1 < 0 ? 0 : (r1 > T - 1 ? T - 1 : r1);                                  \
        _Pragma("unroll") for (int kk = 0; kk < 2; ++kk) { KA[kk][0] = *(const bf16x8*)(Kb + (size_t)r0 * 256 + hk * 64 + kk * 32 + quad * 8); KA[kk][1] = *(const bf16x8*)(Kb + (size_t)r1 * 256 + hk * 64 + kk * 32 + quad * 8); } \
        int c0 = kb_ + quad * 4, c1 = c0 + 16; c0 = c0 < 0 ? 0 : (c0 > T - 4 ? T - 4 : c0); c1 = c1 < 0 ? 0 : (c1 > T - 4 ? T - 4 : c1);                                   \
        _Pragma("unroll") for (int dt = 0; dt < 4; ++dt) { const bf16_t* vp = VT + (size_t)(hk * 64 + dt * 16 + lq) * T; XV[dt][0] = *(const s16x4*)(vp + c0); XV[dt][1] = *(const s16x4*)(vp + c1); } } while (0)
    bf16x8 ka[2][2], kan[2][2]; s16x4 xv[4][2], xvn[4][2];
    SWA4_LOAD(ka, xv, 0);
#pragma unroll 1
    for (int st = 0; st < 5; ++st) {
        const int kb = t0 - 128 + st * 32;
        SWA4_LOAD(kan, xvn, st < 4 ? st + 1 : 4);
#pragma unroll
        for (int w = 0; w < 4; ++w) {
            f32x4 s0 = (f32x4){0.f, 0.f, 0.f, 0.f}, s1 = (f32x4){0.f, 0.f, 0.f, 0.f};
#pragma unroll
            for (int kk = 0; kk < 2; ++kk) { s0 = __builtin_amdgcn_mfma_f32_16x16x32_bf16(ka[kk][0], qf[w][kk], s0, 0, 0, 0); s1 = __builtin_amdgcn_mfma_f32_16x16x32_bf16(ka[kk][1], qf[w][kk], s1, 0, 0, 0); }
            float pv[8]; float mloc = -INFINITY;
#pragma unroll
            for (int i = 0; i < 4; ++i) {
                const int tk0 = kb + quad * 4 + i, tk1 = tk0 + 16, d0 = tq - tk0, d1 = tq - tk1;
                pv[i] = (tk0 >= 0 && d0 >= 0 && d0 < 128) ? s0[i] * sc2 - slope2[w] * (float)d0 : -INFINITY;
                pv[4 + i] = (tk1 >= 0 && d1 >= 0 && d1 < 128) ? s1[i] * sc2 - slope2[w] * (float)d1 : -INFINITY;
                mloc = fmaxf(mloc, fmaxf(pv[i], pv[4 + i]));
            }
            mloc = fmaxf(mloc, __shfl_xor(mloc, 16)); mloc = fmaxf(mloc, __shfl_xor(mloc, 32));
            const float mnew = fmaxf(m[w], mloc), alpha = exp2f(m[w] - mnew);
            m[w] = mnew;
            float ps = 0.f;
#pragma unroll
            for (int i = 0; i < 8; ++i) { pv[i] = exp2f(pv[i] - mnew); ps += pv[i]; }
            l[w] = l[w] * alpha + ps;
            u32x4 pw; pw.x = pg8::cvt_pk_bf16(pv[0], pv[1]); pw.y = pg8::cvt_pk_bf16(pv[2], pv[3]); pw.z = pg8::cvt_pk_bf16(pv[4], pv[5]); pw.w = pg8::cvt_pk_bf16(pv[6], pv[7]);
            const bf16x8 pb = __builtin_bit_cast(bf16x8, pw);
#pragma unroll
            for (int dt = 0; dt < 4; ++dt) { const s16x4 x0 = xv[dt][0], x1 = xv[dt][1];
                const bf16x8 va = (bf16x8){x0[0], x0[1], x0[2], x0[3], x1[0], x1[1], x1[2], x1[3]};
                o[w][dt] = __builtin_amdgcn_mfma_f32_16x16x32_bf16(va, pb, o[w][dt] * alpha, 0, 0, 0); }
        }
#pragma unroll
        for (int kk = 0; kk < 2; ++kk) { ka[kk][0] = kan[kk][0]; ka[kk][1] = kan[kk][1]; }
#pragma unroll
        for (int dt = 0; dt < 4; ++dt) { xv[dt][0] = xvn[dt][0]; xv[dt][1] = xvn[dt][1]; }
    }
#undef SWA4_LOAD
#pragma unroll
    for (int w = 0; w < 4; ++w) { float ls = l[w]; ls += __shfl_xor(ls, 16); ls += __shfl_xor(ls, 32); ls += exp2f(sink2[w] - m[w]);
        const float inv = 1.0f / ls;
#pragma unroll
        for (int dt = 0; dt < 4; ++dt) { u32x2 wv; wv.x = pg8::cvt_pk_bf16(o[w][dt][0] * inv, o[w][dt][1] * inv); wv.y = pg8::cvt_pk_bf16(o[w][dt][2] * inv, o[w][dt][3] * inv);
            *(u32x2*)(O + (size_t)tq * D + (hq0 + w) * 64 + dt * 16 + quad * 4) = wv; } }
}

__global__ void __launch_bounds__(NWAVES * 64, 2) mk_fwd(Args args) {
    extern __shared__ __attribute__((aligned(16))) unsigned char lds_raw[];
    LAS unsigned char* lds = (LAS unsigned char*)lds_raw;
    volatile LAS unsigned* MISC = (volatile LAS unsigned*)(lds + MISC_OFF);
    const int tid = threadIdx.x, lane = tid & 63, wave = __builtin_amdgcn_readfirstlane(tid >> 6);
    const int G = gridDim.x, bx = blockIdx.x;
    const int vcu = (G % 8 == 0) ? (bx % 8) * (G / 8) + bx / 8 : bx;
    const int gw = vcu * NWAVES + wave, NGW = G * NWAVES;
    unsigned char* const ws0 = args.ws;
    for (int u = tid; u < (LDS_BYTES - LDSCTL_OFF) / 4; u += NWAVES * 64) ((LAS unsigned*)(lds + LDSCTL_OFF))[u] = 0u;
    __syncthreads();
    XcdBarrier bar; { unsigned char* ws = ws0; bar = xcd_barrier_post(W_ctl + 4096, MISC + 8); }
#define GRID_BAR() do { XcdBarrier b_ = bar; { WS_FRESH(); b_.bar = W_ctl + 4096; b_.x = xb_xcc_id(); } xcd_barrier(b_); } while (0)
    const float* x_in = args.in[0]; const float* c_in = args.in[1]; const float* norm_g = args.in[2]; const float* ada_w = args.in[3]; const float* ada_b = args.in[4];
    const float* w_gate = args.in[5]; const float* w_up = args.in[6]; const float* w_down = args.in[7]; const float* moba_qkv = args.in[8]; const float* moba_o = args.in[9];
    const float* pool_w = args.in[10]; const float* pool_scale = args.in[11]; const float* swa_qkv = args.in[12]; const float* swa_o = args.in[13]; const float* swa_sinks = args.in[14];
    const float* final_g = args.in[15];

    {
        WS_FRESH();
        LAS float* scr = (LAS float*)(lds + RING_OFF + wave * 16384);
        constexpr int I_MOD = KSPLIT * DEPTH * 72, I_FFN = 5632, I_MQ = 32 * 192, I_MO = 32 * 64;
        constexpr int NITEMS = I_MOD + 2 * I_FFN;
        (void)I_MO; (void)I_MQ;
        for (int it = gw; it < NITEMS; it += NGW) {
            int r = it;
            if (r < I_MOD) { p0_mod_item(c_in, ada_w, W_modp, r, lane); continue; } r -= I_MOD;
            if (r < I_FFN) p0_transpose_item(w_gate, D, F, W_wgu, 1, 0, scr, r, lane);
            else p0_transpose_item(w_up, D, F, W_wgu, 2, 0, scr, r - I_FFN, lane);
        }
    }
    GRID_BAR();
    { WS_FRESH();
    for (int idx = (vcu * NWAVES * 64) + tid; idx < DEPTH * 3 * D; idx += G * NWAVES * 64) {
        const int c = idx % D, sub = idx / D, l = sub / 3, s = sub % 3;
        const size_t i0 = (size_t)l * NMOD + (3 * s) * D + c;
        float sh = ada_b[i0], sc = ada_b[i0 + D], gt = ada_b[i0 + 2 * D];
        for (int ks = 0; ks < KSPLIT; ++ks) { const float* mp = W_modp + (size_t)ks * DEPTH * NMOD + i0; sh += mp[0]; sc += mp[D]; gt += mp[2 * D]; }
        W_shv[idx] = sh; W_gs[idx] = norm_g[idx] * (1.f + sc);
        float cr = gt * (s == 1 ? 1.f : 0.5f); if (s == 1 && (l % 3) == 1) cr *= pool_scale[(l / 3) * D + c];
        W_cres[idx] = cr;
    } }
    GRID_BAR();
    { WS_FRESH();
    for (int sub = 0; sub < 1; ++sub) {
        const int l = sub / 3, s = sub % 3, kind = l % 3, j = l / 3;
        const bf16_t* Wt; int nrows;
        if (s != 1) { Wt = W_wgu + (size_t)(l * 2 + (s >> 1)) * F2 * D; nrows = F2; }
        else if (kind == 0) { Wt = W_mqkv + (size_t)j * 3 * D * D; nrows = 3 * D; }
        else if (kind == 2) { Wt = W_sqkv; nrows = 2560; }
        else { Wt = nullptr; nrows = 0; }
        const float* sh = W_shv + (size_t)sub * D;
        for (int n = gw; n < nrows; n += NGW) {
            float a = 0.f;
#pragma unroll
            for (int k = lane * 8; k < D; k += 512) {
                const bf16x8 wv = *(const bf16x8*)(Wt + ((size_t)((n >> 8) * (D / 64) + (k >> 6)) * 256 + (n & 255)) * 64 + (k & 63)); const f32x4 s0 = *(const f32x4*)(sh + k), s1 = *(const f32x4*)(sh + k + 4);
                a += s0[0] * bf2f((unsigned short)wv[0]) + s0[1] * bf2f((unsigned short)wv[1]) + s0[2] * bf2f((unsigned short)wv[2]) + s0[3] * bf2f((unsigned short)wv[3])
                   + s1[0] * bf2f((unsigned short)wv[4]) + s1[1] * bf2f((unsigned short)wv[5]) + s1[2] * bf2f((unsigned short)wv[6]) + s1[3] * bf2f((unsigned short)wv[7]);
            }
            a = wave_sum(a);
            if (lane == 0) W_bias[(size_t)sub * F2 + n] = a;
        }
    }
    for (int t = gw; t < T; t += NGW) {
        float ssq = 0.f;
#pragma unroll
        for (int c = lane * 4; c < D; c += 256) { const f32x4 v = *(const f32x4*)(x_in + (size_t)t * D + c); const f32x4 g = *(const f32x4*)(W_gs + c);
            ssq += (v[0] * v[0] + v[1] * v[1]) + (v[2] * v[2] + v[3] * v[3]);
            u32x2 o; o.x = pg8::cvt_pk_bf16(v[0] * g[0], v[1] * g[1]); o.y = pg8::cvt_pk_bf16(v[2] * g[2], v[3] * g[3]); *(u32x2*)(W_ap + ((size_t)((t >> 8) * (D / 64) + (c >> 6)) * 256 + (t & 255)) * 64 + (c & 63)) = o;
            u32x2 xo; xo.x = pg8::cvt_pk_bf16(v[0], v[1]); xo.y = pg8::cvt_pk_bf16(v[2], v[3]); *(u32x2*)(W_x + XIDX(t, c)) = xo; }
        ssq = wave_sum(ssq);
        if (lane < 32) W_ss[(size_t)t * 32 + lane] = lane == 0 ? ssq : 0.f;
    } }
    GRID_BAR();

    for (int sub = 0; sub < DEPTH * 3; ++sub) {
        WS_FRESH();
        const int l = sub / 3, s = sub % 3, kind = l % 3, j = l / 3;
        const bool hostsub = (G == 256) && (sub == 0 || sub == 2 || sub == 3 || sub == 5 || sub == 6 || sub == 8);
        const float* bias = W_bias + (size_t)sub * F2;
        const bf16_t* rA; const bf16_t* rB; int rK, rlda, rgrp, rtile = 0;
        if (s != 1) {
            const size_t wi = (size_t)(l * 2 + (s >> 1));
            const bool convwg = hostsub && bx >= G - 16;
            if (!convwg) {
                pg8::Gemm g{sub == 0 ? W_ap : W_x, W_wgu + wi * F2 * D, T, F2, D, D, 0, 1, 1}; pg8::StaticOrder S; S.init(T, F2, hostsub ? G - 16 : G, bx);
                pg8::EpiGU E{W_ss, bias, W_act};
                { FRESH_TID(); pg8::gemm_phase<pg8::EpiGU, pg8::StaticOrder, true>(lds + RING_OFF, g, S, E, ftid); }
            }
            rA = W_act; rB = W_wd + wi * D * F; rK = F; rlda = F; rgrp = 0; rtile = 1;
        } else if (kind == 0 || kind == 2) {
            const bool moba = (kind == 0);
            const bf16_t* Wt = moba ? W_mqkv + (size_t)j * 3 * D * D : W_sqkv; const int N = moba ? 3 * D : 2560;
            pg8::Gemm g{W_x, Wt, T, N, D, D, 0, 1, 1}; pg8::StaticOrder S; S.init(T, N, G, bx);
            pg8::EpiQKV E{W_ss, bias, W_qb, moba ? nullptr : W_vtb, moba ? W_kmp : nullptr, W_ctl + 12288 + j * 64, D, moba ? D : 256, moba ? 1 : 0};
            { FRESH_TID(); pg8::gemm_phase<pg8::EpiQKV, pg8::StaticOrder, true>(lds + RING_OFF, g, S, E, ftid); }
            GRID_BAR();
            if (moba) {
                FRESH_TID();
                LAS float* km = (LAS float*)(lds + RING_OFF + 67584);
                LAS unsigned* picks = (LAS unsigned*)(lds + RING_OFF + 84480);
                int item0 = vcu; asm volatile("" : "+s"(item0));
#pragma unroll 1
                for (int it = item0; it < 256; it += G)
#pragma unroll 1
                    for (int ps = 0; ps < 2; ++ps) {
                        const int h_ = it >> 4, y_ = it & 15, qb_ = ps ? 31 - y_ : y_;
                        const float* kmp_h = W_kmp + h_ * 128;
                        __syncthreads();
                        for (int e = ftid; e < qb_ * 32; e += NWAVES * 64) { const int n = e >> 5, d4 = (e & 31) * 4;
                            const f32x4 a = *(const f32x4*)(kmp_h + (size_t)n * D + d4), bq = *(const f32x4*)(kmp_h + (size_t)(32 + n) * D + d4);
                            *(LAS f32x4*)(km + n * 136 + (d4 >> 6) * 68 + (d4 & 63)) = a + bq; }
                        __syncthreads();
                        const int row = ftid >> 1, half = ftid & 1;
                        float q[64];
                        { const bf16_t* qp = W_qb + ((size_t)h_ * T + qb_ * 256 + row) * 128 + half * 64;
#pragma unroll
                          for (int i = 0; i < 8; ++i) { const bf16x8 v = *(const bf16x8*)(qp + i * 8);
#pragma unroll
                              for (int jj = 0; jj < 8; ++jj) q[i * 8 + jj] = bf2f((unsigned short)v[jj]); } }
                        float v0 = -INFINITY, v1 = -INFINITY, v2 = -INFINITY; int i0 = -1, i1 = -1, i2 = -1;
#pragma unroll 1
                        for (int n = 0; n < qb_; ++n) {
                            const LAS float* kp = km + n * 136 + half * 68;
                            float a0 = 0.f, a1 = 0.f, a2 = 0.f, a3 = 0.f;
#pragma unroll
                            for (int jj = 0; jj < 64; jj += 4) { const f32x4 kv = *(const LAS f32x4*)(kp + jj);
                                a0 += q[jj] * kv[0]; a1 += q[jj + 1] * kv[1]; a2 += q[jj + 2] * kv[2]; a3 += q[jj + 3] * kv[3]; }
                            float gsc = (a0 + a1) + (a2 + a3); gsc += __shfl_xor(gsc, 1);
                            if (gsc > v0) { v2 = v1; i2 = i1; v1 = v0; i1 = i0; v0 = gsc; i0 = n; }
                            else if (gsc > v1) { v2 = v1; i2 = i1; v1 = gsc; i1 = n; }
                            else if (gsc > v2) { v2 = gsc; i2 = n; }
                        }
                        {
                            float l1 = 0.f;
#pragma unroll
                            for (int i = 0; i < 64; ++i) l1 += fabsf(q[i]);
                            l1 += __shfl_xor(l1, 1);
                            const float kmaxv = __uint_as_float(__hip_atomic_load(W_ctl + 12288 + j * 64 + h_, __ATOMIC_RELAXED, __HIP_MEMORY_SCOPE_AGENT));
                            const float Bq = mb::SCALE * l1 * kmaxv * 1.02f, slope = exp2f(-(float)(h_ + 1) * 0.5f);
                            const float Dz = (2.f * Bq + 104.f) / slope, posf = (float)(qb_ * 256 + row - 255);
                            if (i0 >= 0 && posf - (float)(i0 * 256) > Dz) i0 = -1;
                            if (i1 >= 0 && posf - (float)(i1 * 256) > Dz) i1 = -1;
                            if (i2 >= 0 && posf - (float)(i2 * 256) > Dz) i2 = -1;
                        }
                        if (half == 0) { picks[row] = (unsigned)(i0 & 255) | ((unsigned)(i1 & 255) << 8) | ((unsigned)(i2 & 255) << 16);
                            int* lc = W_loc + ((size_t)h_ * T + qb_ * 256 + row) * 4;
                            if (i0 < 0) lc[0] = -1; if (i1 < 0) lc[1] = -1; if (i2 < 0) lc[2] = -1; }
                        __syncthreads();
#pragma unroll 1
                        for (int n = wave; n < qb_; n += NWAVES) {
                            int base = 0; int* sg = W_seg + (size_t)((h_ * 32 + n) * 32 + qb_) * 256;
#pragma unroll 1
                            for (int p4 = 0; p4 < 4; ++p4) { const int r = p4 * 64 + flane; const unsigned pk = picks[r];
                                const int sl = (pk & 255u) == (unsigned)n ? 0 : (((pk >> 8) & 255u) == (unsigned)n ? 1 : (((pk >> 16) & 255u) == (unsigned)n ? 2 : -1));
                                const unsigned long long bal = __ballot(sl >= 0);
                                const int rank = __popcll(bal & ((1ull << flane) - 1ull));
                                if (sl >= 0) sg[base + rank] = (qb_ * 256 + r) | (sl << 16);
                                base += __popcll(bal); }
                            if (flane == 0) W_cnt[(h_ * 32 + n) * 32 + qb_] = base;
                        }
                    }
                GRID_BAR();
            } else {
                FRESH_TID(); const int lane = flane;
#pragma unroll 1
                for (int u = gw; u < (T / 16) * 8; u += NGW) swa_attn_unit4(W_qb, W_kb, W_vtb, swa_sinks, W_ao, 4 * u, lane);
            }
            rA = W_ao; rB = moba ? W_mo + (size_t)j * D * D : W_so; rK = D; rlda = D; rgrp = 0;
        } else {
            const bf16_t* xc = W_x; const float* gsv = W_gs + (size_t)sub * D;
#define XLD4(p_) ({ const u32x2 q_ = *(const u32x2*)(p_); (f32x4){__builtin_bit_cast(float, q_.x << 16), __builtin_bit_cast(float, q_.x & 0xFFFF0000u), __builtin_bit_cast(float, q_.y << 16), __builtin_bit_cast(float, q_.y & 0xFFFF0000u)}; })
            LAS float* rtab = (LAS float*)(lds + RING_OFF);
            FRESH_TID(); const int tid = ftid;
            for (int un = vcu; un < T / 32; un += G) {
                const int r0 = un * 32;
                __syncthreads();
                if (tid < 47) { const int r = r0 - 15 + tid; float sv = 0.f;
                    if (r >= 0) { const f32x4* p = (const f32x4*)(W_ss + (size_t)r * 32);
#pragma unroll
                        for (int q = 0; q < 8; ++q) { const f32x4 v = p[q]; sv += (v[0] + v[1]) + (v[2] + v[3]); } }
                    rtab[tid] = 1.0f / sqrtf(sv * (1.0f / D) + EPS); }
                __syncthreads();
                const int c = tid * 4, wsz = 2 << (c >> 9);
                const f32x4 g4 = *(const f32x4*)(gsv + c);
                f32x4 sum = {0.f, 0.f, 0.f, 0.f};
#pragma unroll 5
                for (int r = r0 - wsz + 1; r < r0; ++r) if (r >= 0) sum += XLD4(xc + XIDX(r, c)) * rtab[r - r0 + 15];
#pragma unroll 1
                for (int rb = r0; rb < r0 + 32; rb += 8) {
                    f32x4 cur8[8], old8[8];
#pragma unroll
                    for (int i = 0; i < 8; ++i) { const int r = rb + i, lo = r - wsz + 1;
                        cur8[i] = XLD4(xc + XIDX(r, c));
                        old8[i] = lo >= 0 ? XLD4(xc + XIDX(lo, c)) : (f32x4){0.f, 0.f, 0.f, 0.f}; }
#pragma unroll
                    for (int i = 0; i < 8; ++i) { const int r = rb + i, lo = r - wsz + 1;
                        const f32x4 cur = cur8[i] * rtab[r - r0 + 15];
                        sum += cur;
                        const float icnt = 1.0f / (float)(lo < 0 ? r + 1 : wsz);
                        const f32x4 pv = g4 * (sum * icnt - cur);
                        u32x2 o; o.x = pg8::cvt_pk_bf16(pv[0], pv[1]); o.y = pg8::cvt_pk_bf16(pv[2], pv[3]); *(u32x2*)(W_ao + (size_t)r * D + c) = o;
                        if (lo >= 0) sum -= old8[i] * rtab[lo - r0 + 15]; }
                }
            }
#undef XLD4
            rA = W_ao; rB = W_pw; rK = 512; rlda = D; rgrp = 1;
        }
        const bool mobasub = (s == 1 && kind == 0);
        const bool hasq = (sub == 1) || (G != 256 && sub == 10);
        const bool roleA = !hasq || (vcu & 1) == 0;
#pragma unroll 1
        for (int st = 0; st < 2; ++st) {
        if (mobasub && ((st == 0) == roleA)) {
            FRESH_TID();
            char* ldsg = (char*)lds_raw + RING_OFF;
            char* ctl = (char*)lds_raw + LDSCTL_OFF;
            int* rowtab = (int*)(ctl + 8192);
            int* cq = (int*)(ctl + 10240);
            LAS int* bc = (LAS int*)(lds + LDSCTL_OFF + 10368);
            LAS int* nrow_t = (LAS int*)(lds + LDSCTL_OFF + 10496);
            LAS int* ist_t = (LAS int*)(lds + LDSCTL_OFF + 12544);
            float* wscr = (float*)(ctl + 14848);
            __syncthreads();
            {
                const int hn = ftid, n = hn & 31; int tot = 0; const int* cp = W_cnt + hn * 32;
#pragma unroll
                for (int qx = 0; qx < 32; ++qx) { const int c = cp[qx]; tot += (qx > n) ? c : 0; }
                nrow_t[hn] = tot; const int nch = (256 + tot + 511) >> 9;
                int sc = nch;
#pragma unroll
                for (int o = 1; o < 64; o <<= 1) { const int v = __shfl_up(sc, o); if (flane >= o) sc += v; }
                if (flane == 63) bc[wave] = sc;
                __syncthreads();
                int woff = 0;
#pragma unroll
                for (int w = 0; w < NWAVES; ++w) woff += (w < wave) ? bc[w] : 0;
                ist_t[hn] = woff + sc - nch;
                if (ftid == NWAVES * 64 - 1) ist_t[512] = woff + sc;
            }
            unsigned* actr = W_ctl + 8192 + 512 + j * 32;
            if (ftid == 0) bc[8] = (int)__hip_atomic_fetch_add(actr, 1u, __ATOMIC_RELAXED, __HIP_MEMORY_SCOPE_AGENT);
            __syncthreads();
            const int NU = __builtin_amdgcn_readfirstlane(ist_t[512]);
#pragma unroll 1
            for (;;) {
                const int unit = __builtin_amdgcn_readfirstlane(bc[8]);
                if (unit >= NU) break;
                int lo = 0, hi = 512;
#pragma unroll 1
                while (hi - lo > 1) { const int mid = (lo + hi) >> 1; if (ist_t[mid] <= unit) lo = mid; else hi = mid; }
                const int hn = __builtin_amdgcn_readfirstlane(lo), c = unit - __builtin_amdgcn_readfirstlane(ist_t[hn]);
                const int h_ = hn >> 5, n_ = hn & 31;
                int pend = NU; if (ftid == 0) pend = (int)__hip_atomic_fetch_add(actr, 1u, __ATOMIC_RELAXED, __HIP_MEMORY_SCOPE_AGENT);
                mb::UnitRef u;
                u.Q = W_qb + (size_t)h_ * T * 128; u.K = W_kb + (size_t)h_ * T * 128; u.V = W_vb + (size_t)h_ * T * 128;
                u.O = W_part + (size_t)unit * 512 * 128; u.ML = W_ml + (size_t)unit * 1024; u.LOC = W_loc + (size_t)h_ * T * 4;
                u.seg = W_seg + (size_t)hn * 32 * 256; u.cnt = W_cnt + hn * 32;
                u.ab = exp2f(-(float)(h_ + 1) * 0.5f) * (1.0f / mb::SCALE); u.n = n_; u.c = c; u.L = __builtin_amdgcn_readfirstlane(nrow_t[hn]); u.unit512 = unit * 512;
                mb::moba_unit(u, ldsg, rowtab, cq, wscr, (int*)(ctl + 10368 + 32), pend, wave);
            }
        }
        if ((st == 0 && (hostsub || (G != 256 && sub == 0))) || (mobasub && hasq && ((st == 0) != roleA))) {
                        constexpr int DQ_MO0 = 2048, DQ_FFN = 21 * 5632, DQ_MQ = 6144, DQ_MO = 2048, DQ_PW = 512, DQ_SQ = 2560, DQ_SO = 2048, DQ_N = DQ_MO0 + DQ_FFN + DQ_MQ + DQ_MO + DQ_PW + DQ_SQ + DQ_SO;
                        static_assert(DQ_N % 8 == 0, "whole chunks");
                        constexpr int DQ_WD0 = 5632, DQ_MQ0 = 6144, DQ_EARLY = DQ_WD0 + DQ_MQ0;
                        constexpr int DQ_LATE = 3 * 5632, DQ_LATE0 = DQ_MO0 + 18 * 5632;
                        static_assert(DQ_LATE % 8 == 0 && (DQ_N - DQ_LATE) % 8 == 0, "whole chunks");
                        constexpr int DQ_F0 = DQ_MO0, DQ_AFT = DQ_MO0 + DQ_FFN;
                        int s0, n0, s1 = 0, n1 = 0;
                        if (G != 256) { if (sub == 0) { s0 = DQ_N; n0 = DQ_EARLY; } else if (sub == 1) { s0 = 0; n0 = DQ_LATE0; s1 = DQ_LATE0 + DQ_LATE; n1 = DQ_N - s1; } else { s0 = DQ_LATE0; n0 = DQ_LATE; } }
                        else if (sub == 0) { s0 = DQ_N; n0 = DQ_EARLY; }
                        else if (sub == 1) { s0 = 0; n0 = DQ_F0 + 9 * 5632; s1 = DQ_AFT + DQ_MQ + DQ_MO; n1 = DQ_PW; }
                        else if (sub == 2) { s0 = DQ_F0 + 9 * 5632; n0 = 3 * 5632; }
                        else if (sub == 3) { s0 = DQ_AFT + DQ_MQ + DQ_MO + DQ_PW; n0 = DQ_SQ + DQ_SO; s1 = DQ_F0 + 12 * 5632; n1 = 2 * 5632; }
                        else if (sub == 5) { s0 = DQ_F0 + 14 * 5632; n0 = 3 * 5632; }
                        else if (sub == 6) { s0 = DQ_F0 + 17 * 5632; n0 = 5632; s1 = DQ_AFT; n1 = DQ_MQ + DQ_MO; }
                        else { s0 = DQ_LATE0; n0 = DQ_LATE; }
                        const int nchunks = (n0 + n1) / 8;
                        unsigned* qctr = W_ctl + 8192 + sub * 32;
                        FRESH_TID(); __syncthreads();
                        float* bpp = W_biasp;
                        constexpr int DQ_C = 8;
#define DQ_DESC(Dd, r_) do { int r = (r_); r = r < n0 ? s0 + r : s1 + (r - n0); Dd.sh = nullptr; Dd.bp = bpp; Dd.roff = 0; Dd.mode = 0;                           \
        if (r < DQ_MO0) { Dd.W = moba_o; Dd.WT = W_mo; Dd.N = D; Dd.KT = D / 64; Dd.kb = r / (D / 32); Dd.nb = r % (D / 32); } else { r -= DQ_MO0;                                         \
        if (r < DQ_FFN) { const int mi = r / 5632, ri = r % 5632, wi = 1 + mi / 3, typ = mi % 3; const int sb = (wi >> 1) * 3 + ((wi & 1) ? 2 : 0);                                         \
            if (typ == 2) { Dd.W = w_down + (size_t)wi * F * D; Dd.WT = W_wd + (size_t)wi * D * F; Dd.N = D; Dd.KT = F / 64; Dd.kb = ri / (D / 32); Dd.nb = ri % (D / 32); }                \
            else { Dd.W = (typ == 0 ? w_gate : w_up) + (size_t)wi * D * F; Dd.WT = W_wgu + (size_t)wi * F2 * D; Dd.N = F; Dd.KT = D / 64; Dd.kb = ri / (F / 32); Dd.nb = ri % (F / 32);     \
                   Dd.mode = 1 + typ; Dd.sh = W_shv + (size_t)sb * D; Dd.bp = bpp + (size_t)sb * F2; }                                                                                        \
        } else { r -= DQ_FFN; Dd.KT = D / 64;                                                                                                                                              \
          if (r < DQ_MQ) { Dd.W = moba_qkv + (size_t)D * 3 * D; Dd.WT = W_mqkv + (size_t)3 * D * D; Dd.N = 3 * D; Dd.kb = r / (3 * D / 32); Dd.nb = r % (3 * D / 32); Dd.sh = W_shv + (size_t)10 * D; Dd.bp = bpp + (size_t)10 * F2; } \
          else { r -= DQ_MQ;                                                                                                                                                               \
          if (r < DQ_MO) { Dd.W = moba_o + (size_t)D * D; Dd.WT = W_mo + (size_t)D * D; Dd.N = D; Dd.kb = r / (D / 32); Dd.nb = r % (D / 32); }                                            \
          else { r -= DQ_MO;                                                                                                                                                               \
          if (r < DQ_PW) { const int g = r / 128, ri = r % 128; Dd.W = pool_w + (size_t)g * 512 * 512; Dd.WT = W_pw; Dd.N = 512; Dd.KT = 512 / 64; Dd.roff = g * 512; Dd.kb = ri / 16; Dd.nb = ri % 16; } \
          else { r -= DQ_PW;                                                                                                                                                               \
          if (r < DQ_SQ) { Dd.W = swa_qkv; Dd.WT = W_sqkv; Dd.N = 2560; Dd.kb = r / 80; Dd.nb = r % 80; Dd.sh = W_shv + (size_t)7 * D; Dd.bp = bpp + (size_t)7 * F2; }                      \
          else { r -= DQ_SQ;                                                                                                                                                               \
          if (r < DQ_SO) { Dd.W = swa_o; Dd.WT = W_so; Dd.N = D; Dd.kb = r / (D / 32); Dd.nb = r % (D / 32); }                                                                             \
          else { r -= DQ_SO;                                                                                                                                                               \
          if (r < DQ_WD0) { Dd.W = w_down; Dd.WT = W_wd; Dd.N = D; Dd.KT = F / 64; Dd.kb = r / (D / 32); Dd.nb = r % (D / 32); }                                                           \
          else { r -= DQ_WD0; Dd.W = moba_qkv; Dd.WT = W_mqkv; Dd.N = 3 * D; Dd.kb = r / (3 * D / 32); Dd.nb = r % (3 * D / 32); Dd.sh = W_shv + (size_t)D; Dd.bp = bpp + (size_t)F2; } } } } } } } } } while (0)
                        unsigned zoff = 0u; asm volatile("" : "+v"(zoff));
                        int chunk_v = 0; if (flane == 0) chunk_v = (int)__hip_atomic_fetch_add(qctr + zoff, 1u, __ATOMIC_RELAXED, __HIP_MEMORY_SCOPE_AGENT);
                        int chunk_nx = __builtin_amdgcn_readfirstlane(chunk_v), chunk = 0, k8 = DQ_C; bool pend = false;
#define DQ_NEXT(have_, r_) do { if (k8 == DQ_C) { chunk = chunk_nx; k8 = 0;                                                                                                              \
            if (chunk < nchunks) { if (flane == 0) chunk_v = (int)__hip_atomic_fetch_add(qctr + zoff, 1u, __ATOMIC_RELAXED, __HIP_MEMORY_SCOPE_AGENT); pend = true; } }                    \
        have_ = chunk < nchunks; r_ = chunk * DQ_C + k8; ++k8; } while (0)
#define DQ_CAPTURE() do { if (pend) { chunk_nx = __builtin_amdgcn_readfirstlane(chunk_v); pend = false; } } while (0)
                        bool haveA, haveB; int rA, rB;
                        LAS unsigned char* cb0 = lds + RING_OFF + wave * 16384; LAS unsigned char* cb1 = cb0 + 8192;
                        LAS unsigned char* sb0 = lds + LDSCTL_OFF + 4096 + wave * 512; LAS unsigned char* sb1 = sb0 + 256;
#define DQ_ISSUE(r_, b_, s_) do { int rr_ = __builtin_amdgcn_readfirstlane(r_); asm volatile("" : "+s"(rr_)); CvtD d_; DQ_DESC(d_, rr_); cvt_issue(d_, flane, b_, s_); } while (0)
#define DQ_FIN(r_, b_, s_) do { int rr_ = __builtin_amdgcn_readfirstlane(r_); asm volatile("" : "+s"(rr_)); CvtD d_; DQ_DESC(d_, rr_); cvt_fin(d_, flane, b_, s_); } while (0)
#define DQ_STEP(have_, r_, b_, s_) do { if (have_) { DQ_ISSUE(r_, b_, s_); asm volatile("s_waitcnt vmcnt(8)" ::: "memory"); DQ_CAPTURE(); } else asm volatile("s_waitcnt vmcnt(0)" ::: "memory"); } while (0)
                        DQ_NEXT(haveA, rA);
                        if (haveA) DQ_ISSUE(rA, cb0, sb0);
                        while (haveA) {
                            DQ_NEXT(haveB, rB);
                            DQ_STEP(haveB, rB, cb1, sb1); DQ_FIN(rA, cb0, sb0);
                            if (!haveB) break;
                            DQ_NEXT(haveA, rA);
                            DQ_STEP(haveA, rA, cb0, sb0); DQ_FIN(rB, cb1, sb1);
                        }
#undef DQ_ISSUE
#undef DQ_FIN
#undef DQ_STEP
#undef DQ_CAPTURE
#undef DQ_DESC
#undef DQ_NEXT
        }
        }
        if (mobasub) {
            GRID_BAR();
            FRESH_TID();
            constexpr float C2 = 1.4426950408889634f * mb::SCALE;
            const int l16 = ftid & 15;
#pragma unroll 1
            for (int rb = vcu * 128 + (ftid >> 4); rb < 16 * T; rb += G * 128) {
                u32x4 lc[4];
#pragma unroll
                for (int k = 0; k < 4; ++k) lc[k] = *(const u32x4*)(W_loc + (size_t)(rb + 32 * k) * 4);
                float mm[4][4], ll[4][4]; bf16x8 pv[4][4];
#pragma unroll
                for (int k = 0; k < 4; ++k)
#pragma unroll
                    for (int sl = 0; sl < 4; ++sl) { const int li = (int)lc[k][sl]; const bool ok = li >= 0; const int lx = ok ? li : 0;
                        const float2 ml = *(const float2*)(W_ml + (size_t)lx * 2); mm[k][sl] = ok ? ml.x : -1e30f; ll[k][sl] = ok ? ml.y : 0.f;
                        const bf16x8 pl = *(const bf16x8*)(W_part + (size_t)lx * 128 + l16 * 8); pv[k][sl] = ok ? pl : (bf16x8){0, 0, 0, 0, 0, 0, 0, 0}; }
#pragma unroll
                for (int k = 0; k < 4; ++k) {
                    const int rix = rb + 32 * k, h_ = rix >> 13, t = rix & (T - 1);
                    const float M = fmaxf(fmaxf(mm[k][0], mm[k][1]), fmaxf(mm[k][2], mm[k][3]));
                    float w[4], den = 0.f;
#pragma unroll
                    for (int sl = 0; sl < 4; ++sl) { w[sl] = ll[k][sl] * __builtin_amdgcn_exp2f((mm[k][sl] - M) * C2); den += w[sl]; }
                    const float inv = 1.0f / den;
                    float o[8];
#pragma unroll
                    for (int e = 0; e < 8; ++e) o[e] = ((w[0] * bf2f((unsigned short)pv[k][0][e]) + w[1] * bf2f((unsigned short)pv[k][1][e])) + (w[2] * bf2f((unsigned short)pv[k][2][e]) + w[3] * bf2f((unsigned short)pv[k][3][e]))) * inv;
                    u32x4 ov; ov.x = pg8::cvt_pk_bf16(o[0], o[1]); ov.y = pg8::cvt_pk_bf16(o[2], o[3]); ov.z = pg8::cvt_pk_bf16(o[4], o[5]); ov.w = pg8::cvt_pk_bf16(o[6], o[7]);
                    *(u32x4*)(W_ao + (size_t)t * D + h_ * 128 + l16 * 8) = ov;
                }
            }
        }
        GRID_BAR();
        if (sub <= 3 || sub == 5 || sub == 6 || sub == 8 || sub == 10) {
            FRESH_TID();
            int sb0, nsb;
            if (G != 256) { sb0 = sub == 0 ? 1 : (sub == 1 ? 2 : 11); nsb = sub == 1 ? 9 : (sub == 0 || sub == 10 ? 1 : 0); }
            else if (sub == 0) { sb0 = 1; nsb = 1; } else if (sub == 1) { sb0 = 2; nsb = 4; } else if (sub == 2) { sb0 = 6; nsb = 1; } else if (sub == 3) { sb0 = 7; nsb = 2; }
            else if (sub == 5) { sb0 = 9; nsb = 1; } else if (sub == 6) { sb0 = 10; nsb = 1; } else if (sub == 8) { sb0 = 11; nsb = 1; } else { sb0 = 0; nsb = 0; }
            for (int idx = vcu * (NWAVES * 64) + ftid; idx < nsb * F2; idx += G * (NWAVES * 64)) {
                const int sb = sb0 + idx / F2, n = idx % F2, s_ = sb % 3, kind_ = (sb / 3) % 3;
                const int nrows = s_ != 1 ? F2 : (kind_ == 0 ? 3 * D : (kind_ == 2 ? 2560 : 0));
                if (n < nrows) { float a = 0.f;
#pragma unroll 8
                    for (int kb = 0; kb < 32; ++kb) a += W_biasp[(size_t)kb * (DEPTH * 3 * F2) + (size_t)sb * F2 + n];
                    W_bias[(size_t)sb * F2 + n] = a; }
            }
        }
        {
            pg8::Gemm g{rA, rB, T, D, rK, rlda, rgrp, rtile, 1}; pg8::StaticOrder S; S.init(T, D, G, bx);
            pg8::EpiRes E{W_x, W_cres + (size_t)sub * D, W_ss};
            { FRESH_TID(); pg8::gemm_phase<pg8::EpiRes, pg8::StaticOrder, true>(lds + RING_OFF, g, S, E, ftid); }
        }
        GRID_BAR();
    }
    { WS_FRESH(); FRESH_TID(); const int lane = flane;
    for (int t = gw; t < T; t += NGW) {
        float sv = lane < 32 ? W_ss[(size_t)t * 32 + lane] : 0.f; sv = wave_sum(sv);
        const float rstd = 1.0f / sqrtf(sv * (1.0f / D) + EPS);
#pragma unroll
        for (int c = lane * 4; c < D; c += 256) { const u32x2 q_ = *(const u32x2*)(W_x + XIDX(t, c)); const f32x4 g = *(const f32x4*)(final_g + c);
            const f32x4 v = {__builtin_bit_cast(float, q_.x << 16), __builtin_bit_cast(float, q_.x & 0xFFFF0000u), __builtin_bit_cast(float, q_.y << 16), __builtin_bit_cast(float, q_.y & 0xFFFF0000u)};
            *(f32x4*)(args.out + (size_t)t * D + c) = v * rstd * g; }
    } }
#undef GRID_BAR
}

extern "C" void kernel_launch(void* const* d_in, const int* in_sizes, int n_in, void* d_out, int out_size, void* d_ws, size_t ws_size, hipStream_t stream) {
    static int grid = 0;
    Args a{};
    const size_t need = WS_NEED;
    if (grid == 0) {
        if (n_in != 16 || in_sizes[0] != T * D || out_size != T * D || ws_size < need) { fprintf(stderr, "kernel_launch: unexpected shapes / workspace (need %zu, have %zu)\n", need, ws_size); grid = -1; return; }
        int dev = 0, cus = 0, per_cu = 0;
        if (hipGetDevice(&dev) != hipSuccess || hipDeviceGetAttribute(&cus, hipDeviceAttributeMultiprocessorCount, dev) != hipSuccess) { grid = -1; return; }
        if (hipFuncSetAttribute((const void*)mk_fwd, hipFuncAttributeMaxDynamicSharedMemorySize, LDS_BYTES) != hipSuccess) { fprintf(stderr, "kernel_launch: hipFuncSetAttribute failed\n"); grid = -1; return; }
        if (hipOccupancyMaxActiveBlocksPerMultiprocessor(&per_cu, (const void*)mk_fwd, NWAVES * 64, LDS_BYTES) != hipSuccess || per_cu < 1) { fprintf(stderr, "kernel_launch: occupancy query reports %d\n", per_cu); }
        (void)hipGetLastError();
        grid = cus;
    }
    if (grid < 0) return;
    (void)hipMemsetAsync((unsigned char*)d_ws + O_ctl, 0, CTL_BYTES, stream);
    for (int i = 0; i < 16; ++i) a.in[i] = (const float*)d_in[i];
    a.out = (float*)d_out; a.ws = (unsigned char*)d_ws;
    hipLaunchKernelGGL(mk_fwd, dim3(grid), dim3(NWAVES * 64), LDS_BYTES, stream, a);
}
```

```cpp
#include <hip/hip_runtime.h>
#include <cstdio>
#include <cstdint>
#include <cmath>

constexpr int T = 8192, D = 2048, F = 5632, F2 = 11264, DEPTH = 4, NMOD = 9 * 2048;
constexpr float EPS = 1e-6f;
constexpr float LOG2E = 1.4426950408889634f;

namespace pg8 {
#define PG8_LAS __attribute__((address_space(3)))
typedef unsigned short bf16_t;
typedef short bf16x8 __attribute__((ext_vector_type(8)));
typedef float f32x4 __attribute__((ext_vector_type(4)));
typedef unsigned u32x4 __attribute__((ext_vector_type(4)));
typedef unsigned u32x2 __attribute__((ext_vector_type(2)));
constexpr int BM = 256, BK = 64, HALF = 128, HTB = HALF * BK * 2  , STAGE_BYTES = 8 * HTB, NXCD = 8, WGM = 8;

__host__ __device__ __forceinline__ int lds_byte(int r, int c) { const int st = (r >> 4) * 2 + (c >> 5), rr = r & 15, cc = c & 31, ob = rr * 64 + cc * 2; return st * 1024 + (ob ^ (((ob >> 9) & 1) << 5)); }
__host__ __device__ __forceinline__ void stage_rc(int b, int& R, int& C) { const int st = b / 1024, sb = b % 1024, swz = sb ^ (((sb >> 9) & 1) << 5); R = (st >> 1) * 16 + swz / 64; C = (st & 1) * 32 + (swz % 64) / 2; }
__host__ __device__ __forceinline__ int perm32(int rho) { const int n = rho >> 4, i = rho & 15; return 8 * (i >> 2) + 4 * n + (i & 3); }

struct Unit { int pm, pn; };
struct Gemm { const bf16_t* A; const bf16_t* Bt; int M, N, K, lda, grouped, ta, tb; };

struct StaticOrder {
    int nM, nN, nwg, G, c;
    __host__ __device__ void init(int M, int N, int G_, int c_) { nM = M / BM; nN = N / BM; nwg = nM * nN; G = G_; c = c_; }
    __host__ __device__ bool next(int i, Unit& u) const {
        const long L = (long)i * G + c; if (L >= nwg) return false;
        int wgid = (int)L; { const int q = nwg / NXCD, r = nwg % NXCD, xcd = wgid % NXCD, off = wgid / NXCD; wgid = (xcd < r ? xcd * (q + 1) : r * (q + 1) + (xcd - r) * q) + off; }
        const int nig = WGM * nN, gid = wgid / nig, fm = gid * WGM, gsz = (nM - fm) < WGM ? (nM - fm) : WGM;
        u.pm = fm + ((wgid % nig) % gsz); u.pn = (wgid % nig) / gsz; return true;
    }
    __device__ __forceinline__ void a_ready(const Unit&) const {}
    __device__ __forceinline__ void done(const Unit&) const {}
};

typedef float f32x2_t __attribute__((ext_vector_type(2))); typedef __bf16 bf16x2_t __attribute__((ext_vector_type(2)));
__device__ __forceinline__ unsigned cvt_pk_bf16(float lo, float hi) { const f32x2_t v = {lo, hi}; const bf16x2_t b = __builtin_convertvector(v, bf16x2_t); return __builtin_bit_cast(unsigned, b); }

__device__ __forceinline__ void load_rstd(const float* ss, int rowb, int fq, float (&rs)[2][4]) {
#pragma unroll
    for (int ai = 0; ai < 2; ++ai)
#pragma unroll
        for (int m = 0; m < 4; ++m) {
            const f32x4* p = (const f32x4*)(ss + (size_t)(rowb + ai * HALF + m * 16) * 32 + fq * 8);
            const f32x4 a = p[0], b = p[1];
            float s = ((a[0] + a[1]) + (a[2] + a[3])) + ((b[0] + b[1]) + (b[2] + b[3]));
            s += __shfl_xor(s, 16); s += __shfl_xor(s, 32);
            rs[ai][m] = __builtin_amdgcn_rsqf(s * (1.0f / D) + EPS);
        }
}
__device__ __forceinline__ float silu_mul(float g, float u) { return g * __builtin_amdgcn_rcpf(1.0f + __expf(-g)) * u; }

struct EpiGU {
    static constexpr bool PERM = true, AFTER_DRAIN = false;
    const float* rtab; const float* btab; bf16_t* act;
    __device__ __forceinline__ void operator()(const f32x4 (&acc)[2][2][4][2], const Unit& u, int wr, int wc, int fr, int fq, int ui) const {
        const int cb = u.pn * BM + wc * 32 + 8 * fq, jcol = u.pn * HALF + wc * 32 + 8 * fq;
        (void)cb;
        f32x4 bg[2], bu[2];
        const float* bt = btab + ui * 256 + wc * 32 + 8 * fq;
#pragma unroll
        for (int n = 0; n < 2; ++n) { bg[n] = *(const f32x4*)(bt + 4 * n); bu[n] = *(const f32x4*)(bt + HALF + 4 * n); }
        float rs[2][4];
#pragma unroll
        for (int ai = 0; ai < 2; ++ai)
#pragma unroll
            for (int m = 0; m < 4; ++m) rs[ai][m] = rtab[ui * 256 + ai * HALF + wr * 64 + m * 16 + fr];
#pragma unroll
        for (int ai = 0; ai < 2; ++ai)
#pragma unroll
            for (int m = 0; m < 4; ++m) {
                const float r = rs[ai][m]; const int row = u.pm * BM + ai * HALF + wr * 64 + m * 16 + fr;
                float g[8], v[8], e[8];
#pragma unroll
                for (int n = 0; n < 2; ++n)
#pragma unroll
                    for (int i = 0; i < 4; ++i) { g[n * 4 + i] = fmaf(acc[ai][0][m][n][i], r, bg[n][i]); v[n * 4 + i] = fmaf(acc[ai][1][m][n][i], r, bu[n][i]); }
#pragma unroll
                for (int i = 0; i < 8; ++i) e[i] = __builtin_amdgcn_exp2f(g[i] * (-LOG2E));
#pragma unroll
                for (int i = 0; i < 8; ++i) e[i] = __builtin_amdgcn_rcpf(1.0f + e[i]);
#pragma unroll
                for (int i = 0; i < 8; ++i) e[i] = (g[i] * e[i]) * v[i];
                u32x4 w; w.x = cvt_pk_bf16(e[0], e[1]); w.y = cvt_pk_bf16(e[2], e[3]); w.z = cvt_pk_bf16(e[4], e[5]); w.w = cvt_pk_bf16(e[6], e[7]);
                *(u32x4*)(act + ((size_t)((row >> 8) * (F / 64) + (jcol >> 6)) * 256 + (row & 255)) * 64 + (jcol & 63)) = w;
            }
    }
};
struct EpiRes {
    static constexpr bool PERM = true, AFTER_DRAIN = false;
    bf16_t* x; const float* cres; float* ss;
    __device__ __forceinline__ void operator()(const f32x4 (&acc)[2][2][4][2], const Unit& u, int wr, int wc, int fr, int fq, int ui) const {
        const int col0 = u.pn * BM + wc * 32 + 8 * fq;
        const size_t off0 = ((size_t)(u.pm * (D / 64) + (col0 >> 6)) * 256 + wr * 64 + fr) * 64 + (col0 & 63);
        f32x4 cr[2][2];
#pragma unroll
        for (int bj = 0; bj < 2; ++bj)
#pragma unroll
            for (int n = 0; n < 2; ++n) cr[bj][n] = *(const f32x4*)(cres + col0 + bj * HALF + n * 4);
        u32x4 xb[3][2];
#define EPIRES_OFF(g, bj) (off0 + (size_t)(((g) >> 2) * HALF + ((g) & 3) * 16) * 64 + (size_t)(bj) * (2 * 256 * 64))
#define EPIRES_LOAD(buf, g) do { _Pragma("unroll") for (int bj = 0; bj < 2; ++bj) xb[buf][bj] = *(const u32x4*)(x + EPIRES_OFF(g, bj)); } while (0)
        EPIRES_LOAD(0, 0); EPIRES_LOAD(1, 1); EPIRES_LOAD(2, 2);
#pragma unroll
        for (int g = 0; g < 8; ++g) {
            const int ai = g >> 2, m = g & 3;
            const int row_ = u.pm * BM + ai * HALF + wr * 64 + m * 16 + fr;
            float sq = 0.f;
#pragma unroll
            for (int bj = 0; bj < 2; ++bj) {
                u32x4 xs;
#pragma unroll
                for (int n = 0; n < 2; ++n) {
                    const unsigned p0 = xb[g % 3][bj][2 * n], p1 = xb[g % 3][bj][2 * n + 1];
                    const f32x4 xo = {__builtin_bit_cast(float, p0 << 16), __builtin_bit_cast(float, p0 & 0xFFFF0000u), __builtin_bit_cast(float, p1 << 16), __builtin_bit_cast(float, p1 & 0xFFFF0000u)};
                    const f32x4 xn = xo + cr[bj][n] * acc[ai][bj][m][n];
                    sq += (xn[0] * xn[0] + xn[1] * xn[1]) + (xn[2] * xn[2] + xn[3] * xn[3]);
                    if (n == 0) { xs.x = cvt_pk_bf16(xn[0], xn[1]); xs.y = cvt_pk_bf16(xn[2], xn[3]); } else { xs.z = cvt_pk_bf16(xn[0], xn[1]); xs.w = cvt_pk_bf16(xn[2], xn[3]); }
                }
                *(u32x4*)(x + EPIRES_OFF(g, bj)) = xs;
            }
            sq += __shfl_xor(sq, 16); sq += __shfl_xor(sq, 32);
            if (fq == 0) ss[(size_t)row_ * 32 + u.pn * 4 + wc] = sq;
            if (g + 3 < 8) EPIRES_LOAD(g % 3, g + 3);
        }
#undef EPIRES_LOAD
#undef EPIRES_OFF
    }
};
struct EpiQKV {
    static constexpr bool PERM = true, AFTER_DRAIN = false;
    const float* ss; const float* bias; bf16_t* qkv; bf16_t* vt; float* kmp; unsigned* kmax; int nq, nk, hm;
    __device__ __forceinline__ void operator()(const f32x4 (&acc)[2][2][4][2], const Unit& u, int wr, int wc, int fr, int fq, int ui) const {
        const int ct = u.pn * BM; const int cb = ct + wc * 32 + 8 * fq;
        f32x4 bv[2][2];
#pragma unroll
        for (int bj = 0; bj < 2; ++bj)
#pragma unroll
            for (int n = 0; n < 2; ++n) bv[bj][n] = *(const f32x4*)(bias + cb + bj * HALF + 4 * n);
        float rs[2][4]; load_rstd(ss, u.pm * BM + wr * 64 + fr, fq, rs);
        asm volatile("" : "+v"(bv[0][0]), "+v"(bv[0][1]), "+v"(bv[1][0]), "+v"(bv[1][1]));
        const int region = ct < nq ? 0 : (ct < nq + nk ? 1 : 2);
        bf16_t* base = qkv + (size_t)region * ((size_t)T * D); const int ld = region == 0 ? nq : nk;
        const int lc = cb - (region == 0 ? 0 : (region == 1 ? nq : nq + nk));
        const bool do_km = (region == 1) && (kmp != nullptr), do_vt = (region == 2) && (vt != nullptr);
        f32x4 csum[2][2];
#pragma unroll
        for (int bj = 0; bj < 2; ++bj)
#pragma unroll
            for (int n = 0; n < 2; ++n) csum[bj][n] = (f32x4){0.f, 0.f, 0.f, 0.f};
        float kmx[2] = {0.f, 0.f};
#pragma unroll
        for (int ai = 0; ai < 2; ++ai)
#pragma unroll
            for (int m = 0; m < 4; ++m) {
                const float r = rs[ai][m]; const int row = u.pm * BM + ai * HALF + wr * 64 + m * 16 + fr;
#pragma unroll
                for (int bj = 0; bj < 2; ++bj) {
                    const f32x4 v0 = acc[ai][bj][m][0] * r + bv[bj][0], v1 = acc[ai][bj][m][1] * r + bv[bj][1];
                    csum[bj][0] += v0; csum[bj][1] += v1;
                    if (do_km) kmx[bj] = fmaxf(kmx[bj], fmaxf(fmaxf(fmaxf(fabsf(v0[0]), fabsf(v0[1])), fmaxf(fabsf(v0[2]), fabsf(v0[3]))), fmaxf(fmaxf(fabsf(v1[0]), fabsf(v1[1])), fmaxf(fabsf(v1[2]), fabsf(v1[3])))));
                    u32x4 w; w.x = cvt_pk_bf16(v0[0], v0[1]); w.y = cvt_pk_bf16(v0[2], v0[3]); w.z = cvt_pk_bf16(v1[0], v1[1]); w.w = cvt_pk_bf16(v1[2], v1[3]);
                    if (hm) *(u32x4*)(base + ((size_t)((lc + bj * HALF) >> 7) * T + row) * 128 + ((lc + bj * HALF) & 127)) = w;
                    else *(u32x4*)(base + (size_t)row * ld + lc + bj * HALF) = w;
                    if (do_vt) {
                        bf16_t* tp = vt + (size_t)(lc + bj * HALF) * T + row;
                        tp[0] = (bf16_t)(w.x & 0xffffu); tp[(size_t)T] = (bf16_t)(w.x >> 16); tp[(size_t)2 * T] = (bf16_t)(w.y & 0xffffu); tp[(size_t)3 * T] = (bf16_t)(w.y >> 16);
                        tp[(size_t)4 * T] = (bf16_t)(w.z & 0xffffu); tp[(size_t)5 * T] = (bf16_t)(w.z >> 16); tp[(size_t)6 * T] = (bf16_t)(w.w & 0xffffu); tp[(size_t)7 * T] = (bf16_t)(w.w >> 16);
                    }
                }
            }
        if (do_km) {
#pragma unroll
            for (int bj = 0; bj < 2; ++bj) {
                float mx = kmx[bj];
#pragma unroll
                for (int o = 1; o < 64; o <<= 1) mx = fmaxf(mx, __shfl_xor(mx, o));
                if (fr == 0 && fq == 0) atomicMax(kmax + ((ct - nq) >> 7) + bj, __float_as_uint(mx));
            }
#pragma unroll
            for (int bj = 0; bj < 2; ++bj)
#pragma unroll
                for (int n = 0; n < 2; ++n) {
                    f32x4 c = csum[bj][n];
#pragma unroll
                    for (int o = 1; o < 16; o <<= 1) { c[0] += __shfl_xor(c[0], o); c[1] += __shfl_xor(c[1], o); c[2] += __shfl_xor(c[2], o); c[3] += __shfl_xor(c[3], o); }
                    if (fr == 0) *(f32x4*)(kmp + ((size_t)wr * 32 + u.pm) * D + lc + bj * HALF + 4 * n) = c;
                }
        }
    }
};

template <class Epi, class Sched, bool ALIGN_EPI>
__device__ __forceinline__ void gemm_phase(PG8_LAS unsigned char* lds, const Gemm g, const Sched& S, const Epi& E, const int tid) {
    const int wid = __builtin_amdgcn_readfirstlane(tid >> 6), lane = tid & 63, wr = wid >> 2, wc = wid & 3, fr = lane & 15, fq = lane >> 4;
    const int K = g.K, nt = K / BK, lda = g.lda;
    unsigned voffA[2], voffB[2];
#pragma unroll
    for (int i = 0; i < 2; ++i) { int R, C; stage_rc(tid * 16 + i * 8192, R, C); const int Rb = Epi::PERM ? ((R & ~31) + perm32(R & 31)) : R;
        voffA[i] = (unsigned)(R * (g.ta ? BK : lda) + C) * 2u; voffB[i] = (unsigned)(Rb * (g.tb ? BK : K) + C) * 2u; }
    const size_t kstepA = g.ta ? (size_t)BM * BK * 2 : (size_t)(BK * 2), kstepB = g.tb ? (size_t)BM * BK * 2 : (size_t)(BK * 2);
    const size_t hstepA = g.ta ? (size_t)HALF * BK * 2 : (size_t)HALF * lda * 2, hstepB = g.tb ? (size_t)HALF * BK * 2 : (size_t)HALF * K * 2;
    const size_t tstepA = g.ta ? (size_t)(K / BK) * BM * BK * 2 : 2 * hstepA, tstepB = g.tb ? (size_t)(K / BK) * BM * BK * 2 : 2 * hstepB;
    const unsigned ldsw = (unsigned)wid * 1024u;
    const int aoff = lds_byte(wr * 64 + fr, fq * 8), boff = lds_byte(wc * 32 + fr, fq * 8);
#define PG8_ACOL(u_) (g.grouped ? (size_t)((u_).pn >> 1) * (size_t)K * 2 : (size_t)0)
#define PG8_SA(b, h) (((b) * 2 + (h)) * HTB)
#define PG8_SB(b, h) ((4 + (b) * 2 + (h)) * HTB)
#define PG8_STAGE(bufoff, gbase, voff) do { _Pragma("unroll") for (int _i = 0; _i < 2; ++_i) \
        __builtin_amdgcn_global_load_lds((const unsigned*)((const char*)(gbase) + (voff)[_i]), (PG8_LAS unsigned*)(lds + (bufoff) + ldsw + _i * 8192), 16, 0, 0); } while (0)
#define PG8_LDA(dst, b, h) do { _Pragma("unroll") for (int m = 0; m < 4; ++m) _Pragma("unroll") for (int k = 0; k < 2; ++k) dst[m][k] = *(const PG8_LAS bf16x8*)(lds + PG8_SA(b, h) + aoff + m * 2048 + k * 1024); } while (0)
#define PG8_LDB(dst, b, h) do { _Pragma("unroll") for (int n = 0; n < 2; ++n) _Pragma("unroll") for (int k = 0; k < 2; ++k) dst[n][k] = *(const PG8_LAS bf16x8*)(lds + PG8_SB(b, h) + boff + n * 2048 + k * 1024); } while (0)
#define PG8_MMA(ai, bj, At, Bt) do { __builtin_amdgcn_s_setprio(1); _Pragma("unroll") for (int m = 0; m < 4; ++m) _Pragma("unroll") for (int n = 0; n < 2; ++n) _Pragma("unroll") for (int k = 0; k < 2; ++k) \
        acc[ai][bj][m][n] = __builtin_amdgcn_mfma_f32_16x16x32_bf16(Bt[n][k], At[m][k], acc[ai][bj][m][n], 0, 0, 0); __builtin_amdgcn_s_setprio(0); } while (0)
#define PG8_WAIT_V(n) asm volatile("s_waitcnt vmcnt(" #n ")" ::: "memory")
#define PG8_WAIT_L(n) asm volatile("s_waitcnt lgkmcnt(" #n ")" ::: "memory")
#define PG8_BAR __builtin_amdgcn_s_barrier()
#define PG8_SCHED __builtin_amdgcn_sched_barrier(0)
    Unit cur, nxt; int ui = 0;
    if (!S.next(0, cur)) return;
    f32x4 acc[2][2][4][2];
#pragma unroll
    for (int a = 0; a < 2; ++a)
#pragma unroll
        for (int b = 0; b < 2; ++b)
#pragma unroll
            for (int m = 0; m < 4; ++m)
#pragma unroll
                for (int n = 0; n < 2; ++n) acc[a][b][m][n] = (f32x4){0.f, 0.f, 0.f, 0.f};
    bf16x8 At[4][2], B0[2][2], B1[2][2];
    const char* cA = (const char*)g.A + (size_t)cur.pm * tstepA + PG8_ACOL(cur); const char* cB = (const char*)g.Bt + (size_t)cur.pn * tstepB;
    S.a_ready(cur);
    PG8_STAGE(PG8_SB(0, 0), cB, voffB); PG8_STAGE(PG8_SB(0, 1), cB + hstepB, voffB); PG8_STAGE(PG8_SA(0, 0), cA, voffA); PG8_STAGE(PG8_SA(0, 1), cA + hstepA, voffA);
    if (wr == 1) PG8_BAR;
    PG8_WAIT_V(2); PG8_BAR;
    PG8_STAGE(PG8_SB(1, 0), cB + kstepB, voffB); PG8_STAGE(PG8_SA(1, 0), cA + kstepA, voffA); PG8_STAGE(PG8_SB(1, 1), cB + hstepB + kstepB, voffB);
    PG8_WAIT_V(6); PG8_BAR;
    for (;;) {
        const bool has_next = S.next(ui + 1, nxt);
        const char* nA = has_next ? (const char*)g.A + (size_t)nxt.pm * tstepA + PG8_ACOL(nxt) : cA; const char* nB = has_next ? (const char*)g.Bt + (size_t)nxt.pn * tstepB : cB;
        for (int t = 0; t < nt; t += 2) {
            const bool last = (t == nt - 2);
            const char* a1 = cA + (size_t)(t + 1) * kstepA;
            const char* a2 = last ? nA : cA + (size_t)(t + 2) * kstepA; const char* b2 = last ? nB : cB + (size_t)(t + 2) * kstepB;
            const char* a3 = a2 + kstepA; const char* b3 = b2 + kstepB;
            if (last && has_next) S.a_ready(nxt);
            PG8_LDB(B0, 0, 0); PG8_LDB(B1, 0, 1); PG8_SCHED; PG8_LDA(At, 0, 0); PG8_STAGE(PG8_SA(1, 1), a1 + hstepA, voffA);
            PG8_WAIT_V(8); PG8_WAIT_L(0); PG8_BAR; PG8_MMA(0, 0, At, B0); PG8_MMA(0, 1, At, B1); PG8_BAR; PG8_SCHED;
            PG8_LDA(At, 0, 1); PG8_STAGE(PG8_SB(0, 0), b2, voffB); PG8_STAGE(PG8_SB(0, 1), b2 + hstepB, voffB); PG8_STAGE(PG8_SA(0, 0), a2, voffA);
            PG8_WAIT_V(8); PG8_WAIT_L(0); PG8_BAR; PG8_MMA(1, 0, At, B0); PG8_MMA(1, 1, At, B1); PG8_BAR; PG8_SCHED;
            PG8_LDB(B0, 1, 0); PG8_LDB(B1, 1, 1); PG8_SCHED; PG8_LDA(At, 1, 0); PG8_STAGE(PG8_SA(0, 1), a2 + hstepA, voffA);
            PG8_WAIT_V(8); PG8_WAIT_L(0); PG8_BAR; PG8_MMA(0, 0, At, B0); PG8_MMA(0, 1, At, B1); PG8_BAR; PG8_SCHED;
            PG8_LDA(At, 1, 1); PG8_STAGE(PG8_SB(1, 0), b3, voffB); PG8_STAGE(PG8_SB(1, 1), b3 + hstepB, voffB); PG8_STAGE(PG8_SA(1, 0), a3, voffA);
            PG8_WAIT_V(8); PG8_WAIT_L(0); PG8_BAR; PG8_MMA(1, 0, At, B0); PG8_MMA(1, 1, At, B1); PG8_BAR; PG8_SCHED;
        }
        if constexpr (ALIGN_EPI) { if (wr == 0) PG8_BAR; }
        E(acc, cur, wr, wc, fr, fq, ui); S.done(cur);
        if (!has_next) break;
#pragma unroll
        for (int a = 0; a < 2; ++a)
#pragma unroll
            for (int b = 0; b < 2; ++b)
#pragma unroll
                for (int m = 0; m < 4; ++m)
#pragma unroll
                    for (int n = 0; n < 2; ++n) acc[a][b][m][n] = (f32x4){0.f, 0.f, 0.f, 0.f};
        cur = nxt; cA = nA; cB = nB; ++ui;
        if constexpr (ALIGN_EPI) { if (wr == 1) PG8_BAR; }
    }
    PG8_WAIT_V(0);
    if constexpr (!ALIGN_EPI) { if (wr == 0) PG8_BAR; }
    PG8_BAR;
#undef PG8_ACOL
#undef PG8_SA
#undef PG8_SB
#undef PG8_STAGE
#undef PG8_LDA
#undef PG8_LDB
#undef PG8_MMA
#undef PG8_WAIT_V
#undef PG8_WAIT_L
#undef PG8_BAR
#undef PG8_SCHED
}
}
#define GAS __attribute__((address_space(1)))
#define LAS __attribute__((address_space(3)))
typedef unsigned short bf16;
typedef unsigned v4u __attribute__((ext_vector_type(4)));
typedef float f32x4 __attribute__((ext_vector_type(4)));
typedef short bf16x8 __attribute__((ext_vector_type(8)));
typedef GAS unsigned gu32;
typedef GAS unsigned long long gu64;
#define RLX_AGENT __ATOMIC_RELAXED, __HIP_MEMORY_SCOPE_AGENT
#define LDS_WAIT() asm volatile("s_waitcnt lgkmcnt(0)" ::: "memory")
#define VM_WAIT() asm volatile("s_waitcnt vmcnt(0)" ::: "memory")
__device__ __forceinline__ unsigned long long rt() { return __builtin_amdgcn_s_memrealtime(); }
__device__ __forceinline__ unsigned f2bf(float f) { unsigned u = __builtin_bit_cast(unsigned, f); return (u + 0x7fffu + ((u >> 16) & 1u)) >> 16; }
__device__ __forceinline__ unsigned pk2(float lo, float hi) { return f2bf(lo) | (f2bf(hi) << 16); }

#define XB_TMO      128
#define XB_XCNT(j)  (256  + 64 * (j))
#define XB_XSUB(j)  (1280 + 64 * (j))
#define XB_XGEN(j)  (2304 + 64 * (j))
#define XB_TOP      3328
#define XB_TOPGEN   3392
#define XCD_BAR_WORDS 3456
#define XB_SPIN_CAP (1u << 18)

__device__ __forceinline__ unsigned xb_ld(unsigned* p)              { return __hip_atomic_load(p, __ATOMIC_RELAXED, __HIP_MEMORY_SCOPE_AGENT); }
__device__ __forceinline__ unsigned xb_add(unsigned* p, unsigned v) { return __hip_atomic_fetch_add(p, v, __ATOMIC_RELAXED, __HIP_MEMORY_SCOPE_AGENT); }
__device__ __forceinline__ unsigned xb_xcc_id() { return (unsigned)__builtin_amdgcn_s_getreg((3 << 11) | 20) & 0xFu; }
#define XB_SPIN(cond, bar) do { unsigned _sp = 0; while (cond) { __builtin_amdgcn_s_sleep(1); \
    if ((++_sp & 255u) == 0u) { if (xb_ld(&(bar)[XB_TMO])) break; if (_sp > XB_SPIN_CAP) { atomicAdd(&(bar)[XB_TMO], 1u); break; } } } } while (0)

struct XcdBarrier {
    unsigned* bar; unsigned x;
    volatile LAS unsigned* st;
};

__device__ __forceinline__ XcdBarrier xcd_barrier_post(unsigned* bar, volatile LAS unsigned* st) {
    XcdBarrier b; b.bar = bar; b.x = xb_xcc_id(); b.st = st;
    if (threadIdx.x == 0) (void)xb_add(&bar[XB_XCNT(b.x)], 1u);
    return b;
}
__device__ __forceinline__ void xcd_barrier_complete(unsigned* bar, unsigned x, unsigned& nloc, unsigned& nx) {
    const unsigned G = gridDim.x * gridDim.y * gridDim.z;
    unsigned sum, cnt, mine, sp = 0u;
    for (;;) {
        sum = 0u; cnt = 0u; mine = 0u;
#pragma unroll
        for (unsigned j = 0; j < 16; ++j) { const unsigned c = xb_ld(&bar[XB_XCNT(j)]); sum += c; cnt += (c > 0u) ? 1u : 0u; mine = (j == x) ? c : mine; }
        if (sum == G) break;
        __builtin_amdgcn_s_sleep(1);
        if ((++sp & 255u) == 0u) { if (xb_ld(&bar[XB_TMO])) break; if (sp > XB_SPIN_CAP) { atomicAdd(&bar[XB_TMO], 1u); break; } }
    }
    nloc = mine > 0u ? mine : 1u; nx = cnt > 0u ? cnt : 1u;
}

__device__ __forceinline__ void xcd_barrier(const XcdBarrier& b) {
    asm volatile("s_waitcnt vmcnt(0)" ::: "memory");
    __syncthreads();
    if (threadIdx.x == 0) {
        unsigned* bar = b.bar;
        __builtin_amdgcn_s_waitcnt(0);
        unsigned nloc = b.st[0], nx = b.st[1];
        if (nloc == 0u) { xcd_barrier_complete(bar, b.x, nloc, nx); b.st[0] = nloc; b.st[1] = nx; }
        const unsigned old = xb_add(&bar[XB_XSUB(b.x)], 1u);
        const unsigned gen = old / nloc;
        if (old + 1u == (gen + 1u) * nloc) {
            __builtin_amdgcn_fence(__ATOMIC_RELEASE, "agent");
            asm volatile("s_waitcnt vmcnt(0)" ::: "memory");
            const unsigned og = xb_add(&bar[XB_TOP], 1u);
            const unsigned tg = og / nx;
            if (og + 1u == (tg + 1u) * nx) xb_add(&bar[XB_TOPGEN], 1u);
            else XB_SPIN(xb_ld(&bar[XB_TOPGEN]) == tg, bar);
            __builtin_amdgcn_fence(__ATOMIC_ACQUIRE, "agent");
            xb_add(&bar[XB_XGEN(b.x)], 1u);
            asm volatile("s_waitcnt vmcnt(0)" ::: "memory");
        } else {
            XB_SPIN(xb_ld(&bar[XB_XGEN(b.x)]) == gen, bar);
            __builtin_amdgcn_fence(__ATOMIC_ACQUIRE, "agent");
            asm volatile("s_waitcnt vmcnt(0)" ::: "memory");
        }
    }
    __syncthreads();
}

namespace mb {
typedef unsigned short bf16_t;
typedef short bf16x8 __attribute__((ext_vector_type(8)));
typedef short s16x4 __attribute__((ext_vector_type(4)));
typedef float f32x16 __attribute__((ext_vector_type(16)));
typedef float f32x4 __attribute__((ext_vector_type(4)));
typedef unsigned u32x4 __attribute__((ext_vector_type(4)));
constexpr int HD = 128, PITCH = 128, OPITCH = 128;
constexpr float SCALE = 0.08838834764831845f;
constexpr float THR = 8.f;
constexpr int NW = 8, QBLK = 32, KVBLK = 64, QB = NW * QBLK;
constexpr int SHM_V = KVBLK * HD * 2, SHM_K = KVBLK * HD * 2;
constexpr int LDS_BYTES = 2 * SHM_V + 2 * SHM_K + NW * 64 * 4;

#define KSWZ(row, colB) ((row) * 256 + ((colB) ^ (((row) & 7) << 4)))
#define SBAR() __builtin_amdgcn_sched_barrier(0)
__device__ __forceinline__ int v_st(int k, int c) { const int kk = (k & ~0xC) | ((k & 4) << 1) | ((k & 8) >> 1); return ((kk >> 3) * 4 + (c >> 5)) * 512 + ((kk & 7) * 32 + (c & 31)) * 2; }
__device__ __forceinline__ int v_rd_base(int lane) { return ((lane & 3) << 3) | (((lane >> 2) & 3) << 6) | (((lane >> 4) & 1) << 5) | (((lane >> 5) & 1) << 8); }
constexpr int v_rd_off(int d0, int ks, int half) { return d0 * 512 + ks * 4096 + half * 2048; }
__device__ __forceinline__ int crow(int r, int hi) { return (r & 3) + 8 * (r >> 2) + 4 * hi; }
__device__ __forceinline__ unsigned cvtpk(float lo, float hi) { unsigned r; asm volatile("v_cvt_pk_bf16_f32 %0, %1, %2" : "=v"(r) : "v"(lo), "v"(hi)); return r; }
__device__ __forceinline__ bf16x8 load8(const bf16_t* p) { return *reinterpret_cast<const bf16x8*>(p); }

__device__ __forceinline__ void bias_tile(f32x16& p0, f32x16& p1, float ab) {
#pragma unroll
    for (int r = 0; r < 16; ++r) { const int c = (r & 3) + 8 * (r >> 2); p0[r] = fmaf(ab, (float)c, p0[r]); p1[r] = fmaf(ab, (float)(c + 32), p1[r]); }
}
__device__ __forceinline__ void causal_tile(f32x16& p0, f32x16& p1, int dq) {
    const float NEG = -__builtin_inff();
#pragma unroll
    for (int r = 0; r < 16; ++r) { const int c = (r & 3) + 8 * (r >> 2); if (dq - c < 0) p0[r] = NEG; if (dq - c - 32 < 0) p1[r] = NEG; }
}
__device__ __forceinline__ void partialSM(f32x16& p0, f32x16& p1, float& m_reg, float& mn, float& alpha, float off, float abh) {
    float pmax = p0[0]; for (int r = 1; r < 16; ++r) pmax = fmaxf(pmax, p0[r]); for (int r = 0; r < 16; ++r) pmax = fmaxf(pmax, p1[r]);
    pmax += abh;
    { auto rr = __builtin_amdgcn_permlane32_swap(__float_as_uint(pmax), __float_as_uint(pmax), false, false);
      pmax = fmaxf(__uint_as_float(rr[0]), __uint_as_float(rr[1])); }
    pmax += off;
    constexpr float C2 = 1.4426950408889634f * SCALE;
    if (__builtin_expect(__all((pmax - m_reg) * SCALE <= THR), 1)) { mn = m_reg; alpha = 1.f; }
    else { mn = fmaxf(m_reg, pmax); alpha = __builtin_amdgcn_exp2f((m_reg - mn) * C2); m_reg = mn; }
    const float mnL = ((off + abh) - mn) * C2;
    for (int r = 0; r < 16; ++r) p0[r] = fmaf(p0[r], C2, mnL); for (int r = 0; r < 16; ++r) p1[r] = fmaf(p1[r], C2, mnL);
    for (int r = 0; r < 16; ++r) p0[r] = __builtin_amdgcn_exp2f(p0[r]);
}
__device__ __forceinline__ void finishSM(f32x16& p0, f32x16& p1, float alpha, float& l_reg, bf16x8& pa0, bf16x8& pa1, bf16x8& pa2, bf16x8& pa3) {
    for (int r = 0; r < 16; ++r) p1[r] = __builtin_amdgcn_exp2f(p1[r]);
    float ps = 0; for (int r = 0; r < 16; ++r) ps += p0[r]; for (int r = 0; r < 16; ++r) ps += p1[r];
    { auto rr = __builtin_amdgcn_permlane32_swap(__float_as_uint(ps), __float_as_uint(ps), false, false);
      ps = __uint_as_float(rr[0]) + __uint_as_float(rr[1]); }
    l_reg = l_reg * alpha + ps;
#define PK4(P, B_, OUT) do { unsigned a0 = cvtpk(P[B_+0], P[B_+1]), a1 = cvtpk(P[B_+2], P[B_+3]);                          \
        unsigned b0 = cvtpk(P[B_+4], P[B_+5]), b1 = cvtpk(P[B_+6], P[B_+7]);                                             \
        auto r0 = __builtin_amdgcn_permlane32_swap(a0, b0, false, false); auto r1 = __builtin_amdgcn_permlane32_swap(a1, b1, false, false); \
        u32x4 w = {r0[0], r1[0], r0[1], r1[1]}; OUT = *reinterpret_cast<bf16x8*>(&w); } while (0)
    PK4(p0, 0, pa0); PK4(p0, 8, pa1); PK4(p1, 0, pa2); PK4(p1, 8, pa3);
#undef PK4
}
template <int KB>
__device__ __forceinline__ void qkt(f32x16& p0, f32x16& p1, const char* K_lds, int r32, int hi, const bf16x8* qr) {
    p0 = f32x16{}; p1 = f32x16{};
    const char* kb[4];
#pragma unroll
    for (int dd = 0; dd < 4; ++dd) kb[dd] = K_lds + KB * SHM_K + KSWZ(r32, (dd * 16 + hi * 8) * 2);
#pragma unroll
    for (int d0 = 0; d0 < 8; ++d0) { const char* a = kb[d0 & 3] + (d0 >> 2) * 128;
        bf16x8 b0 = *reinterpret_cast<const bf16x8*>(a);
        bf16x8 b1 = *reinterpret_cast<const bf16x8*>(a + 32 * 256);
        p0 = __builtin_amdgcn_mfma_f32_32x32x16_bf16(b0, qr[d0], p0, 0, 0, 0);
        p1 = __builtin_amdgcn_mfma_f32_32x32x16_bf16(b1, qr[d0], p1, 0, 0, 0); }
}
template <int VB>
__device__ __forceinline__ void pv_tile(f32x16* o, int vb0, bf16x8 pa0, bf16x8 pa1, bf16x8 pa2, bf16x8 pa3) {
#define TRRD(dst, off) asm volatile("ds_read_b64_tr_b16 %0, %1 offset:%2" : "=&v"(dst) : "v"(vb0), "i"(off) : "memory")
#define PV_D0(d0) do { s16x4 l0, l1, l2, l3, h0, h1, h2, h3; constexpr int b_ = VB * SHM_V + v_rd_off(d0, 0, 0);     \
        TRRD(l0, b_); TRRD(h0, b_ + 2048); TRRD(l1, b_ + 4096); TRRD(h1, b_ + 6144); TRRD(l2, b_ + 8192); TRRD(h2, b_ + 10240); TRRD(l3, b_ + 12288); TRRD(h3, b_ + 14336); \
        asm volatile("s_waitcnt lgkmcnt(0)" ::: "memory"); SBAR();   \
        o[d0] = __builtin_amdgcn_mfma_f32_32x32x16_bf16(pa0, (bf16x8){l0[0], l0[1], l0[2], l0[3], h0[0], h0[1], h0[2], h0[3]}, o[d0], 0, 0, 0);   \
        o[d0] = __builtin_amdgcn_mfma_f32_32x32x16_bf16(pa1, (bf16x8){l1[0], l1[1], l1[2], l1[3], h1[0], h1[1], h1[2], h1[3]}, o[d0], 0, 0, 0);   \
        o[d0] = __builtin_amdgcn_mfma_f32_32x32x16_bf16(pa2, (bf16x8){l2[0], l2[1], l2[2], l2[3], h2[0], h2[1], h2[2], h2[3]}, o[d0], 0, 0, 0);   \
        o[d0] = __builtin_amdgcn_mfma_f32_32x32x16_bf16(pa3, (bf16x8){l3[0], l3[1], l3[2], l3[3], h3[0], h3[1], h3[2], h3[3]}, o[d0], 0, 0, 0); } while (0)
    PV_D0(0); PV_D0(1); PV_D0(2); PV_D0(3);
#undef PV_D0
#undef TRRD
}

struct BlockRef { const bf16_t* Q; const bf16_t* K; const bf16_t* V; bf16_t* O; const int* rowtab; float* ML; int* LOC; int P0; float ab; int jlo; int item256; };
struct Seam { bf16x8 qr[8]; bf16x8 st_v0, st_v1, st_k0, st_k1; };
#define ROWP(p, k0) ((const char*)(p) + (size_t)(k0) * (PITCH * 2))
#define VMW() asm volatile("s_waitcnt vmcnt(0)" ::: "memory")
#define VMWN(n) asm volatile("s_waitcnt vmcnt(%0)" :: "i"(n) : "memory")
#define SLOAD_H(Kp, Vp, k0) do { const char* vp_ = ROWP(Vp, k0); const char* kp_ = ROWP(Kp, k0);                                   \
                         S.st_v0 = *(const bf16x8*)(vp_ + loff); S.st_v1 = *(const bf16x8*)(vp_ + 32 * PITCH * 2 + loff);          \
                         S.st_k0 = *(const bf16x8*)(kp_ + loff); S.st_k1 = *(const bf16x8*)(kp_ + 32 * PITCH * 2 + loff); } while (0)
#define SWRITE_HK(bf) do { *(bf16x8*)(K_lds + (bf) * SHM_K + kws) = S.st_k0; *(bf16x8*)(K_lds + (bf) * SHM_K + kws + 32 * 256) = S.st_k1; } while (0)
#define SWRITE_HV(bf) do { *(bf16x8*)(V_lds + (bf) * SHM_V + vst0) = S.st_v0; *(bf16x8*)(V_lds + (bf) * SHM_V + vst1) = S.st_v1; } while (0)
#define SWRITE_H(bf) do { SWRITE_HV(bf); SWRITE_HK(bf); } while (0)
__device__ __forceinline__ int fresh_lane() { int l; asm volatile("v_mbcnt_lo_u32_b32 %0, -1, 0\n\tv_mbcnt_hi_u32_b32 %0, -1, %0" : "=v"(l)); return l; }
__device__ __forceinline__ void moba_prime(const BlockRef& cur, char* lds, Seam& S, const int wid) {
    const int lane = fresh_lane(), tid = wid * 64 + lane, r32 = lane & 31, hi = lane >> 5;
    const int sr = tid >> 4, sc = (tid & 15) * 8, kws = KSWZ(sr, sc * 2); char* K_lds = lds + 2 * SHM_V;
    const int rid = cur.rowtab[wid * QBLK + r32], pos = rid >= 0 ? (rid & 0xFFFF) : 0;
    const unsigned loff = (unsigned)(sr * PITCH + sc) * 2u, qoff = (unsigned)(pos * PITCH + hi * 8) * 2u;
#pragma unroll
    for (int d0 = 0; d0 < 8; ++d0) S.qr[d0] = *(const bf16x8*)((const char*)cur.Q + d0 * 32 + qoff);
    SLOAD_H(cur.K, cur.V, cur.jlo * KVBLK); VMW(); SWRITE_HK(0);
    __syncthreads();
}
__device__ __forceinline__ void moba_block(const BlockRef& cur, const BlockRef& nxt, char* lds, Seam& S, const int wid, const int pend_ent, const int pend_idx, int* nxt_rt, int* idx_slot) {
    const int lane = fresh_lane(), tid = wid * 64 + lane, r32 = lane & 31, hi = lane >> 5;
    const int j_lo = cur.jlo; constexpr int NT = 4;
    const int rid = cur.rowtab[wid * QBLK + r32], pos = rid >= 0 ? (rid & 0xFFFF) : 0;
    const int qlo = cur.P0 + wid * QBLK, qm = pos - 4 * hi;
    const float ab = cur.ab, abh = cur.ab * (float)(4 * hi);
    const unsigned mymask = rid >= 0 ? 0xFFFFFFFFu : 0u;
    char* V_lds = lds; char* K_lds = lds + 2 * SHM_V;
    float* ws = (float*)(lds + 2 * SHM_V + 2 * SHM_K) + wid * 64; float* li_l = ws, * al_l = ws + 32;
    float m_reg = -1e30f, l_reg = 0; f32x16 o[4] = {};
    const int sr = tid >> 4, sc = (tid & 15) * 8, vst0 = v_st(sr, sc), vst1 = v_st(32 + sr, sc), kws = KSWZ(sr, sc * 2);
    const unsigned loff = (unsigned)(sr * PITCH + sc) * 2u, qoff = (unsigned)(pos * PITCH + hi * 8) * 2u;
    const int vb0 = (int)(uintptr_t)V_lds + v_rd_base(lane);
    const bf16_t* Kh = cur.K; const bf16_t* Vh = cur.V;
#define RESC(a) do { if (__any((a) < 1.f)) { if (hi == 0) al_l[r32] = (a); asm volatile("s_waitcnt lgkmcnt(0)" ::: "memory");              \
                     for (int d_ = 0; d_ < 4; ++d_) for (int r = 0; r < 16; ++r) o[d_][r] *= al_l[crow(r, hi)]; } } while (0)
#define KBASE(t) ((j_lo + (t)) * KVBLK)
#define BMASK(P0_, P1_, t, OFF_) do { const int kb_ = KBASE(t); const int dq_ = qm - kb_; bias_tile(P0_, P1_, ab);                                   \
        if (kb_ >= cur.P0) { if (kb_ + KVBLK - 1 > qlo) causal_tile(P0_, P1_, dq_); OFF_ = -ab * (float)(dq_ + 4 * hi); }                          \
        else { OFF_ = ((mymask >> (kb_ >> 8)) & 1u) ? -ab * (float)(dq_ + 4 * hi) : -__builtin_inff(); } } while (0)
    constexpr int NQL = 8;
#define SEAM_K0() do { VMWN(NQL); SWRITE_HK(0); SBAR(); } while (0)
    f32x16 pA0, pA1, pB0, pB1; float mnA, mnB, alA, alB, offA, offB; bf16x8 pa0, pa1, pa2, pa3;
    SWRITE_HV(0); SBAR();
    SLOAD_H(Kh, Vh, KBASE(1));
    SBAR(); qkt<0>(pA0, pA1, K_lds, r32, hi, S.qr);
    BMASK(pA0, pA1, 0, offA); partialSM(pA0, pA1, m_reg, mnA, alA, offA, abh);
    VMW(); SWRITE_H(1);
    SBAR(); SLOAD_H(Kh, Vh, KBASE(2)); SBAR();
    if (tid < 256) nxt_rt[tid] = pend_ent;
    if (tid == 0) *idx_slot = pend_idx;
    __syncthreads();
#define HALF_STEP(PX0, PX1, mnX, alX, offX, PY0, PY1, alY, t, KB, VB, SB) do {                                               \
        SBAR(); qkt<KB>(PX0, PX1, K_lds, r32, hi, S.qr);                                                                      \
        finishSM(PY0, PY1, alY, l_reg, pa0, pa1, pa2, pa3); SBAR();                                                           \
        pv_tile<VB>(o, vb0, pa0, pa1, pa2, pa3); BMASK(PX0, PX1, (t), offX); partialSM(PX0, PX1, m_reg, mnX, alX, offX, abh);      \
        __syncthreads();                                                                                                      \
        if ((t) + 1 < NT) { VMW(); SWRITE_H(SB); SBAR(); if ((t) + 2 < NT) { SLOAD_H(Kh, Vh, KBASE((t) + 2)); SBAR(); } }      \
        RESC(alX); __syncthreads(); } while (0)
    for (int t = 1; t + 1 < NT; t += 2) {
        HALF_STEP(pB0, pB1, mnB, alB, offB, pA0, pA1, alA, t, 1, 0, 0);
        HALF_STEP(pA0, pA1, mnA, alA, offA, pB0, pB1, alB, t + 1, 0, 1, 1);
    }
    SBAR(); qkt<1>(pB0, pB1, K_lds, r32, hi, S.qr); SBAR();
    SLOAD_H(nxt.K, nxt.V, nxt.jlo * KVBLK); SBAR();
    { const int ridn = nxt.rowtab[wid * QBLK + r32], posn = ridn >= 0 ? (ridn & 0xFFFF) : 0; const unsigned qoffn = (unsigned)(posn * PITCH + hi * 8) * 2u;
#pragma unroll
    for (int d0 = 0; d0 < 8; ++d0) S.qr[d0] = *(const bf16x8*)((const char*)nxt.Q + d0 * 32 + qoffn); }
    SBAR();
    finishSM(pA0, pA1, alA, l_reg, pa0, pa1, pa2, pa3); SBAR();
    pv_tile<0>(o, vb0, pa0, pa1, pa2, pa3);
    BMASK(pB0, pB1, NT - 1, offB); partialSM(pB0, pB1, m_reg, mnB, alB, offB, abh); __syncthreads(); RESC(alB);
    finishSM(pB0, pB1, alB, l_reg, pa0, pa1, pa2, pa3); SBAR(); pv_tile<1>(o, vb0, pa0, pa1, pa2, pa3);
    SBAR(); SEAM_K0();
    if (hi == 0) li_l[r32] = l_reg; asm volatile("s_waitcnt lgkmcnt(0)" ::: "memory");
    float rli[16];
#pragma unroll
    for (int r = 0; r < 16; ++r) rli[r] = __builtin_amdgcn_rcpf(li_l[crow(r, hi)]);
    const unsigned ooff = (unsigned)((wid * QBLK + 4 * hi) * OPITCH + r32) * 2u;
#pragma unroll
    for (int r = 0; r < 16; ++r) { const int orc = (r & 3) + 8 * (r >> 2);
#pragma unroll
        for (int d0 = 0; d0 < 4; ++d0) { const float v = o[d0][r] * rli[r];
            const float vn = __shfl_xor(v, 1);
            if ((r32 & 1) == 0) *(unsigned*)((char*)cur.O + (size_t)(orc * OPITCH + d0 * 32) * 2 + ooff) = cvtpk(v, vn); } }
    if (hi == 0) { float2 mlv; mlv.x = m_reg; mlv.y = l_reg; *(float2*)(cur.ML + (wid * QBLK + r32) * 2) = mlv;
        if (rid >= 0) cur.LOC[pos * 4 + (rid >> 16)] = cur.item256 + wid * QBLK + r32; }
    __syncthreads();
#undef RESC
#undef KBASE
#undef BMASK
#undef SEAM_K0
#undef HALF_STEP
}
struct UnitRef { const bf16_t* Q; const bf16_t* K; const bf16_t* V; bf16_t* O; float* ML; int* LOC; const int* seg; const int* cnt; float ab; int n; int c; int L; int unit512; };
__device__ __forceinline__ void moba_unit(const UnitRef& u, char* lds, int* rowtab, int* cq, float* wscr, int* idx_slot, const int pend_idx, const int wid) {
    const int lane = fresh_lane(), tid = wid * 64 + lane, r32 = lane & 31, hi = lane >> 5;
    char* V_lds = lds; char* K_lds = lds + 4 * SHM_V;
    const int sr = tid >> 4, sc = (tid & 15) * 8, vst0 = v_st(sr, sc), vst1 = v_st(32 + sr, sc), kws = KSWZ(sr, sc * 2);
    const unsigned loff = (unsigned)(sr * PITCH + sc) * 2u;
    bf16x8 kv[4][4];
#pragma unroll
    for (int t = 0; t < 4; ++t) { const char* vp_ = ROWP(u.V, u.n * 256 + t * 64); const char* kp_ = ROWP(u.K, u.n * 256 + t * 64);
        kv[t][0] = *(const bf16x8*)(vp_ + loff); kv[t][1] = *(const bf16x8*)(vp_ + 32 * PITCH * 2 + loff);
        kv[t][2] = *(const bf16x8*)(kp_ + loff); kv[t][3] = *(const bf16x8*)(kp_ + 32 * PITCH * 2 + loff); }
    if (tid < 32) cq[tid] = (tid > u.n) ? u.cnt[tid] : 0;
    __syncthreads();
    {
        const int sidx = u.c * 512 + tid; int ent = -1;
        if (sidx < 256) ent = (u.n * 256 + sidx) | (3 << 16);
        else { const int g = sidx - 256;
            if (g < u.L) { int acc = 0, qx = u.n + 1;
                while (qx < 31 && g >= acc + cq[qx]) { acc += cq[qx]; ++qx; }
                ent = u.seg[qx * 256 + (g - acc)]; } }
        rowtab[tid] = ent;
    }
#pragma unroll
    for (int t = 0; t < 4; ++t) {
        *(bf16x8*)(V_lds + t * SHM_V + vst0) = kv[t][0]; *(bf16x8*)(V_lds + t * SHM_V + vst1) = kv[t][1];
        *(bf16x8*)(K_lds + t * SHM_K + kws) = kv[t][2]; *(bf16x8*)(K_lds + t * SHM_K + kws + 32 * 256) = kv[t][3]; }
    if (tid == 0) *idx_slot = pend_idx;
    __syncthreads();
    int nr = 256 + u.L - u.c * 512; nr = nr > 512 ? 512 : nr;
    const int ngroups = (nr + 31) >> 5;
    float* li_l = wscr + wid * 64; float* al_l = li_l + 32;
    const int vb0 = (int)(uintptr_t)V_lds + v_rd_base(lane);
    const float ab = u.ab, abh = u.ab * (float)(4 * hi);
#define URESC(a) do { if (__any((a) < 1.f)) { if (hi == 0) al_l[r32] = (a); asm volatile("s_waitcnt lgkmcnt(0)" ::: "memory");              \
                     for (int d_ = 0; d_ < 4; ++d_) for (int r = 0; r < 16; ++r) o[d_][r] *= al_l[crow(r, hi)]; } } while (0)
#define UMASK(P0_, P1_, t, OFF_) do { const int kb_ = u.n * 256 + (t) * KVBLK; const int dq_ = qm - kb_; bias_tile(P0_, P1_, ab);                       \
        if (own) { if (kb_ + KVBLK - 1 > qlo) causal_tile(P0_, P1_, dq_); OFF_ = -ab * (float)(dq_ + 4 * hi); }                                        \
        else OFF_ = rid >= 0 ? -ab * (float)(dq_ + 4 * hi) : -__builtin_inff(); } while (0)
#pragma unroll 1
    for (int grp = wid; grp < ngroups; grp += NW) {
        const int rid = rowtab[grp * 32 + r32], pos = rid >= 0 ? (rid & 0xFFFF) : 0;
        const bool own = (u.c == 0) && (grp < 8);
        const int qlo = u.n * 256 + grp * 32, qm = pos - 4 * hi;
        const unsigned qoff = (unsigned)(pos * PITCH + hi * 8) * 2u;
        bf16x8 qr[8];
#pragma unroll
        for (int d0 = 0; d0 < 8; ++d0) qr[d0] = *(const bf16x8*)((const char*)u.Q + d0 * 32 + qoff);
        float m_reg = -1e30f, l_reg = 0; f32x16 o[4] = {};
        f32x16 pA0, pA1, pB0, pB1; float mnA, mnB, alA, alB, offA, offB; bf16x8 pa0, pa1, pa2, pa3;
        const int nt = own ? (grp >> 1) + 1 : 4;
#define UFIN(P0_, P1_, al_, VB_) do { finishSM(P0_, P1_, al_, l_reg, pa0, pa1, pa2, pa3); pv_tile<VB_>(o, vb0, pa0, pa1, pa2, pa3); } while (0)
        qkt<0>(pA0, pA1, K_lds, r32, hi, qr); UMASK(pA0, pA1, 0, offA); partialSM(pA0, pA1, m_reg, mnA, alA, offA, abh);
        if (nt > 1) qkt<1>(pB0, pB1, K_lds, r32, hi, qr);
        UFIN(pA0, pA1, alA, 0);
        if (nt > 1) {
            UMASK(pB0, pB1, 1, offB); partialSM(pB0, pB1, m_reg, mnB, alB, offB, abh); URESC(alB);
            if (nt > 2) qkt<2>(pA0, pA1, K_lds, r32, hi, qr);
            UFIN(pB0, pB1, alB, 1);
            if (nt > 2) {
                UMASK(pA0, pA1, 2, offA); partialSM(pA0, pA1, m_reg, mnA, alA, offA, abh); URESC(alA);
                if (nt > 3) qkt<3>(pB0, pB1, K_lds, r32, hi, qr);
                UFIN(pA0, pA1, alA, 2);
                if (nt > 3) { UMASK(pB0, pB1, 3, offB); partialSM(pB0, pB1, m_reg, mnB, alB, offB, abh); URESC(alB); UFIN(pB0, pB1, alB, 3); }
            }
        }
#undef UFIN
        if (hi == 0) li_l[r32] = l_reg; asm volatile("s_waitcnt lgkmcnt(0)" ::: "memory");
        float rli[16];
#pragma unroll
        for (int r = 0; r < 16; ++r) rli[r] = __builtin_amdgcn_rcpf(li_l[crow(r, hi)]);
        const unsigned ooff = (unsigned)((grp * 32 + 4 * hi) * OPITCH + r32) * 2u;
#pragma unroll
        for (int r = 0; r < 16; ++r) { const int orc = (r & 3) + 8 * (r >> 2);
#pragma unroll
            for (int d0 = 0; d0 < 4; ++d0) { const float v = o[d0][r] * rli[r];
                const float vn = __shfl_xor(v, 1);
                if ((r32 & 1) == 0) *(unsigned*)((char*)u.O + (size_t)(orc * OPITCH + d0 * 32) * 2 + ooff) = cvtpk(v, vn); } }
        if (hi == 0) { float2 mlv; mlv.x = m_reg; mlv.y = l_reg; *(float2*)(u.ML + (grp * 32 + r32) * 2) = mlv;
            if (rid >= 0) u.LOC[pos * 4 + (rid >> 16)] = u.unit512 + grp * 32 + r32; }
    }
#undef URESC
#undef UMASK
    __syncthreads();
}
#undef ROWP
#undef VMW
#undef VMWN
#undef SLOAD_H
#undef SWRITE_HK
#undef SWRITE_HV
#undef SWRITE_H
#undef KSWZ
#undef SBAR
}

constexpr int NWAVES = 8;
constexpr int RING_OFF = 0, RING_BYTES = 131072;
constexpr int LDSCTL_OFF = RING_BYTES, MISC_OFF = LDSCTL_OFF + 320;
constexpr int LDS_BYTES = 163840;
typedef pg8::bf16_t bf16_t;
typedef short s16x4 __attribute__((ext_vector_type(4)));
typedef unsigned u32x2 __attribute__((ext_vector_type(2)));
typedef unsigned u32x4 __attribute__((ext_vector_type(4)));
constexpr int KSPLIT = 16;

constexpr size_t CTL_BYTES = 65536;
constexpr size_t al256(size_t v) { return (v + 255) & ~(size_t)255; }
constexpr size_t O_ctl = 0;
constexpr size_t O_modp = O_ctl + CTL_BYTES;
constexpr size_t O_shv = O_modp + al256((size_t)KSPLIT * DEPTH * NMOD * 4);
constexpr size_t O_gs = O_shv + al256((size_t)DEPTH * 3 * D * 4);
constexpr size_t O_cres = O_gs + al256((size_t)DEPTH * 3 * D * 4);
constexpr size_t O_bias = O_cres + al256((size_t)DEPTH * 3 * D * 4);
constexpr size_t O_ss = O_bias + al256((size_t)DEPTH * 3 * F2 * 4);
constexpr size_t O_kmp = O_ss + al256((size_t)T * 32 * 4);
constexpr size_t O_sel = O_kmp + al256((size_t)2 * 32 * D * 4);
constexpr size_t O_wgu = O_sel + al256((size_t)T * 16 * 4);
constexpr size_t O_wd = O_wgu + al256((size_t)DEPTH * 2 * F2 * D * 2);
constexpr size_t O_mqkv = O_wd + al256((size_t)DEPTH * 2 * D * F * 2);
constexpr size_t O_mo = O_mqkv + al256((size_t)2 * 3 * D * D * 2);
constexpr size_t O_pw = O_mo + al256((size_t)2 * D * D * 2);
constexpr size_t O_sqkv = O_pw + al256((size_t)D * 512 * 2);
constexpr size_t O_so = O_sqkv + al256((size_t)2560 * D * 2);
constexpr size_t O_x = O_so + al256((size_t)D * D * 2);
constexpr size_t O_ap = O_x + al256((size_t)T * D * 4);
constexpr size_t O_act = O_ap + al256((size_t)T * D * 2);
constexpr size_t O_qb = O_act + al256((size_t)T * F * 2);
constexpr size_t O_kb = O_qb + al256((size_t)T * D * 2);
constexpr size_t O_vb = O_kb + al256((size_t)T * D * 2);
constexpr size_t O_vtb = O_vb + al256((size_t)T * D * 2);
constexpr size_t O_ao = O_vtb + al256((size_t)T * D * 2);
constexpr size_t O_biasp = O_ao + al256((size_t)T * D * 2);
constexpr int MB_MAXUNITS = 16 * (64 + 32);
constexpr size_t O_seg = O_biasp + al256((size_t)32 * DEPTH * 3 * F2 * 4);
constexpr size_t O_cnt = O_seg + al256((size_t)16 * 32 * 32 * 256 * 4);
constexpr size_t O_loc = O_cnt + al256((size_t)16 * 32 * 32 * 4);
constexpr size_t O_ml = O_loc + al256((size_t)16 * T * 4 * 4);
constexpr size_t O_part = O_ml + al256((size_t)MB_MAXUNITS * 512 * 2 * 4);
constexpr size_t WS_NEED = O_part + al256((size_t)MB_MAXUNITS * 512 * 128 * 2);
static_assert(O_kb == O_qb + (size_t)T * D * 2 && O_vb == O_kb + (size_t)T * D * 2, "q | k | v contiguous");
#define W_ctl ((unsigned*)(ws + O_ctl))
#define W_modp ((float*)(ws + O_modp))
#define W_shv ((float*)(ws + O_shv))
#define W_gs ((float*)(ws + O_gs))
#define W_cres ((float*)(ws + O_cres))
#define W_bias ((float*)(ws + O_bias))
#define W_ss ((float*)(ws + O_ss))
#define W_kmp ((float*)(ws + O_kmp))
#define W_sel ((unsigned*)(ws + O_sel))
#define W_wgu ((bf16_t*)(ws + O_wgu))
#define W_wd ((bf16_t*)(ws + O_wd))
#define W_mqkv ((bf16_t*)(ws + O_mqkv))
#define W_mo ((bf16_t*)(ws + O_mo))
#define W_pw ((bf16_t*)(ws + O_pw))
#define W_sqkv ((bf16_t*)(ws + O_sqkv))
#define W_so ((bf16_t*)(ws + O_so))
#define W_x ((bf16_t*)(ws + O_x))
#define XIDX(r_, c_) (((size_t)(((r_) >> 8) * (D / 64) + ((c_) >> 6)) * 256 + ((r_) & 255)) * 64 + ((c_) & 63))
#define W_ap ((bf16_t*)(ws + O_ap))
#define W_act ((bf16_t*)(ws + O_act))
#define W_qb ((bf16_t*)(ws + O_qb))
#define W_kb ((bf16_t*)(ws + O_kb))
#define W_vb ((bf16_t*)(ws + O_vb))
#define W_vtb ((bf16_t*)(ws + O_vtb))
#define W_ao ((bf16_t*)(ws + O_ao))
#define W_biasp ((float*)(ws + O_biasp))
#define W_seg ((int*)(ws + O_seg))
#define W_cnt ((int*)(ws + O_cnt))
#define W_loc ((int*)(ws + O_loc))
#define W_ml ((float*)(ws + O_ml))
#define W_part ((bf16_t*)(ws + O_part))
#define WS_FRESH() GAS unsigned char* wsg_ = (GAS unsigned char*)ws0; asm volatile("" : "+s"(wsg_)); unsigned char* ws = (unsigned char*)wsg_
#define FRESH_TID() int ftid; asm volatile("v_mbcnt_lo_u32_b32 %0, -1, 0\n\tv_mbcnt_hi_u32_b32 %0, -1, %0" : "=v"(ftid)); ftid += (wave << 6); const int flane = ftid & 63; (void)flane
struct Args { const float* in[16]; float* out; unsigned char* ws; };

__device__ __forceinline__ float wave_sum(float v) {
#pragma unroll
    for (int o = 1; o < 64; o <<= 1) v += __shfl_xor(v, o);
    return v;
}
__device__ __forceinline__ float bf2f(unsigned b) { return __builtin_bit_cast(float, b << 16); }

__device__ __forceinline__ void p0_transpose_item(const float* W, int K, int N, bf16_t* WT, int mode, int row_off, LAS float* scr, int item, int lane, const float* sh = nullptr, float* biasp = nullptr) {
    const int nblk = N / 32, kb = item / nblk, nb = item % nblk, k0 = 64 * kb, n0 = 32 * nb;
    const int r0 = mode == 0 ? n0 + row_off : ((n0 >> 7) * 256 + (mode == 2 ? 128 : 0) + (n0 & 127));
    const int hf = lane >> 5, nl = lane & 31;
    float w[32];
    const float* wp = W + (size_t)(k0 + hf) * N + n0 + nl;
#pragma unroll
    for (int i = 0; i < 32; ++i) w[i] = wp[(size_t)(2 * i) * N];
    if (sh) scr[2112 + lane] = sh[k0 + lane];
#pragma unroll
    for (int i = 0; i < 32; ++i) scr[(2 * i + hf) * 33 + nl] = w[i];
    LDS_WAIT(); asm volatile("" ::: "memory");
    if (sh) { float a0 = 0.f, a1 = 0.f;
#pragma unroll
        for (int i = 0; i < 32; i += 2) { a0 += scr[2112 + 2 * i + hf] * w[i]; a1 += scr[2112 + 2 * i + 2 + hf] * w[i + 1]; }
        float a = a0 + a1; a += __shfl_xor(a, 32);
        if (lane < 32) biasp[(size_t)kb * (DEPTH * 3 * F2) + r0 + nl] = a; }
    const int c = lane & 7;
#pragma unroll
    for (int j = 0; j < 4; ++j) { const int n = (lane >> 3) + 8 * j; const LAS float* s = scr + (8 * c) * 33 + n;
        v4u o; o.x = pk2(s[0 * 33], s[1 * 33]); o.y = pk2(s[2 * 33], s[3 * 33]); o.z = pk2(s[4 * 33], s[5 * 33]); o.w = pk2(s[6 * 33], s[7 * 33]);
        *(GAS v4u*)(WT + ((size_t)((r0 >> 8) * (K / 64) + kb) * 256 + ((r0 & 255) + n)) * 64 + 8 * c) = o; }
    LDS_WAIT(); asm volatile("" ::: "memory");
}
constexpr int CVT_GSB = 13312;
struct CvtD { const float* W; bf16_t* WT; const float* sh; float* bp; int N, KT, mode, roff, kb, nb; };
__device__ __forceinline__ void cvt_issue(const CvtD& d, int lane, LAS unsigned char* buf, LAS unsigned char* shb) {
    if (d.sh) {
        __builtin_amdgcn_global_load_lds((const unsigned*)((const char*)(d.sh + 64 * d.kb) + (unsigned)lane * 4u), (LAS unsigned*)shb, 4, 0, 0);
        __builtin_amdgcn_global_load_lds((const unsigned*)((const char*)(d.sh + 64 * d.kb) + (O_gs - O_shv) + (unsigned)lane * 4u), (LAS unsigned*)(shb + CVT_GSB), 4, 0, 0); }
    const float* base = d.W + (size_t)(64 * d.kb) * d.N + 32 * d.nb;
    const unsigned voff = (unsigned)((8 * (lane & 7)) * d.N + 4 * (lane >> 3)) * 4u;
#pragma unroll
    for (int i = 0; i < 8; ++i)
        __builtin_amdgcn_global_load_lds((const unsigned*)((const char*)(base + (size_t)i * d.N) + voff), (LAS unsigned*)(buf + i * 1024), 16, 0, 0);
}
__device__ __forceinline__ void cvt_fin(const CvtD& d, int lane, const LAS unsigned char* buf, const LAS unsigned char* shb) {
    const int n0 = 32 * d.nb, kb = d.kb;
    const int r0 = d.mode == 0 ? n0 + d.roff : ((n0 >> 7) * 256 + (d.mode == 2 ? 128 : 0) + (n0 & 127));
    const int c = lane & 7, nlo = lane >> 3;
    const LAS float* lp = (const LAS float*)buf + ((nlo >> 2) * 32 + c * 4 + (nlo & 3));
    float v[4][8];
#pragma unroll
    for (int j = 0; j < 4; ++j)
#pragma unroll
        for (int e = 0; e < 8; ++e) v[j][e] = lp[e * 256 + j * 64];
    if (d.sh) {
        const f32x4 s0 = *(const LAS f32x4*)(shb + c * 32), s1 = *(const LAS f32x4*)(shb + c * 32 + 16);
        float a[4];
#pragma unroll
        for (int j = 0; j < 4; ++j) { a[j] = ((v[j][0] * s0[0] + v[j][1] * s0[1]) + (v[j][2] * s0[2] + v[j][3] * s0[3])) + ((v[j][4] * s1[0] + v[j][5] * s1[1]) + (v[j][6] * s1[2] + v[j][7] * s1[3]));
            a[j] += __shfl_xor(a[j], 1); a[j] += __shfl_xor(a[j], 2); a[j] += __shfl_xor(a[j], 4); }
        const float av = c == 0 ? a[0] : (c == 1 ? a[1] : (c == 2 ? a[2] : a[3]));
        if (c < 4) d.bp[(size_t)kb * (DEPTH * 3 * F2) + r0 + nlo + 8 * c] = av;
        const f32x4 g0 = *(const LAS f32x4*)(shb + CVT_GSB + c * 32), g1 = *(const LAS f32x4*)(shb + CVT_GSB + c * 32 + 16);
#pragma unroll
        for (int j = 0; j < 4; ++j) { v[j][0] *= g0[0]; v[j][1] *= g0[1]; v[j][2] *= g0[2]; v[j][3] *= g0[3]; v[j][4] *= g1[0]; v[j][5] *= g1[1]; v[j][6] *= g1[2]; v[j][7] *= g1[3]; }
    }
#pragma unroll
    for (int j = 0; j < 4; ++j) {
        v4u o; o.x = pk2(v[j][0], v[j][1]); o.y = pk2(v[j][2], v[j][3]); o.z = pk2(v[j][4], v[j][5]); o.w = pk2(v[j][6], v[j][7]);
        *(GAS v4u*)((GAS char*)(d.WT + ((size_t)((r0 >> 8) * d.KT + kb) * 256 + (r0 & 255) + 8 * j) * 64) + (unsigned)(nlo * 64 + 8 * c) * 2u) = o; }
}
__device__ __forceinline__ void p0_mod_item(const float* c, const float* ada_w, float* modp, int item, int lane) {
    const int chunk = item % 72, l = (item / 72) % DEPTH, ks = item / (72 * DEPTH);
    const int j = chunk * 256 + lane * 4, kr = D / KSPLIT, k0 = ks * kr;
    const float* w = ada_w + ((size_t)l * D + k0) * NMOD + j;
    static_assert(D / KSPLIT == 128, "two silu(c) values per lane");
    const float cA = c[k0 + lane], cB = c[k0 + 64 + lane];
    const float sA = cA / (1.f + __expf(-cA)), sB = cB / (1.f + __expf(-cB));
    f32x4 a0 = {0.f, 0.f, 0.f, 0.f}, a1 = a0, a2 = a0, a3 = a0;
#pragma unroll 1
    for (int k = 0; k < kr; k += 16) {
        f32x4 wv[16];
#pragma unroll
        for (int i = 0; i < 16; ++i) wv[i] = *(const f32x4*)(w + (size_t)(k + i) * NMOD);
        const float sv = (k & 64) ? sB : sA;
#pragma unroll
        for (int i = 0; i < 16; i += 4) {
            const int r = (k & 63) + i;
            a0 += wv[i] * __builtin_bit_cast(float, __builtin_amdgcn_readlane(__builtin_bit_cast(int, sv), r)); a1 += wv[i + 1] * __builtin_bit_cast(float, __builtin_amdgcn_readlane(__builtin_bit_cast(int, sv), r + 1));
            a2 += wv[i + 2] * __builtin_bit_cast(float, __builtin_amdgcn_readlane(__builtin_bit_cast(int, sv), r + 2)); a3 += wv[i + 3] * __builtin_bit_cast(float, __builtin_amdgcn_readlane(__builtin_bit_cast(int, sv), r + 3));
        }
    }
    *(f32x4*)(modp + ((size_t)ks * DEPTH + l) * NMOD + j) = (a0 + a1) + (a2 + a3);
}

__device__ __forceinline__ void moba_attn_unit(const bf16_t* __restrict__ Q, const bf16_t* __restrict__ Kb, const bf16_t* __restrict__ VT, const unsigned* __restrict__ sel, bf16_t* __restrict__ O, int gw, int lane) {
    const int lq = lane & 15, quad = lane >> 4;
    const int h = gw & 15, rg = gw >> 4, t0 = rg * 16, qblk = t0 >> 8, tq = t0 + lq;
    const float slope2 = exp2f(-(float)(h + 1) * 0.5f) * LOG2E, sc2 = 0.08838834764831845f * LOG2E;
    bf16x8 qf[4];
#pragma unroll
    for (int kk = 0; kk < 4; ++kk) qf[kk] = *(const bf16x8*)(Q + (size_t)tq * D + h * 128 + kk * 32 + quad * 8);
    const unsigned mymask = sel[tq * 16 + h];
    unsigned um = mymask; um |= __shfl_xor(um, 1); um |= __shfl_xor(um, 2); um |= __shfl_xor(um, 4); um |= __shfl_xor(um, 8);
    um = __builtin_amdgcn_readfirstlane(um) | (1u << qblk);
    float m = -1e30f, l = 0.f; f32x4 o[8];
#pragma unroll
    for (int dt = 0; dt < 8; ++dt) o[dt] = (f32x4){0.f, 0.f, 0.f, 0.f};
    for (int j = 0; j <= qblk; ++j) {
        if (!((um >> j) & 1u)) continue;
        const bool own = (j == qblk), rowsel = own || ((mymask >> j) & 1u);
        const int nsteps = own ? ((t0 + 15 - j * 256) / 32 + 1) : 8;
        for (int st = 0; st < nsteps; ++st) {
            const int kb = j * 256 + st * 32;
            f32x4 s0 = (f32x4){0.f, 0.f, 0.f, 0.f}, s1 = (f32x4){0.f, 0.f, 0.f, 0.f};
#pragma unroll
            for (int kk = 0; kk < 4; ++kk) {
                const bf16x8 a0 = *(const bf16x8*)(Kb + (size_t)(kb + lq) * D + h * 128 + kk * 32 + quad * 8);
                const bf16x8 a1 = *(const bf16x8*)(Kb + (size_t)(kb + 16 + lq) * D + h * 128 + kk * 32 + quad * 8);
                s0 = __builtin_amdgcn_mfma_f32_16x16x32_bf16(a0, qf[kk], s0, 0, 0, 0);
                s1 = __builtin_amdgcn_mfma_f32_16x16x32_bf16(a1, qf[kk], s1, 0, 0, 0);
            }
            float p[8]; float mx = -INFINITY;
#pragma unroll
            for (int i = 0; i < 4; ++i) {
                const int tk0 = kb + quad * 4 + i, tk1 = tk0 + 16;
                float a = s0[i] * sc2 - slope2 * (float)(tq - tk0); if (!rowsel || tk0 > tq) a = -INFINITY;
                float b = s1[i] * sc2 - slope2 * (float)(tq - tk1); if (!rowsel || tk1 > tq) b = -INFINITY;
                p[i] = a; p[4 + i] = b; mx = fmaxf(mx, fmaxf(a, b));
            }
            mx = fmaxf(mx, __shfl_xor(mx, 16)); mx = fmaxf(mx, __shfl_xor(mx, 32));
            const float mn = fmaxf(m, mx), alpha = exp2f(m - mn); m = mn;
            float ps = 0.f;
#pragma unroll
            for (int i = 0; i < 8; ++i) { p[i] = exp2f(p[i] - mn); ps += p[i]; }
            l = l * alpha + ps;
            u32x4 pw; pw.x = pg8::cvt_pk_bf16(p[0], p[1]); pw.y = pg8::cvt_pk_bf16(p[2], p[3]); pw.z = pg8::cvt_pk_bf16(p[4], p[5]); pw.w = pg8::cvt_pk_bf16(p[6], p[7]);
            const bf16x8 pb = __builtin_bit_cast(bf16x8, pw);
#pragma unroll
            for (int dt = 0; dt < 8; ++dt) {
                const bf16_t* vp = VT + (size_t)(h * 128 + dt * 16 + lq) * T + kb + quad * 4;
                const s16x4 x0 = *(const s16x4*)vp, x1 = *(const s16x4*)(vp + 16);
                const bf16x8 va = (bf16x8){x0[0], x0[1], x0[2], x0[3], x1[0], x1[1], x1[2], x1[3]};
                o[dt] = o[dt] * alpha;
                o[dt] = __builtin_amdgcn_mfma_f32_16x16x32_bf16(va, pb, o[dt], 0, 0, 0);
            }
        }
    }
    l += __shfl_xor(l, 16); l += __shfl_xor(l, 32);
    const float inv = 1.0f / l;
#pragma unroll
    for (int dt = 0; dt < 8; ++dt) { u32x2 w; w.x = pg8::cvt_pk_bf16(o[dt][0] * inv, o[dt][1] * inv); w.y = pg8::cvt_pk_bf16(o[dt][2] * inv, o[dt][3] * inv);
        *(u32x2*)(O + (size_t)tq * D + h * 128 + dt * 16 + quad * 4) = w; }
}
__device__ __forceinline__ void swa_attn_unit(const bf16_t* __restrict__ Q, const bf16_t* __restrict__ Kb, const bf16_t* __restrict__ VT, const float* __restrict__ sinks, bf16_t* __restrict__ O, int gw, int lane) {
    const int lq = lane & 15, quad = lane >> 4;
    const int hq = gw & 31, rg = gw >> 5, t0 = rg * 16, hk = hq >> 3, tq = t0 + lq;
    const float slope2 = exp2f(-(float)(hq + 1) * 0.25f) * LOG2E, sc2 = 0.125f * LOG2E, sink2 = sinks[hq] * LOG2E;
    bf16x8 qf[2];
#pragma unroll
    for (int kk = 0; kk < 2; ++kk) qf[kk] = *(const bf16x8*)(Q + (size_t)tq * D + hq * 64 + kk * 32 + quad * 8);
    float p[5][8]; float mx = sink2;
#pragma unroll
    for (int st = 0; st < 5; ++st) {
        const int kb = t0 - 128 + st * 32;
        f32x4 s0 = (f32x4){0.f, 0.f, 0.f, 0.f}, s1 = (f32x4){0.f, 0.f, 0.f, 0.f};
        int r0 = kb + lq, r1 = kb + 16 + lq; r0 = r0 < 0 ? 0 : (r0 > T - 1 ? T - 1 : r0); r1 = r1 < 0 ? 0 : (r1 > T - 1 ? T - 1 : r1);
#pragma unroll
        for (int kk = 0; kk < 2; ++kk) {
            const bf16x8 a0 = *(const bf16x8*)(Kb + (size_t)r0 * 256 + hk * 64 + kk * 32 + quad * 8);
            const bf16x8 a1 = *(const bf16x8*)(Kb + (size_t)r1 * 256 + hk * 64 + kk * 32 + quad * 8);
            s0 = __builtin_amdgcn_mfma_f32_16x16x32_bf16(a0, qf[kk], s0, 0, 0, 0);
            s1 = __builtin_amdgcn_mfma_f32_16x16x32_bf16(a1, qf[kk], s1, 0, 0, 0);
        }
#pragma unroll
        for (int i = 0; i < 4; ++i) {
            const int tk0 = kb + quad * 4 + i, tk1 = tk0 + 16, d0 = tq - tk0, d1 = tq - tk1;
            const float a = (tk0 >= 0 && d0 >= 0 && d0 < 128) ? s0[i] * sc2 - slope2 * (float)d0 : -INFINITY;
            const float b = (tk1 >= 0 && d1 >= 0 && d1 < 128) ? s1[i] * sc2 - slope2 * (float)d1 : -INFINITY;
            p[st][i] = a; p[st][4 + i] = b; mx = fmaxf(mx, fmaxf(a, b));
        }
    }
    mx = fmaxf(mx, __shfl_xor(mx, 16)); mx = fmaxf(mx, __shfl_xor(mx, 32));
    float l = 0.f;
#pragma unroll
    for (int st = 0; st < 5; ++st)
#pragma unroll
        for (int i = 0; i < 8; ++i) { p[st][i] = exp2f(p[st][i] - mx); l += p[st][i]; }
    l += __shfl_xor(l, 16); l += __shfl_xor(l, 32);
    l += exp2f(sink2 - mx);
    f32x4 o[4];
#pragma unroll
    for (int dt = 0; dt < 4; ++dt) o[dt] = (f32x4){0.f, 0.f, 0.f, 0.f};
#pragma unroll
    for (int st = 0; st < 5; ++st) {
        const int kb = t0 - 128 + st * 32;
        u32x4 pw; pw.x = pg8::cvt_pk_bf16(p[st][0], p[st][1]); pw.y = pg8::cvt_pk_bf16(p[st][2], p[st][3]); pw.z = pg8::cvt_pk_bf16(p[st][4], p[st][5]); pw.w = pg8::cvt_pk_bf16(p[st][6], p[st][7]);
        const bf16x8 pb = __builtin_bit_cast(bf16x8, pw);
        int c0 = kb + quad * 4, c1 = c0 + 16; c0 = c0 < 0 ? 0 : (c0 > T - 4 ? T - 4 : c0); c1 = c1 < 0 ? 0 : (c1 > T - 4 ? T - 4 : c1);
#pragma unroll
        for (int dt = 0; dt < 4; ++dt) {
            const bf16_t* vp = VT + (size_t)(hk * 64 + dt * 16 + lq) * T;
            const s16x4 x0 = *(const s16x4*)(vp + c0), x1 = *(const s16x4*)(vp + c1);
            const bf16x8 va = (bf16x8){x0[0], x0[1], x0[2], x0[3], x1[0], x1[1], x1[2], x1[3]};
            o[dt] = __builtin_amdgcn_mfma_f32_16x16x32_bf16(va, pb, o[dt], 0, 0, 0);
        }
    }
    const float inv = 1.0f / l;
#pragma unroll
    for (int dt = 0; dt < 4; ++dt) { u32x2 w; w.x = pg8::cvt_pk_bf16(o[dt][0] * inv, o[dt][1] * inv); w.y = pg8::cvt_pk_bf16(o[dt][2] * inv, o[dt][3] * inv);
        *(u32x2*)(O + (size_t)tq * D + hq * 64 + dt * 16 + quad * 4) = w; }
}

__device__ __forceinline__ void swa_attn_unit2(const bf16_t* __restrict__ Q, const bf16_t* __restrict__ Kb, const bf16_t* __restrict__ VT, const float* __restrict__ sinks, bf16_t* __restrict__ O, int gw0, int gw1, int lane) {
    const int lq = lane & 15, quad = lane >> 4;
    int hq[2], t0[2], hk[2], tq[2]; float slope2[2], sink2[2];
    constexpr float sc2 = 0.125f * LOG2E;
#pragma unroll
    for (int w = 0; w < 2; ++w) { const int gw = w ? gw1 : gw0; hq[w] = gw & 31; t0[w] = (gw >> 5) * 16; hk[w] = hq[w] >> 3; tq[w] = t0[w] + lq;
        slope2[w] = exp2f(-(float)(hq[w] + 1) * 0.25f) * LOG2E; sink2[w] = sinks[hq[w]] * LOG2E; }
    bf16x8 qf[2][2];
#pragma unroll
    for (int w = 0; w < 2; ++w)
#pragma unroll
        for (int kk = 0; kk < 2; ++kk) qf[w][kk] = *(const bf16x8*)(Q + (size_t)tq[w] * D + hq[w] * 64 + kk * 32 + quad * 8);
    float p[2][5][8]; float mx[2] = {sink2[0], sink2[1]};
#pragma unroll
    for (int st = 0; st < 5; ++st) {
        bf16x8 ka[2][2];
        { const int kb = t0[0] - 128 + st * 32;
            int r0 = kb + lq, r1 = kb + 16 + lq; r0 = r0 < 0 ? 0 : (r0 > T - 1 ? T - 1 : r0); r1 = r1 < 0 ? 0 : (r1 > T - 1 ? T - 1 : r1);
#pragma unroll
            for (int kk = 0; kk < 2; ++kk) { ka[kk][0] = *(const bf16x8*)(Kb + (size_t)r0 * 256 + hk[0] * 64 + kk * 32 + quad * 8);
                ka[kk][1] = *(const bf16x8*)(Kb + (size_t)r1 * 256 + hk[0] * 64 + kk * 32 + quad * 8); } }
#pragma unroll
        for (int w = 0; w < 2; ++w) { const int kb = t0[w] - 128 + st * 32;
            f32x4 s0 = (f32x4){0.f, 0.f, 0.f, 0.f}, s1 = (f32x4){0.f, 0.f, 0.f, 0.f};
#pragma unroll
            for (int kk = 0; kk < 2; ++kk) { s0 = __builtin_amdgcn_mfma_f32_16x16x32_bf16(ka[kk][0], qf[w][kk], s0, 0, 0, 0); s1 = __builtin_amdgcn_mfma_f32_16x16x32_bf16(ka[kk][1], qf[w][kk], s1, 0, 0, 0); }
#pragma unroll
            for (int i = 0; i < 4; ++i) {
                const int tk0 = kb + quad * 4 + i, tk1 = tk0 + 16, d0 = tq[w] - tk0, d1 = tq[w] - tk1;
                const float a = (tk0 >= 0 && d0 >= 0 && d0 < 128) ? s0[i] * sc2 - slope2[w] * (float)d0 : -INFINITY;
                const float bq = (tk1 >= 0 && d1 >= 0 && d1 < 128) ? s1[i] * sc2 - slope2[w] * (float)d1 : -INFINITY;
                p[w][st][i] = a; p[w][st][4 + i] = bq; mx[w] = fmaxf(mx[w], fmaxf(a, bq));
            } }
    }
    float l[2];
#pragma unroll
    for (int w = 0; w < 2; ++w) { mx[w] = fmaxf(mx[w], __shfl_xor(mx[w], 16)); mx[w] = fmaxf(mx[w], __shfl_xor(mx[w], 32));
        float ls = 0.f;
#pragma unroll
        for (int st = 0; st < 5; ++st)
#pragma unroll
            for (int i = 0; i < 8; ++i) { p[w][st][i] = exp2f(p[w][st][i] - mx[w]); ls += p[w][st][i]; }
        ls += __shfl_xor(ls, 16); ls += __shfl_xor(ls, 32);
        l[w] = ls + exp2f(sink2[w] - mx[w]); }
    f32x4 o[2][4];
#pragma unroll
    for (int w = 0; w < 2; ++w)
#pragma unroll
        for (int dt = 0; dt < 4; ++dt) o[w][dt] = (f32x4){0.f, 0.f, 0.f, 0.f};
#pragma unroll
    for (int st = 0; st < 5; ++st) {
        s16x4 xv[4][2];
        { const int kb = t0[0] - 128 + st * 32;
            int c0 = kb + quad * 4, c1 = c0 + 16; c0 = c0 < 0 ? 0 : (c0 > T - 4 ? T - 4 : c0); c1 = c1 < 0 ? 0 : (c1 > T - 4 ? T - 4 : c1);
#pragma unroll
            for (int dt = 0; dt < 4; ++dt) { const bf16_t* vp = VT + (size_t)(hk[0] * 64 + dt * 16 + lq) * T; xv[dt][0] = *(const s16x4*)(vp + c0); xv[dt][1] = *(const s16x4*)(vp + c1); } }
#pragma unroll
        for (int w = 0; w < 2; ++w) {
            u32x4 pw; pw.x = pg8::cvt_pk_bf16(p[w][st][0], p[w][st][1]); pw.y = pg8::cvt_pk_bf16(p[w][st][2], p[w][st][3]); pw.z = pg8::cvt_pk_bf16(p[w][st][4], p[w][st][5]); pw.w = pg8::cvt_pk_bf16(p[w][st][6], p[w][st][7]);
            const bf16x8 pb = __builtin_bit_cast(bf16x8, pw);
#pragma unroll
            for (int dt = 0; dt < 4; ++dt) { const s16x4 x0 = xv[dt][0], x1 = xv[dt][1];
                const bf16x8 va = (bf16x8){x0[0], x0[1], x0[2], x0[3], x1[0], x1[1], x1[2], x1[3]};
                o[w][dt] = __builtin_amdgcn_mfma_f32_16x16x32_bf16(va, pb, o[w][dt], 0, 0, 0); } }
    }
#pragma unroll
    for (int w = 0; w < 2; ++w) { const float inv = 1.0f / l[w];
#pragma unroll
        for (int dt = 0; dt < 4; ++dt) { u32x2 wv; wv.x = pg8::cvt_pk_bf16(o[w][dt][0] * inv, o[w][dt][1] * inv); wv.y = pg8::cvt_pk_bf16(o[w][dt][2] * inv, o[w][dt][3] * inv);
            *(u32x2*)(O + (size_t)tq[w] * D + hq[w] * 64 + dt * 16 + quad * 4) = wv; } }
}

__device__ __forceinline__ void swa_attn_unit4(const bf16_t* __restrict__ Q, const bf16_t* __restrict__ Kb, const bf16_t* __restrict__ VT, const float* __restrict__ sinks, bf16_t* __restrict__ O, int gw0, int lane) {
    const int lq = lane & 15, quad = lane >> 4;
    const int hq0 = gw0 & 31, t0 = (gw0 >> 5) * 16, hk = hq0 >> 3, tq = t0 + lq;
    constexpr float sc2 = 0.125f * LOG2E;
    float slope2[4], sink2[4], m[4], l[4]; bf16x8 qf[4][2]; f32x4 o[4][4];
#pragma unroll
    for (int w = 0; w < 4; ++w) { slope2[w] = exp2f(-(float)(hq0 + w + 1) * 0.25f) * LOG2E; sink2[w] = sinks[hq0 + w] * LOG2E; m[w] = sink2[w]; l[w] = 0.f;
#pragma unroll
        for (int kk = 0; kk < 2; ++kk) qf[w][kk] = *(const bf16x8*)(Q + (size_t)tq * D + (hq0 + w) * 64 + kk * 32 + quad * 8);
#pragma unroll
        for (int dt = 0; dt < 4; ++dt) o[w][dt] = (f32x4){0.f, 0.f, 0.f, 0.f}; }
#define SWA4_LOAD(KA, XV, st_) do { const int kb_ = t0 - 128 + (st_) * 32;                                                                                             \
        int r0 = kb_ + lq, r1 = kb_ + 16 + lq; r0 = r0 < 0 ? 0 : (r0 > T - 1 ? T - 1 : r0); r1 = r1 < 0 ? 0 : (r1 > T - 1 ? T - 1 : r1);                                  \
        _Pragma("unroll") for (int kk = 0; kk < 2; ++kk) { KA[kk][0] = *(const bf16x8*)(Kb + (size_t)r0 * 256 + hk * 64 + kk * 32 + quad * 8); KA[kk][1] = *(const bf16x8*)(Kb + (size_t)r1 * 256 + hk * 64 + kk * 32 + quad * 8); } \
        int c0 = kb_ + quad * 4, c1 = c0 + 16; c0 = c0 < 0 ? 0 : (c0 > T - 4 ? T - 4 : c0); c1 = c1 < 0 ? 0 : (c1 > T - 4 ? T - 4 : c1);                                   \
        _Pragma("unroll") for (int dt = 0; dt < 4; ++dt) { const bf16_t* vp = VT + (size_t)(hk * 64 + dt * 16 + lq) * T; XV[dt][0] = *(const s16x4*)(vp + c0); XV[dt][1] = *(const s16x4*)(vp + c1); } } while (0)
    bf16x8 ka[2][2], kan[2][2]; s16x4 xv[4][2], xvn[4][2];
    SWA4_LOAD(ka, xv, 0);
#pragma unroll 1
    for (int st = 0; st < 5; ++st) {
        const int kb = t0 - 128 + st * 32;
        SWA4_LOAD(kan, xvn, st < 4 ? st + 1 : 4);
#pragma unroll
        for (int w = 0; w < 4; ++w) {
            f32x4 s0 = (f32x4){0.f, 0.f, 0.f, 0.f}, s1 = (f32x4){0.f, 0.f, 0.f, 0.f};
#pragma unroll
            for (int kk = 0; kk < 2; ++kk) { s0 = __builtin_amdgcn_mfma_f32_16x16x32_bf16(ka[kk][0], qf[w][kk], s0, 0, 0, 0); s1 = __builtin_amdgcn_mfma_f32_16x16x32_bf16(ka[kk][1], qf[w][kk], s1, 0, 0, 0); }
            float pv[8]; float mloc = -INFINITY;
#pragma unroll
            for (int i = 0; i < 4; ++i) {
                const int tk0 = kb + quad * 4 + i, tk1 = tk0 + 16, d0 = tq - tk0, d1 = tq - tk1;
                pv[i] = (tk0 >= 0 && d0 >= 0 && d0 < 128) ? s0[i] * sc2 - slope2[w] * (float)d0 : -INFINITY;
                pv[4 + i] = (tk1 >= 0 && d1 >= 0 && d1 < 128) ? s1[i] * sc2 - slope2[w] * (float)d1 : -INFINITY;
                mloc = fmaxf(mloc, fmaxf(pv[i], pv[4 + i]));
            }
            mloc = fmaxf(mloc, __shfl_xor(mloc, 16)); mloc = fmaxf(mloc, __shfl_xor(mloc, 32));
            const float mnew = fmaxf(m[w], mloc), alpha = exp2f(m[w] - mnew);
            m[w] = mnew;
            float ps = 0.f;
#pragma unroll
            for (int i = 0; i < 8; ++i) { pv[i] = exp2f(pv[i] - mnew); ps += pv[i]; }
            l[w] = l[w] * alpha + ps;
            u32x4 pw; pw.x = pg8::cvt_pk_bf16(pv[0], pv[1]); pw.y = pg8::cvt_pk_bf16(pv[2], pv[3]); pw.z = pg8::cvt_pk_bf16(pv[4], pv[5]); pw.w = pg8::cvt_pk_bf16(pv[6], pv[7]);
            const bf16x8 pb = __builtin_bit_cast(bf16x8, pw);
#pragma unroll
            for (int dt = 0; dt < 4; ++dt) { const s16x4 x0 = xv[dt][0], x1 = xv[dt][1];
                const bf16x8 va = (bf16x8){x0[0], x0[1], x0[2], x0[3], x1[0], x1[1], x1[2], x1[3]};
                o[w][dt] = __builtin_amdgcn_mfma_f32_16x16x32_bf16(va, pb, o[w][dt] * alpha, 0, 0, 0); }
        }
#pragma unroll
        for (int kk = 0; kk < 2; ++kk) { ka[kk][0] = kan[kk][0]; ka[kk][1] = kan[kk][1]; }
#pragma unroll
        for (int dt = 0; dt < 4; ++dt) { xv[dt][0] = xvn[dt][0]; xv[dt][1] = xvn[dt][1]; }
    }
#undef SWA4_LOAD
#pragma unroll
    for (int w = 0; w < 4; ++w) { float ls = l[w]; ls += __shfl_xor(ls, 16); ls += __shfl_xor(ls, 32); ls += exp2f(sink2[w] - m[w]);
        const float inv = 1.0f / ls;
#pragma unroll
        for (int dt = 0; dt < 4; ++dt) { u32x2 wv; wv.x = pg8::cvt_pk_bf16(o[w][dt][0] * inv, o[w][dt][1] * inv); wv.y = pg8::cvt_pk_bf16(o[w][dt][2] * inv, o[w][dt][3] * inv);
            *(u32x2*)(O + (size_t)tq * D + (hq0 + w) * 64 + dt * 16 + quad * 4) = wv; } }
}

__global__ void __launch_bounds__(NWAVES * 64, 2) mk_fwd(Args args) {
    extern __shared__ __attribute__((aligned(16))) unsigned char lds_raw[];
    LAS unsigned char* lds = (LAS unsigned char*)lds_raw;
    volatile LAS unsigned* MISC = (volatile LAS unsigned*)(lds + MISC_OFF);
    const int tid = threadIdx.x, lane = tid & 63, wave = __builtin_amdgcn_readfirstlane(tid >> 6);
    const int G = gridDim.x, bx = blockIdx.x;
    const int vcu = (G % 8 == 0) ? (bx % 8) * (G / 8) + bx / 8 : bx;
    const int gw = vcu * NWAVES + wave, NGW = G * NWAVES;
    unsigned char* const ws0 = args.ws;
    for (int u = tid; u < (LDS_BYTES - LDSCTL_OFF) / 4; u += NWAVES * 64) ((LAS unsigned*)(lds + LDSCTL_OFF))[u] = 0u;
    __syncthreads();
    XcdBarrier bar; { unsigned char* ws = ws0; bar = xcd_barrier_post(W_ctl + 4096, MISC + 8); }
#define GRID_BAR() do { XcdBarrier b_ = bar; { WS_FRESH(); b_.bar = W_ctl + 4096; b_.x = xb_xcc_id(); } xcd_barrier(b_); } while (0)
    const float* x_in = args.in[0]; const float* c_in = args.in[1]; const float* norm_g = args.in[2]; const float* ada_w = args.in[3]; const float* ada_b = args.in[4];
    const float* w_gate = args.in[5]; const float* w_up = args.in[6]; const float* w_down = args.in[7]; const float* moba_qkv = args.in[8]; const float* moba_o = args.in[9];
    const float* pool_w = args.in[10]; const float* pool_scale = args.in[11]; const float* swa_qkv = args.in[12]; const float* swa_o = args.in[13]; const float* swa_sinks = args.in[14];
    const float* final_g = args.in[15];

    {
        WS_FRESH();
        LAS float* scr = (LAS float*)(lds + RING_OFF + wave * 16384);
        constexpr int I_MOD = KSPLIT * DEPTH * 72, I_FFN = 5632, I_MQ = 32 * 192, I_MO = 32 * 64;
        constexpr int NITEMS = I_MOD + 2 * I_FFN;
        (void)I_MO; (void)I_MQ;
        for (int it = gw; it < NITEMS; it += NGW) {
            int r = it;
            if (r < I_MOD) { p0_mod_item(c_in, ada_w, W_modp, r, lane); continue; } r -= I_MOD;
            if (r < I_FFN) p0_transpose_item(w_gate, D, F, W_wgu, 1, 0, scr, r, lane);
            else p0_transpose_item(w_up, D, F, W_wgu, 2, 0, scr, r - I_FFN, lane);
        }
    }
    GRID_BAR();
    { WS_FRESH();
    for (int idx = (vcu * NWAVES * 64) + tid; idx < DEPTH * 3 * D; idx += G * NWAVES * 64) {
        const int c = idx % D, sub = idx / D, l = sub / 3, s = sub % 3;
        const size_t i0 = (size_t)l * NMOD + (3 * s) * D + c;
        float sh = ada_b[i0], sc = ada_b[i0 + D], gt = ada_b[i0 + 2 * D];
        for (int ks = 0; ks < KSPLIT; ++ks) { const float* mp = W_modp + (size_t)ks * DEPTH * NMOD + i0; sh += mp[0]; sc += mp[D]; gt += mp[2 * D]; }
        W_shv[idx] = sh; W_gs[idx] = norm_g[idx] * (1.f + sc);
        float cr = gt * (s == 1 ? 1.f : 0.5f); if (s == 1 && (l % 3) == 1) cr *= pool_scale[(l / 3) * D + c];
        W_cres[idx] = cr;
    } }
    GRID_BAR();
    { WS_FRESH();
    for (int sub = 0; sub < 1; ++sub) {
        const int l = sub / 3, s = sub % 3, kind = l % 3, j = l / 3;
        const bf16_t* Wt; int nrows;
        if (s != 1) { Wt = W_wgu + (size_t)(l * 2 + (s >> 1)) * F2 * D; nrows = F2; }
        else if (kind == 0) { Wt = W_mqkv + (size_t)j * 3 * D * D; nrows = 3 * D; }
        else if (kind == 2) { Wt = W_sqkv; nrows = 2560; }
        else { Wt = nullptr; nrows = 0; }
        const float* sh = W_shv + (size_t)sub * D;
        for (int n = gw; n < nrows; n += NGW) {
            float a = 0.f;
#pragma unroll
            for (int k = lane * 8; k < D; k += 512) {
                const bf16x8 wv = *(const bf16x8*)(Wt + ((size_t)((n >> 8) * (D / 64) + (k >> 6)) * 256 + (n & 255)) * 64 + (k & 63)); const f32x4 s0 = *(const f32x4*)(sh + k), s1 = *(const f32x4*)(sh + k + 4);
                a += s0[0] * bf2f((unsigned short)wv[0]) + s0[1] * bf2f((unsigned short)wv[1]) + s0[2] * bf2f((unsigned short)wv[2]) + s0[3] * bf2f((unsigned short)wv[3])
                   + s1[0] * bf2f((unsigned short)wv[4]) + s1[1] * bf2f((unsigned short)wv[5]) + s1[2] * bf2f((unsigned short)wv[6]) + s1[3] * bf2f((unsigned short)wv[7]);
            }
            a = wave_sum(a);
            if (lane == 0) W_bias[(size_t)sub * F2 + n] = a;
        }
    }
    for (int t = gw; t < T; t += NGW) {
        float ssq = 0.f;
#pragma unroll
        for (int c = lane * 4; c < D; c += 256) { const f32x4 v = *(const f32x4*)(x_in + (size_t)t * D + c); const f32x4 g = *(const f32x4*)(W_gs + c);
            ssq += (v[0] * v[0] + v[1] * v[1]) + (v[2] * v[2] + v[3] * v[3]);
            u32x2 o; o.x = pg8::cvt_pk_bf16(v[0] * g[0], v[1] * g[1]); o.y = pg8::cvt_pk_bf16(v[2] * g[2], v[3] * g[3]); *(u32x2*)(W_ap + ((size_t)((t >> 8) * (D / 64) + (c >> 6)) * 256 + (t & 255)) * 64 + (c & 63)) = o;
            u32x2 xo; xo.x = pg8::cvt_pk_bf16(v[0], v[1]); xo.y = pg8::cvt_pk_bf16(v[2], v[3]); *(u32x2*)(W_x + XIDX(t, c)) = xo; }
        ssq = wave_sum(ssq);
        if (lane < 32) W_ss[(size_t)t * 32 + lane] = lane == 0 ? ssq : 0.f;
    } }
    GRID_BAR();

    for (int sub = 0; sub < DEPTH * 3; ++sub) {
        WS_FRESH();
        const int l = sub / 3, s = sub % 3, kind = l % 3, j = l / 3;
        const bool hostsub = (G == 256) && (sub == 0 || sub == 2 || sub == 3 || sub == 5 || sub == 6 || sub == 8);
        const float* bias = W_bias + (size_t)sub * F2;
        const bf16_t* rA; const bf16_t* rB; int rK, rlda, rgrp, rtile = 0;
        if (s != 1) {
            const size_t wi = (size_t)(l * 2 + (s >> 1));
            const bool convwg = hostsub && bx >= G - 16;
            if (!convwg) {
                pg8::Gemm g{sub == 0 ? W_ap : W_x, W_wgu + wi * F2 * D, T, F2, D, D, 0, 1, 1}; pg8::StaticOrder S; S.init(T, F2, hostsub ? G - 16 : G, bx);
                const float* rtab = (const float*)((char*)lds_raw + LDSCTL_OFF + 8192); const float* btab = rtab + 6 * 256;
                {
                    FRESH_TID();
                    LAS float* rt = (LAS float*)(lds + LDSCTL_OFF + 8192); LAS float* bt = rt + 6 * 256;
                    f32x4 sv[6][4]; float bv[6]; pg8::Unit uu[6]; bool ok[6];
#pragma unroll
                    for (int i = 0; i < 6; ++i) { ok[i] = S.next(i, uu[i]); const int pm_ = ok[i] ? uu[i].pm : 0, pn_ = ok[i] ? uu[i].pn : 0;
                        const f32x4* p = (const f32x4*)(W_ss + ((size_t)pm_ * 256 + (ftid >> 1)) * 32 + (ftid & 1) * 16);
                        sv[i][0] = p[0]; sv[i][1] = p[1]; sv[i][2] = p[2]; sv[i][3] = p[3];
                        bv[i] = bias[pn_ * 256 + (ftid & 255)]; }
                    __syncthreads();
#pragma unroll
                    for (int i = 0; i < 6; ++i) { const f32x4 t4 = (sv[i][0] + sv[i][1]) + (sv[i][2] + sv[i][3]); float s1 = (t4[0] + t4[1]) + (t4[2] + t4[3]); s1 += __shfl_xor(s1, 1);
                        if ((ftid & 1) == 0) rt[i * 256 + (ftid >> 1)] = __builtin_amdgcn_rsqf(s1 * (1.0f / D) + EPS);
                        if (ftid < 256) bt[i * 256 + ftid] = bv[i]; }
                    __syncthreads();
                }
                pg8::EpiGU E{rtab, btab, W_act};
                { FRESH_TID(); pg8::gemm_phase<pg8::EpiGU, pg8::StaticOrder, true>(lds + RING_OFF, g, S, E, ftid); }
            }
            rA = W_act; rB = W_wd + wi * D * F; rK = F; rlda = F; rgrp = 0; rtile = 1;
        } else if (kind == 0 || kind == 2) {
            const bool moba = (kind == 0);
            const bf16_t* Wt = moba ? W_mqkv + (size_t)j * 3 * D * D : W_sqkv; const int N = moba ? 3 * D : 2560;
            pg8::Gemm g{W_x, Wt, T, N, D, D, 0, 1, 1}; pg8::StaticOrder S; S.init(T, N, G, bx);
            pg8::EpiQKV E{W_ss, bias, W_qb, moba ? nullptr : W_vtb, moba ? W_kmp : nullptr, W_ctl + 12288 + j * 64, D, moba ? D : 256, moba ? 1 : 0};
            { FRESH_TID(); pg8::gemm_phase<pg8::EpiQKV, pg8::StaticOrder, true>(lds + RING_OFF, g, S, E, ftid); }
            GRID_BAR();
            if (moba) {
                FRESH_TID();
                LAS float* km = (LAS float*)(lds + RING_OFF + 67584);
                LAS unsigned* picks = (LAS unsigned*)(lds + RING_OFF + 84480);
                int item0 = vcu; asm volatile("" : "+s"(item0));
#pragma unroll 1
                for (int it = item0; it < 256; it += G)
#pragma unroll 1
                    for (int ps = 0; ps < 2; ++ps) {
                        const int h_ = it >> 4, y_ = it & 15, qb_ = ps ? 31 - y_ : y_;
                        const float* kmp_h = W_kmp + h_ * 128;
                        __syncthreads();
                        for (int e = ftid; e < qb_ * 32; e += NWAVES * 64) { const int n = e >> 5, d4 = (e & 31) * 4;
                            const f32x4 a = *(const f32x4*)(kmp_h + (size_t)n * D + d4), bq = *(const f32x4*)(kmp_h + (size_t)(32 + n) * D + d4);
                            *(LAS f32x4*)(km + n * 136 + (d4 >> 6) * 68 + (d4 & 63)) = a + bq; }
                        __syncthreads();
                        const int row = ftid >> 1, half = ftid & 1;
                        float q[64];
                        { const bf16_t* qp = W_qb + ((size_t)h_ * T + qb_ * 256 + row) * 128 + half * 64;
#pragma unroll
                          for (int i = 0; i < 8; ++i) { const bf16x8 v = *(const bf16x8*)(qp + i * 8);
#pragma unroll
                              for (int jj = 0; jj < 8; ++jj) q[i * 8 + jj] = bf2f((unsigned short)v[jj]); } }
                        float v0 = -INFINITY, v1 = -INFINITY, v2 = -INFINITY; int i0 = -1, i1 = -1, i2 = -1;
#pragma unroll 1
                        for (int n = 0; n < qb_; ++n) {
                            const LAS float* kp = km + n * 136 + half * 68;
                            float a0 = 0.f, a1 = 0.f, a2 = 0.f, a3 = 0.f;
#pragma unroll
                            for (int jj = 0; jj < 64; jj += 4) { const f32x4 kv = *(const LAS f32x4*)(kp + jj);
                                a0 += q[jj] * kv[0]; a1 += q[jj + 1] * kv[1]; a2 += q[jj + 2] * kv[2]; a3 += q[jj + 3] * kv[3]; }
                            float gsc = (a0 + a1) + (a2 + a3); gsc += __shfl_xor(gsc, 1);
                            if (gsc > v0) { v2 = v1; i2 = i1; v1 = v0; i1 = i0; v0 = gsc; i0 = n; }
                            else if (gsc > v1) { v2 = v1; i2 = i1; v1 = gsc; i1 = n; }
                            else if (gsc > v2) { v2 = gsc; i2 = n; }
                        }
                        {
                            float l1 = 0.f;
#pragma unroll
                            for (int i = 0; i < 64; ++i) l1 += fabsf(q[i]);
                            l1 += __shfl_xor(l1, 1);
                            const float kmaxv = __uint_as_float(__hip_atomic_load(W_ctl + 12288 + j * 64 + h_, __ATOMIC_RELAXED, __HIP_MEMORY_SCOPE_AGENT));
                            const float Bq = mb::SCALE * l1 * kmaxv * 1.02f, slope = exp2f(-(float)(h_ + 1) * 0.5f);
                            const float Dz = (2.f * Bq + 104.f) / slope, posf = (float)(qb_ * 256 + row - 255);
                            if (i0 >= 0 && posf - (float)(i0 * 256) > Dz) i0 = -1;
                            if (i1 >= 0 && posf - (float)(i1 * 256) > Dz) i1 = -1;
                            if (i2 >= 0 && posf - (float)(i2 * 256) > Dz) i2 = -1;
                        }
                        if (half == 0) { picks[row] = (unsigned)(i0 & 255) | ((unsigned)(i1 & 255) << 8) | ((unsigned)(i2 & 255) << 16);
                            int* lc = W_loc + ((size_t)h_ * T + qb_ * 256 + row) * 4;
                            if (i0 < 0) lc[0] = -1; if (i1 < 0) lc[1] = -1; if (i2 < 0) lc[2] = -1; }
                        __syncthreads();
#pragma unroll 1
                        for (int n = wave; n < qb_; n += NWAVES) {
                            int base = 0; int* sg = W_seg + (size_t)((h_ * 32 + n) * 32 + qb_) * 256;
#pragma unroll 1
                            for (int p4 = 0; p4 < 4; ++p4) { const int r = p4 * 64 + flane; const unsigned pk = picks[r];
                                const int sl = (pk & 255u) == (unsigned)n ? 0 : (((pk >> 8) & 255u) == (unsigned)n ? 1 : (((pk >> 16) & 255u) == (unsigned)n ? 2 : -1));
                                const unsigned long long bal = __ballot(sl >= 0);
                                const int rank = __popcll(bal & ((1ull << flane) - 1ull));
                                if (sl >= 0) sg[base + rank] = (qb_ * 256 + r) | (sl << 16);
                                base += __popcll(bal); }
                            if (flane == 0) W_cnt[(h_ * 32 + n) * 32 + qb_] = base;
                        }
                    }
                GRID_BAR();
            } else {
                FRESH_TID(); const int lane = flane;
#pragma unroll 1
                for (int u = gw; u < (T / 16) * 8; u += NGW) swa_attn_unit4(W_qb, W_kb, W_vtb, swa_sinks, W_ao, 4 * u, lane);
            }
            rA = W_ao; rB = moba ? W_mo + (size_t)j * D * D : W_so; rK = D; rlda = D; rgrp = 0;
        } else {
            const bf16_t* xc = W_x; const float* gsv = W_gs + (size_t)sub * D;
#define XLD4(p_) ({ const u32x2 q_ = *(const u32x2*)(p_); (f32x4){__builtin_bit_cast(float, q_.x << 16), __builtin_bit_cast(float, q_.x & 0xFFFF0000u), __builtin_bit_cast(float, q_.y << 16), __builtin_bit_cast(float, q_.y & 0xFFFF0000u)}; })
            LAS float* rtab = (LAS float*)(lds + RING_OFF);
            FRESH_TID(); const int tid = ftid;
            for (int un = vcu; un < T / 32; un += G) {
                const int r0 = un * 32;
                __syncthreads();
                if (tid < 47) { const int r = r0 - 15 + tid; float sv = 0.f;
                    if (r >= 0) { const f32x4* p = (const f32x4*)(W_ss + (size_t)r * 32);
#pragma unroll
                        for (int q = 0; q < 8; ++q) { const f32x4 v = p[q]; sv += (v[0] + v[1]) + (v[2] + v[3]); } }
                    rtab[tid] = 1.0f / sqrtf(sv * (1.0f / D) + EPS); }
                __syncthreads();
                const int c = tid * 4, wsz = 2 << (c >> 9);
                const f32x4 g4 = *(const f32x4*)(gsv + c);
                f32x4 sum = {0.f, 0.f, 0.f, 0.f};
#pragma unroll 5
                for (int r = r0 - wsz + 1; r < r0; ++r) if (r >= 0) sum += XLD4(xc + XIDX(r, c)) * rtab[r - r0 + 15];
#pragma unroll 1
                for (int rb = r0; rb < r0 + 32; rb += 8) {
                    f32x4 cur8[8], old8[8];
#pragma unroll
                    for (int i = 0; i < 8; ++i) { const int r = rb + i, lo = r - wsz + 1;
                        cur8[i] = XLD4(xc + XIDX(r, c));
                        old8[i] = lo >= 0 ? XLD4(xc + XIDX(lo, c)) : (f32x4){0.f, 0.f, 0.f, 0.f}; }
#pragma unroll
                    for (int i = 0; i < 8; ++i) { const int r = rb + i, lo = r - wsz + 1;
                        const f32x4 cur = cur8[i] * rtab[r - r0 + 15];
                        sum += cur;
                        const float icnt = 1.0f / (float)(lo < 0 ? r + 1 : wsz);
                        const f32x4 pv = g4 * (sum * icnt - cur);
                        u32x2 o; o.x = pg8::cvt_pk_bf16(pv[0], pv[1]); o.y = pg8::cvt_pk_bf16(pv[2], pv[3]); *(u32x2*)(W_ao + (size_t)r * D + c) = o;
                        if (lo >= 0) sum -= old8[i] * rtab[lo - r0 + 15]; }
                }
            }
#undef XLD4
            rA = W_ao; rB = W_pw; rK = 512; rlda = D; rgrp = 1;
        }
        const bool mobasub = (s == 1 && kind == 0);
        const bool hasq = (sub == 1) || (G != 256 && sub == 10);
        const bool roleA = !hasq || (vcu & 1) == 0;
#pragma unroll 1
        for (int st = 0; st < 2; ++st) {
        if (mobasub && ((st == 0) == roleA)) {
            FRESH_TID();
            char* ldsg = (char*)lds_raw + RING_OFF;
            char* ctl = (char*)lds_raw + LDSCTL_OFF;
            int* rowtab = (int*)(ctl + 8192);
            int* cq = (int*)(ctl + 10240);
            LAS int* bc = (LAS int*)(lds + LDSCTL_OFF + 10368);
            LAS int* nrow_t = (LAS int*)(lds + LDSCTL_OFF + 10496);
            LAS int* ist_t = (LAS int*)(lds + LDSCTL_OFF + 12544);
            float* wscr = (float*)(ctl + 14848);
            __syncthreads();
            {
                const int hn = ftid, n = hn & 31; int tot = 0; const int* cp = W_cnt + hn * 32;
#pragma unroll
                for (int qx = 0; qx < 32; ++qx) { const int c = cp[qx]; tot += (qx > n) ? c : 0; }
                nrow_t[hn] = tot; const int nch = (256 + tot + 511) >> 9;
                int sc = nch;
#pragma unroll
                for (int o = 1; o < 64; o <<= 1) { const int v = __shfl_up(sc, o); if (flane >= o) sc += v; }
                if (flane == 63) bc[wave] = sc;
                __syncthreads();
                int woff = 0;
#pragma unroll
                for (int w = 0; w < NWAVES; ++w) woff += (w < wave) ? bc[w] : 0;
                ist_t[hn] = woff + sc - nch;
                if (ftid == NWAVES * 64 - 1) ist_t[512] = woff + sc;
            }
            unsigned* actr = W_ctl + 8192 + 512 + j * 32;
            if (ftid == 0) bc[8] = (int)__hip_atomic_fetch_add(actr, 1u, __ATOMIC_RELAXED, __HIP_MEMORY_SCOPE_AGENT);
            __syncthreads();
            const int NU = __builtin_amdgcn_readfirstlane(ist_t[512]);
#pragma unroll 1
            for (;;) {
                const int unit = __builtin_amdgcn_readfirstlane(bc[8]);
                if (unit >= NU) break;
                int lo = 0, hi = 512;
#pragma unroll 1
                while (hi - lo > 1) { const int mid = (lo + hi) >> 1; if (ist_t[mid] <= unit) lo = mid; else hi = mid; }
                const int hn = __builtin_amdgcn_readfirstlane(lo), c = unit - __builtin_amdgcn_readfirstlane(ist_t[hn]);
                const int h_ = hn >> 5, n_ = hn & 31;
                int pend = NU; if (ftid == 0) pend = (int)__hip_atomic_fetch_add(actr, 1u, __ATOMIC_RELAXED, __HIP_MEMORY_SCOPE_AGENT);
                mb::UnitRef u;
                u.Q = W_qb + (size_t)h_ * T * 128; u.K = W_kb + (size_t)h_ * T * 128; u.V = W_vb + (size_t)h_ * T * 128;
                u.O = W_part + (size_t)unit * 512 * 128; u.ML = W_ml + (size_t)unit * 1024; u.LOC = W_loc + (size_t)h_ * T * 4;
                u.seg = W_seg + (size_t)hn * 32 * 256; u.cnt = W_cnt + hn * 32;
                u.ab = exp2f(-(float)(h_ + 1) * 0.5f) * (1.0f / mb::SCALE); u.n = n_; u.c = c; u.L = __builtin_amdgcn_readfirstlane(nrow_t[hn]); u.unit512 = unit * 512;
                mb::moba_unit(u, ldsg, rowtab, cq, wscr, (int*)(ctl + 10368 + 32), pend, wave);
            }
        }
        if ((st == 0 && (hostsub || (G != 256 && sub == 0))) || (mobasub && hasq && ((st == 0) != roleA))) {
                        constexpr int DQ_MO0 = 2048, DQ_FFN = 21 * 5632, DQ_MQ = 6144, DQ_MO = 2048, DQ_PW = 512, DQ_SQ = 2560, DQ_SO = 2048, DQ_N = DQ_MO0 + DQ_FFN + DQ_MQ + DQ_MO + DQ_PW + DQ_SQ + DQ_SO;
                        static_assert(DQ_N % 8 == 0, "whole chunks");
                        constexpr int DQ_WD0 = 5632, DQ_MQ0 = 6144, DQ_EARLY = DQ_WD0 + DQ_MQ0;
                        constexpr int DQ_LATE = 3 * 5632, DQ_LATE0 = DQ_MO0 + 18 * 5632;
                        static_assert(DQ_LATE % 8 == 0 && (DQ_N - DQ_LATE) % 8 == 0, "whole chunks");
                        constexpr int DQ_F0 = DQ_MO0, DQ_AFT = DQ_MO0 + DQ_FFN;
                        int s0, n0, s1 = 0, n1 = 0;
                        if (G != 256) { if (sub == 0) { s0 = DQ_N; n0 = DQ_EARLY; } else if (sub == 1) { s0 = 0; n0 = DQ_LATE0; s1 = DQ_LATE0 + DQ_LATE; n1 = DQ_N - s1; } else { s0 = DQ_LATE0; n0 = DQ_LATE; } }
                        else if (sub == 0) { s0 = DQ_N; n0 = DQ_EARLY; }
                        else if (sub == 1) { s0 = 0; n0 = DQ_F0 + 9 * 5632; s1 = DQ_AFT + DQ_MQ + DQ_MO; n1 = DQ_PW; }
                        else if (sub == 2) { s0 = DQ_F0 + 9 * 5632; n0 = 3 * 5632; }
                        else if (sub == 3) { s0 = DQ_AFT + DQ_MQ + DQ_MO + DQ_PW; n0 = DQ_SQ + DQ_SO; s1 = DQ_F0 + 12 * 5632; n1 = 2 * 5632; }
                        else if (sub == 5) { s0 = DQ_F0 + 14 * 5632; n0 = 3 * 5632; }
                        else if (sub == 6) { s0 = DQ_F0 + 17 * 5632; n0 = 5632; s1 = DQ_AFT; n1 = DQ_MQ + DQ_MO; }
                        else { s0 = DQ_LATE0; n0 = DQ_LATE; }
                        const int nchunks = (n0 + n1) / 8;
                        unsigned* qctr = W_ctl + 8192 + sub * 32;
                        FRESH_TID(); __syncthreads();
                        float* bpp = W_biasp;
                        constexpr int DQ_C = 8;
#define DQ_DESC(Dd, r_) do { int r = (r_); r = r < n0 ? s0 + r : s1 + (r - n0); Dd.sh = nullptr; Dd.bp = bpp; Dd.roff = 0; Dd.mode = 0;                           \
        if (r < DQ_MO0) { Dd.W = moba_o; Dd.WT = W_mo; Dd.N = D; Dd.KT = D / 64; Dd.kb = r / (D / 32); Dd.nb = r % (D / 32); } else { r -= DQ_MO0;                                         \
        if (r < DQ_FFN) { const int mi = r / 5632, ri = r % 5632, wi = 1 + mi / 3, typ = mi % 3; const int sb = (wi >> 1) * 3 + ((wi & 1) ? 2 : 0);                                         \
            if (typ == 2) { Dd.W = w_down + (size_t)wi * F * D; Dd.WT = W_wd + (size_t)wi * D * F; Dd.N = D; Dd.KT = F / 64; Dd.kb = ri / (D / 32); Dd.nb = ri % (D / 32); }                \
            else { Dd.W = (typ == 0 ? w_gate : w_up) + (size_t)wi * D * F; Dd.WT = W_wgu + (size_t)wi * F2 * D; Dd.N = F; Dd.KT = D / 64; Dd.kb = ri / (F / 32); Dd.nb = ri % (F / 32);     \
                   Dd.mode = 1 + typ; Dd.sh = W_shv + (size_t)sb * D; Dd.bp = bpp + (size_t)sb * F2; }                                                                                        \
        } else { r -= DQ_FFN; Dd.KT = D / 64;                                                                                                                                              \
          if (r < DQ_MQ) { Dd.W = moba_qkv + (size_t)D * 3 * D; Dd.WT = W_mqkv + (size_t)3 * D * D; Dd.N = 3 * D; Dd.kb = r / (3 * D / 32); Dd.nb = r % (3 * D / 32); Dd.sh = W_shv + (size_t)10 * D; Dd.bp = bpp + (size_t)10 * F2; } \
          else { r -= DQ_MQ;                                                                                                                                                               \
          if (r < DQ_MO) { Dd.W = moba_o + (size_t)D * D; Dd.WT = W_mo + (size_t)D * D; Dd.N = D; Dd.kb = r / (D / 32); Dd.nb = r % (D / 32); }                                            \
          else { r -= DQ_MO;                                                                                                                                                               \
          if (r < DQ_PW) { const int g = r / 128, ri = r % 128; Dd.W = pool_w + (size_t)g * 512 * 512; Dd.WT = W_pw; Dd.N = 512; Dd.KT = 512 / 64; Dd.roff = g * 512; Dd.kb = ri / 16; Dd.nb = ri % 16; } \
          else { r -= DQ_PW;                                                                                                                                                               \
          if (r < DQ_SQ) { Dd.W = swa_qkv; Dd.WT = W_sqkv; Dd.N = 2560; Dd.kb = r / 80; Dd.nb = r % 80; Dd.sh = W_shv + (size_t)7 * D; Dd.bp = bpp + (size_t)7 * F2; }                      \
          else { r -= DQ_SQ;                                                                                                                                                               \
          if (r < DQ_SO) { Dd.W = swa_o; Dd.WT = W_so; Dd.N = D; Dd.kb = r / (D / 32); Dd.nb = r % (D / 32); }                                                                             \
          else { r -= DQ_SO;                                                                                                                                                               \
          if (r < DQ_WD0) { Dd.W = w_down; Dd.WT = W_wd; Dd.N = D; Dd.KT = F / 64; Dd.kb = r / (D / 32); Dd.nb = r % (D / 32); }                                                           \
          else { r -= DQ_WD0; Dd.W = moba_qkv; Dd.WT = W_mqkv; Dd.N = 3 * D; Dd.kb = r / (3 * D / 32); Dd.nb = r % (3 * D / 32); Dd.sh = W_shv + (size_t)D; Dd.bp = bpp + (size_t)F2; } } } } } } } } } while (0)
                        unsigned zoff = 0u; asm volatile("" : "+v"(zoff));
                        int chunk_v = 0; if (flane == 0) chunk_v = (int)__hip_atomic_fetch_add(qctr + zoff, 1u, __ATOMIC_RELAXED, __HIP_MEMORY_SCOPE_AGENT);
                        int chunk_nx = __builtin_amdgcn_readfirstlane(chunk_v), chunk = 0, k8 = DQ_C; bool pend = false;
#define DQ_NEXT(have_, r_) do { if (k8 == DQ_C) { chunk = chunk_nx; k8 = 0;                                                                                                              \
            if (chunk < nchunks) { if (flane == 0) chunk_v = (int)__hip_atomic_fetch_add(qctr + zoff, 1u, __ATOMIC_RELAXED, __HIP_MEMORY_SCOPE_AGENT); pend = true; } }                    \
        have_ = chunk < nchunks; r_ = chunk * DQ_C + k8; ++k8; } while (0)
#define DQ_CAPTURE() do { if (pend) { chunk_nx = __builtin_amdgcn_readfirstlane(chunk_v); pend = false; } } while (0)
                        bool haveA, haveB; int rA, rB;
                        LAS unsigned char* cb0 = lds + RING_OFF + wave * 16384; LAS unsigned char* cb1 = cb0 + 8192;
                        LAS unsigned char* sb0 = lds + LDSCTL_OFF + 4096 + wave * 512; LAS unsigned char* sb1 = sb0 + 256;
#define DQ_ISSUE(r_, b_, s_) do { int rr_ = __builtin_amdgcn_readfirstlane(r_); asm volatile("" : "+s"(rr_)); CvtD d_; DQ_DESC(d_, rr_); cvt_issue(d_, flane, b_, s_); } while (0)
#define DQ_FIN(r_, b_, s_) do { int rr_ = __builtin_amdgcn_readfirstlane(r_); asm volatile("" : "+s"(rr_)); CvtD d_; DQ_DESC(d_, rr_); cvt_fin(d_, flane, b_, s_); } while (0)
#define DQ_STEP(have_, r_, b_, s_) do { if (have_) { DQ_ISSUE(r_, b_, s_); asm volatile("s_waitcnt vmcnt(8)" ::: "memory"); DQ_CAPTURE(); } else asm volatile("s_waitcnt vmcnt(0)" ::: "memory"); } while (0)
                        DQ_NEXT(haveA, rA);
                        if (haveA) DQ_ISSUE(rA, cb0, sb0);
                        while (haveA) {
                            DQ_NEXT(haveB, rB);
                            DQ_STEP(haveB, rB, cb1, sb1); DQ_FIN(rA, cb0, sb0);
                            if (!haveB) break;
                            DQ_NEXT(haveA, rA);
                            DQ_STEP(haveA, rA, cb0, sb0); DQ_FIN(rB, cb1, sb1);
                        }
#undef DQ_ISSUE
#undef DQ_FIN
#undef DQ_STEP
#undef DQ_CAPTURE
#undef DQ_DESC
#undef DQ_NEXT
        }
        }
        if (mobasub) {
            GRID_BAR();
            FRESH_TID();
            constexpr float C2 = 1.4426950408889634f * mb::SCALE;
            const int l16 = ftid & 15;
#pragma unroll 1
            for (int rb = vcu * 128 + (ftid >> 4); rb < 16 * T; rb += G * 128) {
                u32x4 lc[4];
#pragma unroll
                for (int k = 0; k < 4; ++k) lc[k] = *(const u32x4*)(W_loc + (size_t)(rb + 32 * k) * 4);
                float mm[4][4], ll[4][4]; bf16x8 pv[4][4];
#pragma unroll
                for (int k = 0; k < 4; ++k)
#pragma unroll
                    for (int sl = 0; sl < 4; ++sl) { const int li = (int)lc[k][sl]; const bool ok = li >= 0; const int lx = ok ? li : 0;
                        const float2 ml = *(const float2*)(W_ml + (size_t)lx * 2); mm[k][sl] = ok ? ml.x : -1e30f; ll[k][sl] = ok ? ml.y : 0.f;
                        const bf16x8 pl = *(const bf16x8*)(W_part + (size_t)lx * 128 + l16 * 8); pv[k][sl] = ok ? pl : (bf16x8){0, 0, 0, 0, 0, 0, 0, 0}; }
#pragma unroll
                for (int k = 0; k < 4; ++k) {
                    const int rix = rb + 32 * k, h_ = rix >> 13, t = rix & (T - 1);
                    const float M = fmaxf(fmaxf(mm[k][0], mm[k][1]), fmaxf(mm[k][2], mm[k][3]));
                    float w[4], den = 0.f;
#pragma unroll
                    for (int sl = 0; sl < 4; ++sl) { w[sl] = ll[k][sl] * __builtin_amdgcn_exp2f((mm[k][sl] - M) * C2); den += w[sl]; }
                    const float inv = 1.0f / den;
                    float o[8];
#pragma unroll
                    for (int e = 0; e < 8; ++e) o[e] = ((w[0] * bf2f((unsigned short)pv[k][0][e]) + w[1] * bf2f((unsigned short)pv[k][1][e])) + (w[2] * bf2f((unsigned short)pv[k][2][e]) + w[3] * bf2f((unsigned short)pv[k][3][e]))) * inv;
                    u32x4 ov; ov.x = pg8::cvt_pk_bf16(o[0], o[1]); ov.y = pg8::cvt_pk_bf16(o[2], o[3]); ov.z = pg8::cvt_pk_bf16(o[4], o[5]); ov.w = pg8::cvt_pk_bf16(o[6], o[7]);
                    *(u32x4*)(W_ao + (size_t)t * D + h_ * 128 + l16 * 8) = ov;
                }
            }
        }
        GRID_BAR();
        if (sub <= 3 || sub == 5 || sub == 6 || sub == 8 || sub == 10) {
            FRESH_TID();
            int sb0, nsb;
            if (G != 256) { sb0 = sub == 0 ? 1 : (sub == 1 ? 2 : 11); nsb = sub == 1 ? 9 : (sub == 0 || sub == 10 ? 1 : 0); }
            else if (sub == 0) { sb0 = 1; nsb = 1; } else if (sub == 1) { sb0 = 2; nsb = 4; } else if (sub == 2) { sb0 = 6; nsb = 1; } else if (sub == 3) { sb0 = 7; nsb = 2; }
            else if (sub == 5) { sb0 = 9; nsb = 1; } else if (sub == 6) { sb0 = 10; nsb = 1; } else if (sub == 8) { sb0 = 11; nsb = 1; } else { sb0 = 0; nsb = 0; }
            for (int idx = vcu * (NWAVES * 64) + ftid; idx < nsb * F2; idx += G * (NWAVES * 64)) {
                const int sb = sb0 + idx / F2, n = idx % F2, s_ = sb % 3, kind_ = (sb / 3) % 3;
                const int nrows = s_ != 1 ? F2 : (kind_ == 0 ? 3 * D : (kind_ == 2 ? 2560 : 0));
                if (n < nrows) { float a = 0.f;
#pragma unroll 8
                    for (int kb = 0; kb < 32; ++kb) a += W_biasp[(size_t)kb * (DEPTH * 3 * F2) + (size_t)sb * F2 + n];
                    W_bias[(size_t)sb * F2 + n] = a; }
            }
        }
        {
            pg8::Gemm g{rA, rB, T, D, rK, rlda, rgrp, rtile, 1}; pg8::StaticOrder S; S.init(T, D, G, bx);
            pg8::EpiRes E{W_x, W_cres + (size_t)sub * D, W_ss};
            { FRESH_TID(); pg8::gemm_phase<pg8::EpiRes, pg8::StaticOrder, true>(lds + RING_OFF, g, S, E, ftid); }
        }
        GRID_BAR();
    }
    { WS_FRESH(); FRESH_TID(); const int lane = flane;
    for (int t = gw; t < T; t += NGW) {
        float sv = lane < 32 ? W_ss[(size_t)t * 32 + lane] : 0.f; sv = wave_sum(sv);
        const float rstd = 1.0f / sqrtf(sv * (1.0f / D) + EPS);
#pragma unroll
        for (int c = lane * 4; c < D; c += 256) { const u32x2 q_ = *(const u32x2*)(W_x + XIDX(t, c)); const f32x4 g = *(const f32x4*)(final_g + c);
            const f32x4 v = {__builtin_bit_cast(float, q_.x << 16), __builtin_bit_cast(float, q_.x & 0xFFFF0000u), __builtin_bit_cast(float, q_.y << 16), __builtin_bit_cast(float, q_.y & 0xFFFF0000u)};
            *(f32x4*)(args.out + (size_t)t * D + c) = v * rstd * g; }
    } }
#undef GRID_BAR
}

extern "C" void kernel_launch(void* const* d_in, const int* in_sizes, int n_in, void* d_out, int out_size, void* d_ws, size_t ws_size, hipStream_t stream) {
    static int grid = 0;
    Args a{};
    const size_t need = WS_NEED;
    if (grid == 0) {
        if (n_in != 16 || in_sizes[0] != T * D || out_size != T * D || ws_size < need) { fprintf(stderr, "kernel_launch: unexpected shapes / workspace (need %zu, have %zu)\n", need, ws_size); grid = -1; return; }
        int dev = 0, cus = 0, per_cu = 0;
        if (hipGetDevice(&dev) != hipSuccess || hipDeviceGetAttribute(&cus, hipDeviceAttributeMultiprocessorCount, dev) != hipSuccess) { grid = -1; return; }
        if (hipFuncSetAttribute((const void*)mk_fwd, hipFuncAttributeMaxDynamicSharedMemorySize, LDS_BYTES) != hipSuccess) { fprintf(stderr, "kernel_launch: hipFuncSetAttribute failed\n"); grid = -1; return; }
        if (hipOccupancyMaxActiveBlocksPerMultiprocessor(&per_cu, (const void*)mk_fwd, NWAVES * 64, LDS_BYTES) != hipSuccess || per_cu < 1) { fprintf(stderr, "kernel_launch: occupancy query reports %d\n", per_cu); }
        (void)hipGetLastError();
        grid = cus;
    }
    if (grid < 0) return;
    (void)hipMemsetAsync((unsigned char*)d_ws + O_ctl, 0, CTL_BYTES, stream);
    for (int i = 0; i < 16; ++i) a.in[i] = (const float*)d_in[i];
    a.out = (float*)d_out; a.ws = (unsigned char*)d_ws;
    hipLaunchKernelGGL(mk_fwd, dim3(grid), dim3(NWAVES * 64), LDS_BYTES, stream, a);
}
```

```cpp
#include <hip/hip_runtime.h>
#include <cstdio>
#include <cstdint>
#include <cmath>

constexpr int T = 8192, D = 2048, F = 5632, F2 = 11264, DEPTH = 4, NMOD = 9 * 2048;
constexpr float EPS = 1e-6f;
constexpr float LOG2E = 1.4426950408889634f;

namespace pg8 {
#define PG8_LAS __attribute__((address_space(3)))
typedef unsigned short bf16_t;
typedef short bf16x8 __attribute__((ext_vector_type(8)));
typedef float f32x4 __attribute__((ext_vector_type(4)));
typedef unsigned u32x4 __attribute__((ext_vector_type(4)));
typedef unsigned u32x2 __attribute__((ext_vector_type(2)));
constexpr int BM = 256, BK = 64, HALF = 128, HTB = HALF * BK * 2  , STAGE_BYTES = 8 * HTB, NXCD = 8, WGM = 8;

__host__ __device__ __forceinline__ int lds_byte(int r, int c) { const int st = (r >> 4) * 2 + (c >> 5), rr = r & 15, cc = c & 31, ob = rr * 64 + cc * 2; return st * 1024 + (ob ^ (((ob >> 9) & 1) << 5)); }
__host__ __device__ __forceinline__ void stage_rc(int b, int& R, int& C) { const int st = b / 1024, sb = b % 1024, swz = sb ^ (((sb >> 9) & 1) << 5); R = (st >> 1) * 16 + swz / 64; C = (st & 1) * 32 + (swz % 64) / 2; }
__host__ __device__ __forceinline__ int perm32(int rho) { const int n = rho >> 4, i = rho & 15; return 8 * (i >> 2) + 4 * n + (i & 3); }

struct Unit { int pm, pn; };
struct Gemm { const bf16_t* A; const bf16_t* Bt; int M, N, K, lda, grouped, ta, tb; };

struct StaticOrder {
    int nM, nN, nwg, G, c;
    __host__ __device__ void init(int M, int N, int G_, int c_) { nM = M / BM; nN = N / BM; nwg = nM * nN; G = G_; c = c_; }
    __host__ __device__ bool next(int i, Unit& u) const {
        const long L = (long)i * G + c; if (L >= nwg) return false;
        int wgid = (int)L; { const int q = nwg / NXCD, r = nwg % NXCD, xcd = wgid % NXCD, off = wgid / NXCD; wgid = (xcd < r ? xcd * (q + 1) : r * (q + 1) + (xcd - r) * q) + off; }
        const int nig = WGM * nN, gid = wgid / nig, fm = gid * WGM, gsz = (nM - fm) < WGM ? (nM - fm) : WGM;
        u.pm = fm + ((wgid % nig) % gsz); u.pn = (wgid % nig) / gsz; return true;
    }
    __device__ __forceinline__ void a_ready(const Unit&) const {}
    __device__ __forceinline__ void done(const Unit&) const {}
};

typedef float f32x2_t __attribute__((ext_vector_type(2))); typedef __bf16 bf16x2_t __attribute__((ext_vector_type(2)));
__device__ __forceinline__ unsigned cvt_pk_bf16(float lo, float hi) { const f32x2_t v = {lo, hi}; const bf16x2_t b = __builtin_convertvector(v, bf16x2_t); return __builtin_bit_cast(unsigned, b); }

__device__ __forceinline__ void load_rstd(const float* ss, int rowb, int fq, float (&rs)[2][4]) {
#pragma unroll
    for (int ai = 0; ai < 2; ++ai)
#pragma unroll
        for (int m = 0; m < 4; ++m) {
            const f32x4* p = (const f32x4*)(ss + (size_t)(rowb + ai * HALF + m * 16) * 32 + fq * 8);
            const f32x4 a = p[0], b = p[1];
            float s = ((a[0] + a[1]) + (a[2] + a[3])) + ((b[0] + b[1]) + (b[2] + b[3]));
            s += __shfl_xor(s, 16); s += __shfl_xor(s, 32);
            rs[ai][m] = __builtin_amdgcn_rsqf(s * (1.0f / D) + EPS);
        }
}
__device__ __forceinline__ float silu_mul(float g, float u) { return g * __builtin_amdgcn_rcpf(1.0f + __expf(-g)) * u; }

struct EpiGU {
    static constexpr bool PERM = true, AFTER_DRAIN = false;
    const float* rtab; const float* btab; bf16_t* act;
    __device__ __forceinline__ void operator()(const f32x4 (&acc)[2][2][4][2], const Unit& u, int wr, int wc, int fr, int fq, int ui) const {
        const int cb = u.pn * BM + wc * 32 + 8 * fq, jcol = u.pn * HALF + wc * 32 + 8 * fq;
        (void)cb;
        f32x4 bg[2], bu[2];
        const float* bt = btab + ui * 256 + wc * 32 + 8 * fq;
#pragma unroll
        for (int n = 0; n < 2; ++n) { bg[n] = *(const f32x4*)(bt + 4 * n); bu[n] = *(const f32x4*)(bt + HALF + 4 * n); }
        float rs[2][4];
#pragma unroll
        for (int ai = 0; ai < 2; ++ai)
#pragma unroll
            for (int m = 0; m < 4; ++m) rs[ai][m] = rtab[ui * 256 + ai * HALF + wr * 64 + m * 16 + fr];
#pragma unroll
        for (int ai = 0; ai < 2; ++ai)
#pragma unroll
            for (int m = 0; m < 4; ++m) {
                const float r = rs[ai][m]; const int row = u.pm * BM + ai * HALF + wr * 64 + m * 16 + fr;
                float g[8], v[8], e[8];
#pragma unroll
                for (int n = 0; n < 2; ++n)
#pragma unroll
                    for (int i = 0; i < 4; ++i) { g[n * 4 + i] = fmaf(acc[ai][0][m][n][i], r, bg[n][i]); v[n * 4 + i] = fmaf(acc[ai][1][m][n][i], r, bu[n][i]); }
#pragma unroll
                for (int i = 0; i < 8; ++i) e[i] = __builtin_amdgcn_exp2f(g[i] * (-LOG2E));
#pragma unroll
                for (int i = 0; i < 8; ++i) e[i] = __builtin_amdgcn_rcpf(1.0f + e[i]);
#pragma unroll
                for (int i = 0; i < 8; ++i) e[i] = (g[i] * e[i]) * v[i];
                u32x4 w; w.x = cvt_pk_bf16(e[0], e[1]); w.y = cvt_pk_bf16(e[2], e[3]); w.z = cvt_pk_bf16(e[4], e[5]); w.w = cvt_pk_bf16(e[6], e[7]);
                *(u32x4*)(act + ((size_t)((row >> 8) * (F / 64) + (jcol >> 6)) * 256 + (row & 255)) * 64 + (jcol & 63)) = w;
            }
    }
};
struct EpiRes {
    static constexpr bool PERM = true, AFTER_DRAIN = false;
    bf16_t* x; const float* cres; float* ss;
    __device__ __forceinline__ void operator()(const f32x4 (&acc)[2][2][4][2], const Unit& u, int wr, int wc, int fr, int fq, int ui) const {
        const int col0 = u.pn * BM + wc * 32 + 8 * fq;
        const size_t off0 = ((size_t)(u.pm * (D / 64) + (col0 >> 6)) * 256 + wr * 64 + fr) * 64 + (col0 & 63);
        f32x4 cr[2][2];
#pragma unroll
        for (int bj = 0; bj < 2; ++bj)
#pragma unroll
            for (int n = 0; n < 2; ++n) cr[bj][n] = *(const f32x4*)(cres + col0 + bj * HALF + n * 4);
        u32x4 xb[3][2];
#define EPIRES_OFF(g, bj) (off0 + (size_t)(((g) >> 2) * HALF + ((g) & 3) * 16) * 64 + (size_t)(bj) * (2 * 256 * 64))
#define EPIRES_LOAD(buf, g) do { _Pragma("unroll") for (int bj = 0; bj < 2; ++bj) xb[buf][bj] = *(const u32x4*)(x + EPIRES_OFF(g, bj)); } while (0)
        EPIRES_LOAD(0, 0); EPIRES_LOAD(1, 1); EPIRES_LOAD(2, 2);
#pragma unroll
        for (int g = 0; g < 8; ++g) {
            const int ai = g >> 2, m = g & 3;
            const int row_ = u.pm * BM + ai * HALF + wr * 64 + m * 16 + fr;
            float sq = 0.f;
#pragma unroll
            for (int bj = 0; bj < 2; ++bj) {
                u32x4 xs;
#pragma unroll
                for (int n = 0; n < 2; ++n) {
                    const unsigned p0 = xb[g % 3][bj][2 * n], p1 = xb[g % 3][bj][2 * n + 1];
                    const f32x4 xo = {__builtin_bit_cast(float, p0 << 16), __builtin_bit_cast(float, p0 & 0xFFFF0000u), __builtin_bit_cast(float, p1 << 16), __builtin_bit_cast(float, p1 & 0xFFFF0000u)};
                    const f32x4 xn = xo + cr[bj][n] * acc[ai][bj][m][n];
                    sq += (xn[0] * xn[0] + xn[1] * xn[1]) + (xn[2] * xn[2] + xn[3] * xn[3]);
                    if (n == 0) { xs.x = cvt_pk_bf16(xn[0], xn[1]); xs.y = cvt_pk_bf16(xn[2], xn[3]); } else { xs.z = cvt_pk_bf16(xn[0], xn[1]); xs.w = cvt_pk_bf16(xn[2], xn[3]); }
                }
                *(u32x4*)(x + EPIRES_OFF(g, bj)) = xs;
            }
            sq += __shfl_xor(sq, 16); sq += __shfl_xor(sq, 32);
            if (fq == 0) ss[(size_t)row_ * 32 + u.pn * 4 + wc] = sq;
            if (g + 3 < 8) EPIRES_LOAD(g % 3, g + 3);
        }
#undef EPIRES_LOAD
#undef EPIRES_OFF
    }
};
struct EpiQKV {
    static constexpr bool PERM = true, AFTER_DRAIN = false;
    const float* ss; const float* bias; bf16_t* qkv; bf16_t* vt; float* kmp; unsigned* kmax; int nq, nk, hm;
    __device__ __forceinline__ void operator()(const f32x4 (&acc)[2][2][4][2], const Unit& u, int wr, int wc, int fr, int fq, int ui) const {
        const int ct = u.pn * BM; const int cb = ct + wc * 32 + 8 * fq;
        f32x4 bv[2][2];
#pragma unroll
        for (int bj = 0; bj < 2; ++bj)
#pragma unroll
            for (int n = 0; n < 2; ++n) bv[bj][n] = *(const f32x4*)(bias + cb + bj * HALF + 4 * n);
        float rs[2][4]; load_rstd(ss, u.pm * BM + wr * 64 + fr, fq, rs);
        asm volatile("" : "+v"(bv[0][0]), "+v"(bv[0][1]), "+v"(bv[1][0]), "+v"(bv[1][1]));
        const int region = ct < nq ? 0 : (ct < nq + nk ? 1 : 2);
        bf16_t* base = qkv + (size_t)region * ((size_t)T * D); const int ld = region == 0 ? nq : nk;
        const int lc = cb - (region == 0 ? 0 : (region == 1 ? nq : nq + nk));
        const bool do_km = (region == 1) && (kmp != nullptr), do_vt = (region == 2) && (vt != nullptr);
        f32x4 csum[2][2];
#pragma unroll
        for (int bj = 0; bj < 2; ++bj)
#pragma unroll
            for (int n = 0; n < 2; ++n) csum[bj][n] = (f32x4){0.f, 0.f, 0.f, 0.f};
        float kmx[2] = {0.f, 0.f};
#pragma unroll
        for (int ai = 0; ai < 2; ++ai)
#pragma unroll
            for (int m = 0; m < 4; ++m) {
                const float r = rs[ai][m]; const int row = u.pm * BM + ai * HALF + wr * 64 + m * 16 + fr;
#pragma unroll
                for (int bj = 0; bj < 2; ++bj) {
                    const f32x4 v0 = acc[ai][bj][m][0] * r + bv[bj][0], v1 = acc[ai][bj][m][1] * r + bv[bj][1];
                    csum[bj][0] += v0; csum[bj][1] += v1;
                    if (do_km) kmx[bj] = fmaxf(kmx[bj], fmaxf(fmaxf(fmaxf(fabsf(v0[0]), fabsf(v0[1])), fmaxf(fabsf(v0[2]), fabsf(v0[3]))), fmaxf(fmaxf(fabsf(v1[0]), fabsf(v1[1])), fmaxf(fabsf(v1[2]), fabsf(v1[3])))));
                    u32x4 w; w.x = cvt_pk_bf16(v0[0], v0[1]); w.y = cvt_pk_bf16(v0[2], v0[3]); w.z = cvt_pk_bf16(v1[0], v1[1]); w.w = cvt_pk_bf16(v1[2], v1[3]);
                    if (hm) *(u32x4*)(base + ((size_t)((lc + bj * HALF) >> 7) * T + row) * 128 + ((lc + bj * HALF) & 127)) = w;
                    else *(u32x4*)(base + (size_t)row * ld + lc + bj * HALF) = w;
                    if (do_vt) {
                        bf16_t* tp = vt + (size_t)(lc + bj * HALF) * T + row;
                        tp[0] = (bf16_t)(w.x & 0xffffu); tp[(size_t)T] = (bf16_t)(w.x >> 16); tp[(size_t)2 * T] = (bf16_t)(w.y & 0xffffu); tp[(size_t)3 * T] = (bf16_t)(w.y >> 16);
                        tp[(size_t)4 * T] = (bf16_t)(w.z & 0xffffu); tp[(size_t)5 * T] = (bf16_t)(w.z >> 16); tp[(size_t)6 * T] = (bf16_t)(w.w & 0xffffu); tp[(size_t)7 * T] = (bf16_t)(w.w >> 16);
                    }
                }
            }
        if (do_km) {
#pragma unroll
            for (int bj = 0; bj < 2; ++bj) {
                float mx = kmx[bj];
#pragma unroll
                for (int o = 1; o < 64; o <<= 1) mx = fmaxf(mx, __shfl_xor(mx, o));
                if (fr == 0 && fq == 0) atomicMax(kmax + ((ct - nq) >> 7) + bj, __float_as_uint(mx));
            }
#pragma unroll
            for (int bj = 0; bj < 2; ++bj)
#pragma unroll
                for (int n = 0; n < 2; ++n) {
                    f32x4 c = csum[bj][n];
#pragma unroll
                    for (int o = 1; o < 16; o <<= 1) { c[0] += __shfl_xor(c[0], o); c[1] += __shfl_xor(c[1], o); c[2] += __shfl_xor(c[2], o); c[3] += __shfl_xor(c[3], o); }
                    if (fr == 0) *(f32x4*)(kmp + ((size_t)wr * 32 + u.pm) * D + lc + bj * HALF + 4 * n) = c;
                }
        }
    }
};

template <class Epi, class Sched, bool ALIGN_EPI>
__device__ __forceinline__ void gemm_phase(PG8_LAS unsigned char* lds, const Gemm g, const Sched& S, const Epi& E, const int tid) {
    const int wid = __builtin_amdgcn_readfirstlane(tid >> 6), lane = tid & 63, wr = wid >> 2, wc = wid & 3, fr = lane & 15, fq = lane >> 4;
    const int K = g.K, nt = K / BK, lda = g.lda;
    unsigned voffA[2], voffB[2];
#pragma unroll
    for (int i = 0; i < 2; ++i) { int R, C; stage_rc(tid * 16 + i * 8192, R, C); const int Rb = Epi::PERM ? ((R & ~31) + perm32(R & 31)) : R;
        voffA[i] = (unsigned)(R * (g.ta ? BK : lda) + C) * 2u; voffB[i] = (unsigned)(Rb * (g.tb ? BK : K) + C) * 2u; }
    const size_t kstepA = g.ta ? (size_t)BM * BK * 2 : (size_t)(BK * 2), kstepB = g.tb ? (size_t)BM * BK * 2 : (size_t)(BK * 2);
    const size_t hstepA = g.ta ? (size_t)HALF * BK * 2 : (size_t)HALF * lda * 2, hstepB = g.tb ? (size_t)HALF * BK * 2 : (size_t)HALF * K * 2;
    const size_t tstepA = g.ta ? (size_t)(K / BK) * BM * BK * 2 : 2 * hstepA, tstepB = g.tb ? (size_t)(K / BK) * BM * BK * 2 : 2 * hstepB;
    const unsigned ldsw = (unsigned)wid * 1024u;
    const int aoff = lds_byte(wr * 64 + fr, fq * 8), boff = lds_byte(wc * 32 + fr, fq * 8);
#define PG8_ACOL(u_) (g.grouped ? (size_t)((u_).pn >> 1) * (size_t)K * 2 : (size_t)0)
#define PG8_SA(b, h) (((b) * 2 + (h)) * HTB)
#define PG8_SB(b, h) ((4 + (b) * 2 + (h)) * HTB)
#define PG8_STAGE(bufoff, gbase, voff) do { _Pragma("unroll") for (int _i = 0; _i < 2; ++_i) \
        __builtin_amdgcn_global_load_lds((const unsigned*)((const char*)(gbase) + (voff)[_i]), (PG8_LAS unsigned*)(lds + (bufoff) + ldsw + _i * 8192), 16, 0, 0); } while (0)
#define PG8_LDA(dst, b, h) do { _Pragma("unroll") for (int m = 0; m < 4; ++m) _Pragma("unroll") for (int k = 0; k < 2; ++k) dst[m][k] = *(const PG8_LAS bf16x8*)(lds + PG8_SA(b, h) + aoff + m * 2048 + k * 1024); } while (0)
#define PG8_LDB(dst, b, h) do { _Pragma("unroll") for (int n = 0; n < 2; ++n) _Pragma("unroll") for (int k = 0; k < 2; ++k) dst[n][k] = *(const PG8_LAS bf16x8*)(lds + PG8_SB(b, h) + boff + n * 2048 + k * 1024); } while (0)
#define PG8_MMA(ai, bj, At, Bt) do { __builtin_amdgcn_s_setprio(1); _Pragma("unroll") for (int m = 0; m < 4; ++m) _Pragma("unroll") for (int n = 0; n < 2; ++n) _Pragma("unroll") for (int k = 0; k < 2; ++k) \
        acc[ai][bj][m][n] = __builtin_amdgcn_mfma_f32_16x16x32_bf16(Bt[n][k], At[m][k], acc[ai][bj][m][n], 0, 0, 0); __builtin_amdgcn_s_setprio(0); } while (0)
#define PG8_WAIT_V(n) asm volatile("s_waitcnt vmcnt(" #n ")" ::: "memory")
#define PG8_WAIT_L(n) asm volatile("s_waitcnt lgkmcnt(" #n ")" ::: "memory")
#define PG8_BAR __builtin_amdgcn_s_barrier()
#define PG8_SCHED __builtin_amdgcn_sched_barrier(0)
    Unit cur, nxt; int ui = 0;
    if (!S.next(0, cur)) return;
    f32x4 acc[2][2][4][2];
#pragma unroll
    for (int a = 0; a < 2; ++a)
#pragma unroll
        for (int b = 0; b < 2; ++b)
#pragma unroll
            for (int m = 0; m < 4; ++m)
#pragma unroll
                for (int n = 0; n < 2; ++n) acc[a][b][m][n] = (f32x4){0.f, 0.f, 0.f, 0.f};
    bf16x8 At[4][2], B0[2][2], B1[2][2];
    const char* cA = (const char*)g.A + (size_t)cur.pm * tstepA + PG8_ACOL(cur); const char* cB = (const char*)g.Bt + (size_t)cur.pn * tstepB;
    S.a_ready(cur);
    PG8_STAGE(PG8_SB(0, 0), cB, voffB); PG8_STAGE(PG8_SB(0, 1), cB + hstepB, voffB); PG8_STAGE(PG8_SA(0, 0), cA, voffA); PG8_STAGE(PG8_SA(0, 1), cA + hstepA, voffA);
    if (wr == 1) PG8_BAR;
    PG8_WAIT_V(2); PG8_BAR;
    PG8_STAGE(PG8_SB(1, 0), cB + kstepB, voffB); PG8_STAGE(PG8_SA(1, 0), cA + kstepA, voffA); PG8_STAGE(PG8_SB(1, 1), cB + hstepB + kstepB, voffB);
    PG8_WAIT_V(6); PG8_BAR;
    for (;;) {
        const bool has_next = S.next(ui + 1, nxt);
        const char* nA = has_next ? (const char*)g.A + (size_t)nxt.pm * tstepA + PG8_ACOL(nxt) : cA; const char* nB = has_next ? (const char*)g.Bt + (size_t)nxt.pn * tstepB : cB;
        for (int t = 0; t < nt; t += 2) {
            const bool last = (t == nt - 2);
            const char* a1 = cA + (size_t)(t + 1) * kstepA;
            const char* a2 = last ? nA : cA + (size_t)(t + 2) * kstepA; const char* b2 = last ? nB : cB + (size_t)(t + 2) * kstepB;
            const char* a3 = a2 + kstepA; const char* b3 = b2 + kstepB;
            if (last && has_next) S.a_ready(nxt);
            PG8_LDB(B0, 0, 0); PG8_LDB(B1, 0, 1); PG8_SCHED; PG8_LDA(At, 0, 0); PG8_STAGE(PG8_SA(1, 1), a1 + hstepA, voffA);
            PG8_WAIT_V(8); PG8_WAIT_L(0); PG8_BAR; PG8_MMA(0, 0, At, B0); PG8_MMA(0, 1, At, B1); PG8_BAR; PG8_SCHED;
            PG8_LDA(At, 0, 1); PG8_STAGE(PG8_SB(0, 0), b2, voffB); PG8_STAGE(PG8_SB(0, 1), b2 + hstepB, voffB); PG8_STAGE(PG8_SA(0, 0), a2, voffA);
            PG8_WAIT_V(8); PG8_WAIT_L(0); PG8_BAR; PG8_MMA(1, 0, At, B0); PG8_MMA(1, 1, At, B1); PG8_BAR; PG8_SCHED;
            PG8_LDB(B0, 1, 0); PG8_LDB(B1, 1, 1); PG8_SCHED; PG8_LDA(At, 1, 0); PG8_STAGE(PG8_SA(0, 1), a2 + hstepA, voffA);
            PG8_WAIT_V(8); PG8_WAIT_L(0); PG8_BAR; PG8_MMA(0, 0, At, B0); PG8_MMA(0, 1, At, B1); PG8_BAR; PG8_SCHED;
            PG8_LDA(At, 1, 1); PG8_STAGE(PG8_SB(1, 0), b3, voffB); PG8_STAGE(PG8_SB(1, 1), b3 + hstepB, voffB); PG8_STAGE(PG8_SA(1, 0), a3, voffA);
            PG8_WAIT_V(8); PG8_WAIT_L(0); PG8_BAR; PG8_MMA(1, 0, At, B0); PG8_MMA(1, 1, At, B1); PG8_BAR; PG8_SCHED;
        }
        if constexpr (ALIGN_EPI) { if (wr == 0) PG8_BAR; }
        E(acc, cur, wr, wc, fr, fq, ui); S.done(cur);
        if (!has_next) break;
#pragma unroll
        for (int a = 0; a < 2; ++a)
#pragma unroll
            for (int b = 0; b < 2; ++b)
#pragma unroll
                for (int m = 0; m < 4; ++m)
#pragma unroll
                    for (int n = 0; n < 2; ++n) acc[a][b][m][n] = (f32x4){0.f, 0.f, 0.f, 0.f};
        cur = nxt; cA = nA; cB = nB; ++ui;
        if constexpr (ALIGN_EPI) { if (wr == 1) PG8_BAR; }
    }
    PG8_WAIT_V(0);
    if constexpr (!ALIGN_EPI) { if (wr == 0) PG8_BAR; }
    PG8_BAR;
#undef PG8_ACOL
#undef PG8_SA
#undef PG8_SB
#undef PG8_STAGE
#undef PG8_LDA
#undef PG8_LDB
#undef PG8_MMA
#undef PG8_WAIT_V
#undef PG8_WAIT_L
#undef PG8_BAR
#undef PG8_SCHED
}
}
#define GAS __attribute__((address_space(1)))
#define LAS __attribute__((address_space(3)))
typedef unsigned short bf16;
typedef unsigned v4u __attribute__((ext_vector_type(4)));
typedef float f32x4 __attribute__((ext_vector_type(4)));
typedef short bf16x8 __attribute__((ext_vector_type(8)));
typedef GAS unsigned gu32;
typedef GAS unsigned long long gu64;
#define RLX_AGENT __ATOMIC_RELAXED, __HIP_MEMORY_SCOPE_AGENT
#define LDS_WAIT() asm volatile("s_waitcnt lgkmcnt(0)" ::: "memory")
#define VM_WAIT() asm volatile("s_waitcnt vmcnt(0)" ::: "memory")
__device__ __forceinline__ unsigned long long rt() { return __builtin_amdgcn_s_memrealtime(); }
__device__ __forceinline__ unsigned f2bf(float f) { unsigned u = __builtin_bit_cast(unsigned, f); return (u + 0x7fffu + ((u >> 16) & 1u)) >> 16; }
__device__ __forceinline__ unsigned pk2(float lo, float hi) { return f2bf(lo) | (f2bf(hi) << 16); }

#define XB_TMO      128
#define XB_XCNT(j)  (256  + 64 * (j))
#define XB_XSUB(j)  (1280 + 64 * (j))
#define XB_XGEN(j)  (2304 + 64 * (j))
#define XB_TOP      3328
#define XB_TOPGEN   3392
#define XCD_BAR_WORDS 3456
#define XB_SPIN_CAP (1u << 18)

__device__ __forceinline__ unsigned xb_ld(unsigned* p)              { return __hip_atomic_load(p, __ATOMIC_RELAXED, __HIP_MEMORY_SCOPE_AGENT); }
__device__ __forceinline__ unsigned xb_add(unsigned* p, unsigned v) { return __hip_atomic_fetch_add(p, v, __ATOMIC_RELAXED, __HIP_MEMORY_SCOPE_AGENT); }
__device__ __forceinline__ unsigned xb_xcc_id() { return (unsigned)__builtin_amdgcn_s_getreg((3 << 11) | 20) & 0xFu; }
#define XB_SPIN(cond, bar) do { unsigned _sp = 0; while (cond) { __builtin_amdgcn_s_sleep(1); \
    if ((++_sp & 255u) == 0u) { if (xb_ld(&(bar)[XB_TMO])) break; if (_sp > XB_SPIN_CAP) { atomicAdd(&(bar)[XB_TMO], 1u); break; } } } } while (0)

struct XcdBarrier {
    unsigned* bar; unsigned x;
    volatile LAS unsigned* st;
};

__device__ __forceinline__ XcdBarrier xcd_barrier_post(unsigned* bar, volatile LAS unsigned* st) {
    XcdBarrier b; b.bar = bar; b.x = xb_xcc_id(); b.st = st;
    if (threadIdx.x == 0) (void)xb_add(&bar[XB_XCNT(b.x)], 1u);
    return b;
}
__device__ __forceinline__ void xcd_barrier_complete(unsigned* bar, unsigned x, unsigned& nloc, unsigned& nx) {
    const unsigned G = gridDim.x * gridDim.y * gridDim.z;
    unsigned sum, cnt, mine, sp = 0u;
    for (;;) {
        sum = 0u; cnt = 0u; mine = 0u;
#pragma unroll
        for (unsigned j = 0; j < 16; ++j) { const unsigned c = xb_ld(&bar[XB_XCNT(j)]); sum += c; cnt += (c > 0u) ? 1u : 0u; mine = (j == x) ? c : mine; }
        if (sum == G) break;
        __builtin_amdgcn_s_sleep(1);
        if ((++sp & 255u) == 0u) { if (xb_ld(&bar[XB_TMO])) break; if (sp > XB_SPIN_CAP) { atomicAdd(&bar[XB_TMO], 1u); break; } }
    }
    nloc = mine > 0u ? mine : 1u; nx = cnt > 0u ? cnt : 1u;
}

__device__ __forceinline__ void xcd_barrier(const XcdBarrier& b) {
    asm volatile("s_waitcnt vmcnt(0)" ::: "memory");
    __syncthreads();
    if (threadIdx.x == 0) {
        unsigned* bar = b.bar;
        __builtin_amdgcn_s_waitcnt(0);
        unsigned nloc = b.st[0], nx = b.st[1];
        if (nloc == 0u) { xcd_barrier_complete(bar, b.x, nloc, nx); b.st[0] = nloc; b.st[1] = nx; }
        const unsigned old = xb_add(&bar[XB_XSUB(b.x)], 1u);
        const unsigned gen = old / nloc;
        if (old + 1u == (gen + 1u) * nloc) {
            __builtin_amdgcn_fence(__ATOMIC_RELEASE, "agent");
            asm volatile("s_waitcnt vmcnt(0)" ::: "memory");
            const unsigned og = xb_add(&bar[XB_TOP], 1u);
            const unsigned tg = og / nx;
            if (og + 1u == (tg + 1u) * nx) xb_add(&bar[XB_TOPGEN], 1u);
            else XB_SPIN(xb_ld(&bar[XB_TOPGEN]) == tg, bar);
            __builtin_amdgcn_fence(__ATOMIC_ACQUIRE, "agent");
            xb_add(&bar[XB_XGEN(b.x)], 1u);
            asm volatile("s_waitcnt vmcnt(0)" ::: "memory");
        } else {
            XB_SPIN(xb_ld(&bar[XB_XGEN(b.x)]) == gen, bar);
            __builtin_amdgcn_fence(__ATOMIC_ACQUIRE, "agent");
            asm volatile("s_waitcnt vmcnt(0)" ::: "memory");
        }
    }
    __syncthreads();
}

namespace mb {
typedef unsigned short bf16_t;
typedef short bf16x8 __attribute__((ext_vector_type(8)));
typedef short s16x4 __attribute__((ext_vector_type(4)));
typedef float f32x16 __attribute__((ext_vector_type(16)));
typedef float f32x4 __attribute__((ext_vector_type(4)));
typedef unsigned u32x4 __attribute__((ext_vector_type(4)));
constexpr int HD = 128, PITCH = 128, OPITCH = 128;
constexpr float SCALE = 0.08838834764831845f;
constexpr float THR = 8.f;
constexpr int NW = 8, QBLK = 32, KVBLK = 64, QB = NW * QBLK;
constexpr int SHM_V = KVBLK * HD * 2, SHM_K = KVBLK * HD * 2;
constexpr int LDS_BYTES = 2 * SHM_V + 2 * SHM_K + NW * 64 * 4;

#define KSWZ(row, colB) ((row) * 256 + ((colB) ^ (((row) & 7) << 4)))
#define SBAR() __builtin_amdgcn_sched_barrier(0)
__device__ __forceinline__ int v_st(int k, int c) { const int kk = (k & ~0xC) | ((k & 4) << 1) | ((k & 8) >> 1); return ((kk >> 3) * 4 + (c >> 5)) * 512 + ((kk & 7) * 32 + (c & 31)) * 2; }
__device__ __forceinline__ int v_rd_base(int lane) { return ((lane & 3) << 3) | (((lane >> 2) & 3) << 6) | (((lane >> 4) & 1) << 5) | (((lane >> 5) & 1) << 8); }
constexpr int v_rd_off(int d0, int ks, int half) { return d0 * 512 + ks * 4096 + half * 2048; }
__device__ __forceinline__ int crow(int r, int hi) { return (r & 3) + 8 * (r >> 2) + 4 * hi; }
__device__ __forceinline__ unsigned cvtpk(float lo, float hi) { unsigned r; asm volatile("v_cvt_pk_bf16_f32 %0, %1, %2" : "=v"(r) : "v"(lo), "v"(hi)); return r; }
__device__ __forceinline__ bf16x8 load8(const bf16_t* p) { return *reinterpret_cast<const bf16x8*>(p); }

__device__ __forceinline__ void bias_tile(f32x16& p0, f32x16& p1, float ab) {
#pragma unroll
    for (int r = 0; r < 16; ++r) { const int c = (r & 3) + 8 * (r >> 2); p0[r] = fmaf(ab, (float)c, p0[r]); p1[r] = fmaf(ab, (float)(c + 32), p1[r]); }
}
__device__ __forceinline__ void causal_tile(f32x16& p0, f32x16& p1, int dq) {
    const float NEG = -__builtin_inff();
#pragma unroll
    for (int r = 0; r < 16; ++r) { const int c = (r & 3) + 8 * (r >> 2); if (dq - c < 0) p0[r] = NEG; if (dq - c - 32 < 0) p1[r] = NEG; }
}
__device__ __forceinline__ void partialSM(f32x16& p0, f32x16& p1, float& m_reg, float& mn, float& alpha, float off, float abh) {
    float pmax = p0[0]; for (int r = 1; r < 16; ++r) pmax = fmaxf(pmax, p0[r]); for (int r = 0; r < 16; ++r) pmax = fmaxf(pmax, p1[r]);
    pmax += abh;
    { auto rr = __builtin_amdgcn_permlane32_swap(__float_as_uint(pmax), __float_as_uint(pmax), false, false);
      pmax = fmaxf(__uint_as_float(rr[0]), __uint_as_float(rr[1])); }
    pmax += off;
    constexpr float C2 = 1.4426950408889634f * SCALE;
    if (__builtin_expect(__all((pmax - m_reg) * SCALE <= THR), 1)) { mn = m_reg; alpha = 1.f; }
    else { mn = fmaxf(m_reg, pmax); alpha = __builtin_amdgcn_exp2f((m_reg - mn) * C2); m_reg = mn; }
    const float mnL = ((off + abh) - mn) * C2;
    for (int r = 0; r < 16; ++r) p0[r] = fmaf(p0[r], C2, mnL); for (int r = 0; r < 16; ++r) p1[r] = fmaf(p1[r], C2, mnL);
    for (int r = 0; r < 16; ++r) p0[r] = __builtin_amdgcn_exp2f(p0[r]);
}
__device__ __forceinline__ void finishSM(f32x16& p0, f32x16& p1, float alpha, float& l_reg, bf16x8& pa0, bf16x8& pa1, bf16x8& pa2, bf16x8& pa3) {
    for (int r = 0; r < 16; ++r) p1[r] = __builtin_amdgcn_exp2f(p1[r]);
    float ps = 0; for (int r = 0; r < 16; ++r) ps += p0[r]; for (int r = 0; r < 16; ++r) ps += p1[r];
    { auto rr = __builtin_amdgcn_permlane32_swap(__float_as_uint(ps), __float_as_uint(ps), false, false);
      ps = __uint_as_float(rr[0]) + __uint_as_float(rr[1]); }
    l_reg = l_reg * alpha + ps;
#define PK4(P, B_, OUT) do { unsigned a0 = cvtpk(P[B_+0], P[B_+1]), a1 = cvtpk(P[B_+2], P[B_+3]);                          \
        unsigned b0 = cvtpk(P[B_+4], P[B_+5]), b1 = cvtpk(P[B_+6], P[B_+7]);                                             \
        auto r0 = __builtin_amdgcn_permlane32_swap(a0, b0, false, false); auto r1 = __builtin_amdgcn_permlane32_swap(a1, b1, false, false); \
        u32x4 w = {r0[0], r1[0], r0[1], r1[1]}; OUT = *reinterpret_cast<bf16x8*>(&w); } while (0)
    PK4(p0, 0, pa0); PK4(p0, 8, pa1); PK4(p1, 0, pa2); PK4(p1, 8, pa3);
#undef PK4
}
template <int KB>
__device__ __forceinline__ void qkt(f32x16& p0, f32x16& p1, const char* K_lds, int r32, int hi, const bf16x8* qr) {
    p0 = f32x16{}; p1 = f32x16{};
    const char* kb[4];
#pragma unroll
    for (int dd = 0; dd < 4; ++dd) kb[dd] = K_lds + KB * SHM_K + KSWZ(r32, (dd * 16 + hi * 8) * 2);
#pragma unroll
    for (int d0 = 0; d0 < 8; ++d0) { const char* a = kb[d0 & 3] + (d0 >> 2) * 128;
        bf16x8 b0 = *reinterpret_cast<const bf16x8*>(a);
        bf16x8 b1 = *reinterpret_cast<const bf16x8*>(a + 32 * 256);
        p0 = __builtin_amdgcn_mfma_f32_32x32x16_bf16(b0, qr[d0], p0, 0, 0, 0);
        p1 = __builtin_amdgcn_mfma_f32_32x32x16_bf16(b1, qr[d0], p1, 0, 0, 0); }
}
template <int VB>
__device__ __forceinline__ void pv_tile(f32x16* o, int vb0, bf16x8 pa0, bf16x8 pa1, bf16x8 pa2, bf16x8 pa3) {
#define TRRD(dst, off) asm volatile("ds_read_b64_tr_b16 %0, %1 offset:%2" : "=&v"(dst) : "v"(vb0), "i"(off) : "memory")
#define PV_D0(d0) do { s16x4 l0, l1, l2, l3, h0, h1, h2, h3; constexpr int b_ = VB * SHM_V + v_rd_off(d0, 0, 0);     \
        TRRD(l0, b_); TRRD(h0, b_ + 2048); TRRD(l1, b_ + 4096); TRRD(h1, b_ + 6144); TRRD(l2, b_ + 8192); TRRD(h2, b_ + 10240); TRRD(l3, b_ + 12288); TRRD(h3, b_ + 14336); \
        asm volatile("s_waitcnt lgkmcnt(0)" ::: "memory"); SBAR();   \
        o[d0] = __builtin_amdgcn_mfma_f32_32x32x16_bf16(pa0, (bf16x8){l0[0], l0[1], l0[2], l0[3], h0[0], h0[1], h0[2], h0[3]}, o[d0], 0, 0, 0);   \
        o[d0] = __builtin_amdgcn_mfma_f32_32x32x16_bf16(pa1, (bf16x8){l1[0], l1[1], l1[2], l1[3], h1[0], h1[1], h1[2], h1[3]}, o[d0], 0, 0, 0);   \
        o[d0] = __builtin_amdgcn_mfma_f32_32x32x16_bf16(pa2, (bf16x8){l2[0], l2[1], l2[2], l2[3], h2[0], h2[1], h2[2], h2[3]}, o[d0], 0, 0, 0);   \
        o[d0] = __builtin_amdgcn_mfma_f32_32x32x16_bf16(pa3, (bf16x8){l3[0], l3[1], l3[2], l3[3], h3[0], h3[1], h3[2], h3[3]}, o[d0], 0, 0, 0); } while (0)
    PV_D0(0); PV_D0(1); PV_D0(2); PV_D0(3);
#undef PV_D0
#undef TRRD
}

struct BlockRef { const bf16_t* Q; const bf16_t* K; const bf16_t* V; bf16_t* O; const int* rowtab; float* ML; int* LOC; int P0; float ab; int jlo; int item256; };
struct Seam { bf16x8 qr[8]; bf16x8 st_v0, st_v1, st_k0, st_k1; };
#define ROWP(p, k0) ((const char*)(p) + (size_t)(k0) * (PITCH * 2))
#define VMW() asm volatile("s_waitcnt vmcnt(0)" ::: "memory")
#define VMWN(n) asm volatile("s_waitcnt vmcnt(%0)" :: "i"(n) : "memory")
#define SLOAD_H(Kp, Vp, k0) do { const char* vp_ = ROWP(Vp, k0); const char* kp_ = ROWP(Kp, k0);                                   \
                         S.st_v0 = *(const bf16x8*)(vp_ + loff); S.st_v1 = *(const bf16x8*)(vp_ + 32 * PITCH * 2 + loff);          \
                         S.st_k0 = *(const bf16x8*)(kp_ + loff); S.st_k1 = *(const bf16x8*)(kp_ + 32 * PITCH * 2 + loff); } while (0)
#define SWRITE_HK(bf) do { *(bf16x8*)(K_lds + (bf) * SHM_K + kws) = S.st_k0; *(bf16x8*)(K_lds + (bf) * SHM_K + kws + 32 * 256) = S.st_k1; } while (0)
#define SWRITE_HV(bf) do { *(bf16x8*)(V_lds + (bf) * SHM_V + vst0) = S.st_v0; *(bf16x8*)(V_lds + (bf) * SHM_V + vst1) = S.st_v1; } while (0)
#define SWRITE_H(bf) do { SWRITE_HV(bf); SWRITE_HK(bf); } while (0)
__device__ __forceinline__ int fresh_lane() { int l; asm volatile("v_mbcnt_lo_u32_b32 %0, -1, 0\n\tv_mbcnt_hi_u32_b32 %0, -1, %0" : "=v"(l)); return l; }
__device__ __forceinline__ void moba_prime(const BlockRef& cur, char* lds, Seam& S, const int wid) {
    const int lane = fresh_lane(), tid = wid * 64 + lane, r32 = lane & 31, hi = lane >> 5;
    const int sr = tid >> 4, sc = (tid & 15) * 8, kws = KSWZ(sr, sc * 2); char* K_lds = lds + 2 * SHM_V;
    const int rid = cur.rowtab[wid * QBLK + r32], pos = rid >= 0 ? (rid & 0xFFFF) : 0;
    const unsigned loff = (unsigned)(sr * PITCH + sc) * 2u, qoff = (unsigned)(pos * PITCH + hi * 8) * 2u;
#pragma unroll
    for (int d0 = 0; d0 < 8; ++d0) S.qr[d0] = *(const bf16x8*)((const char*)cur.Q + d0 * 32 + qoff);
    SLOAD_H(cur.K, cur.V, cur.jlo * KVBLK); VMW(); SWRITE_HK(0);
    __syncthreads();
}
__device__ __forceinline__ void moba_block(const BlockRef& cur, const BlockRef& nxt, char* lds, Seam& S, const int wid, const int pend_ent, const int pend_idx, int* nxt_rt, int* idx_slot) {
    const int lane = fresh_lane(), tid = wid * 64 + lane, r32 = lane & 31, hi = lane >> 5;
    const int j_lo = cur.jlo; constexpr int NT = 4;
    const int rid = cur.rowtab[wid * QBLK + r32], pos = rid >= 0 ? (rid & 0xFFFF) : 0;
    const int qlo = cur.P0 + wid * QBLK, qm = pos - 4 * hi;
    const float ab = cur.ab, abh = cur.ab * (float)(4 * hi);
    const unsigned mymask = rid >= 0 ? 0xFFFFFFFFu : 0u;
    char* V_lds = lds; char* K_lds = lds + 2 * SHM_V;
    float* ws = (float*)(lds + 2 * SHM_V + 2 * SHM_K) + wid * 64; float* li_l = ws, * al_l = ws + 32;
    float m_reg = -1e30f, l_reg = 0; f32x16 o[4] = {};
    const int sr = tid >> 4, sc = (tid & 15) * 8, vst0 = v_st(sr, sc), vst1 = v_st(32 + sr, sc), kws = KSWZ(sr, sc * 2);
    const unsigned loff = (unsigned)(sr * PITCH + sc) * 2u, qoff = (unsigned)(pos * PITCH + hi * 8) * 2u;
    const int vb0 = (int)(uintptr_t)V_lds + v_rd_base(lane);
    const bf16_t* Kh = cur.K; const bf16_t* Vh = cur.V;
#define RESC(a) do { if (__any((a) < 1.f)) { if (hi == 0) al_l[r32] = (a); asm volatile("s_waitcnt lgkmcnt(0)" ::: "memory");              \
                     for (int d_ = 0; d_ < 4; ++d_) for (int r = 0; r < 16; ++r) o[d_][r] *= al_l[crow(r, hi)]; } } while (0)
#define KBASE(t) ((j_lo + (t)) * KVBLK)
#define BMASK(P0_, P1_, t, OFF_) do { const int kb_ = KBASE(t); const int dq_ = qm - kb_; bias_tile(P0_, P1_, ab);                                   \
        if (kb_ >= cur.P0) { if (kb_ + KVBLK - 1 > qlo) causal_tile(P0_, P1_, dq_); OFF_ = -ab * (float)(dq_ + 4 * hi); }                          \
        else { OFF_ = ((mymask >> (kb_ >> 8)) & 1u) ? -ab * (float)(dq_ + 4 * hi) : -__builtin_inff(); } } while (0)
    constexpr int NQL = 8;
#define SEAM_K0() do { VMWN(NQL); SWRITE_HK(0); SBAR(); } while (0)
    f32x16 pA0, pA1, pB0, pB1; float mnA, mnB, alA, alB, offA, offB; bf16x8 pa0, pa1, pa2, pa3;
    SWRITE_HV(0); SBAR();
    SLOAD_H(Kh, Vh, KBASE(1));
    SBAR(); qkt<0>(pA0, pA1, K_lds, r32, hi, S.qr);
    BMASK(pA0, pA1, 0, offA); partialSM(pA0, pA1, m_reg, mnA, alA, offA, abh);
    VMW(); SWRITE_H(1);
    SBAR(); SLOAD_H(Kh, Vh, KBASE(2)); SBAR();
    if (tid < 256) nxt_rt[tid] = pend_ent;
    if (tid == 0) *idx_slot = pend_idx;
    __syncthreads();
#define HALF_STEP(PX0, PX1, mnX, alX, offX, PY0, PY1, alY, t, KB, VB, SB) do {                                               \
        SBAR(); qkt<KB>(PX0, PX1, K_lds, r32, hi, S.qr);                                                                      \
        finishSM(PY0, PY1, alY, l_reg, pa0, pa1, pa2, pa3); SBAR();                                                           \
        pv_tile<VB>(o, vb0, pa0, pa1, pa2, pa3); BMASK(PX0, PX1, (t), offX); partialSM(PX0, PX1, m_reg, mnX, alX, offX, abh);      \
        __syncthreads();                                                                                                      \
        if ((t) + 1 < NT) { VMW(); SWRITE_H(SB); SBAR(); if ((t) + 2 < NT) { SLOAD_H(Kh, Vh, KBASE((t) + 2)); SBAR(); } }      \
        RESC(alX); __syncthreads(); } while (0)
    for (int t = 1; t + 1 < NT; t += 2) {
        HALF_STEP(pB0, pB1, mnB, alB, offB, pA0, pA1, alA, t, 1, 0, 0);
        HALF_STEP(pA0, pA1, mnA, alA, offA, pB0, pB1, alB, t + 1, 0, 1, 1);
    }
    SBAR(); qkt<1>(pB0, pB1, K_lds, r32, hi, S.qr); SBAR();
    SLOAD_H(nxt.K, nxt.V, nxt.jlo * KVBLK); SBAR();
    { const int ridn = nxt.rowtab[wid * QBLK + r32], posn = ridn >= 0 ? (ridn & 0xFFFF) : 0; const unsigned qoffn = (unsigned)(posn * PITCH + hi * 8) * 2u;
#pragma unroll
    for (int d0 = 0; d0 < 8; ++d0) S.qr[d0] = *(const bf16x8*)((const char*)nxt.Q + d0 * 32 + qoffn); }
    SBAR();
    finishSM(pA0, pA1, alA, l_reg, pa0, pa1, pa2, pa3); SBAR();
    pv_tile<0>(o, vb0, pa0, pa1, pa2, pa3);
    BMASK(pB0, pB1, NT - 1, offB); partialSM(pB0, pB1, m_reg, mnB, alB, offB, abh); __syncthreads(); RESC(alB);
    finishSM(pB0, pB1, alB, l_reg, pa0, pa1, pa2, pa3); SBAR(); pv_tile<1>(o, vb0, pa0, pa1, pa2, pa3);
    SBAR(); SEAM_K0();
    if (hi == 0) li_l[r32] = l_reg; asm volatile("s_waitcnt lgkmcnt(0)" ::: "memory");
    float rli[16];
#pragma unroll
    for (int r = 0; r < 16; ++r) rli[r] = __builtin_amdgcn_rcpf(li_l[crow(r, hi)]);
    const unsigned ooff = (unsigned)((wid * QBLK + 4 * hi) * OPITCH + r32) * 2u;
#pragma unroll
    for (int r = 0; r < 16; ++r) { const int orc = (r & 3) + 8 * (r >> 2);
#pragma unroll
        for (int d0 = 0; d0 < 4; ++d0) { const float v = o[d0][r] * rli[r];
            const float vn = __shfl_xor(v, 1);
            if ((r32 & 1) == 0) *(unsigned*)((char*)cur.O + (size_t)(orc * OPITCH + d0 * 32) * 2 + ooff) = cvtpk(v, vn); } }
    if (hi == 0) { float2 mlv; mlv.x = m_reg; mlv.y = l_reg; *(float2*)(cur.ML + (wid * QBLK + r32) * 2) = mlv;
        if (rid >= 0) cur.LOC[pos * 4 + (rid >> 16)] = cur.item256 + wid * QBLK + r32; }
    __syncthreads();
#undef RESC
#undef KBASE
#undef BMASK
#undef SEAM_K0
#undef HALF_STEP
}
struct UnitRef { const bf16_t* Q; const bf16_t* K; const bf16_t* V; bf16_t* O; float* ML; int* LOC; const int* seg; const int* cnt; float ab; int n; int c; int L; int unit512; };
__device__ __forceinline__ void moba_unit(const UnitRef& u, char* lds, int* rowtab, int* cq, float* wscr, int* idx_slot, const int pend_idx, const int wid) {
    const int lane = fresh_lane(), tid = wid * 64 + lane, r32 = lane & 31, hi = lane >> 5;
    char* V_lds = lds; char* K_lds = lds + 4 * SHM_V;
    const int sr = tid >> 4, sc = (tid & 15) * 8, vst0 = v_st(sr, sc), vst1 = v_st(32 + sr, sc), kws = KSWZ(sr, sc * 2);
    const unsigned loff = (unsigned)(sr * PITCH + sc) * 2u;
    bf16x8 kv[4][4];
#pragma unroll
    for (int t = 0; t < 4; ++t) { const char* vp_ = ROWP(u.V, u.n * 256 + t * 64); const char* kp_ = ROWP(u.K, u.n * 256 + t * 64);
        kv[t][0] = *(const bf16x8*)(vp_ + loff); kv[t][1] = *(const bf16x8*)(vp_ + 32 * PITCH * 2 + loff);
        kv[t][2] = *(const bf16x8*)(kp_ + loff); kv[t][3] = *(const bf16x8*)(kp_ + 32 * PITCH * 2 + loff); }
    if (tid < 32) cq[tid] = (tid > u.n) ? u.cnt[tid] : 0;
    __syncthreads();
    {
        const int sidx = u.c * 512 + tid; int ent = -1;
        if (sidx < 256) ent = (u.n * 256 + sidx) | (3 << 16);
        else { const int g = sidx - 256;
            if (g < u.L) { int acc = 0, qx = u.n + 1;
                while (qx < 31 && g >= acc + cq[qx]) { acc += cq[qx]; ++qx; }
                ent = u.seg[qx * 256 + (g - acc)]; } }
        rowtab[tid] = ent;
    }
#pragma unroll
    for (int t = 0; t < 4; ++t) {
        *(bf16x8*)(V_lds + t * SHM_V + vst0) = kv[t][0]; *(bf16x8*)(V_lds + t * SHM_V + vst1) = kv[t][1];
        *(bf16x8*)(K_lds + t * SHM_K + kws) = kv[t][2]; *(bf16x8*)(K_lds + t * SHM_K + kws + 32 * 256) = kv[t][3]; }
    if (tid == 0) *idx_slot = pend_idx;
    __syncthreads();
    int nr = 256 + u.L - u.c * 512; nr = nr > 512 ? 512 : nr;
    const int ngroups = (nr + 31) >> 5;
    float* li_l = wscr + wid * 64; float* al_l = li_l + 32;
    const int vb0 = (int)(uintptr_t)V_lds + v_rd_base(lane);
    const float ab = u.ab, abh = u.ab * (float)(4 * hi);
#define URESC(a) do { if (__any((a) < 1.f)) { if (hi == 0) al_l[r32] = (a); asm volatile("s_waitcnt lgkmcnt(0)" ::: "memory");              \
                     for (int d_ = 0; d_ < 4; ++d_) for (int r = 0; r < 16; ++r) o[d_][r] *= al_l[crow(r, hi)]; } } while (0)
#define UMASK(P0_, P1_, t, OFF_) do { const int kb_ = u.n * 256 + (t) * KVBLK; const int dq_ = qm - kb_; bias_tile(P0_, P1_, ab);                       \
        if (own) { if (kb_ + KVBLK - 1 > qlo) causal_tile(P0_, P1_, dq_); OFF_ = -ab * (float)(dq_ + 4 * hi); }                                        \
        else OFF_ = rid >= 0 ? -ab * (float)(dq_ + 4 * hi) : -__builtin_inff(); } while (0)
#pragma unroll 1
    for (int grp = wid; grp < ngroups; grp += NW) {
        const int rid = rowtab[grp * 32 + r32], pos = rid >= 0 ? (rid & 0xFFFF) : 0;
        const bool own = (u.c == 0) && (grp < 8);
        const int qlo = u.n * 256 + grp * 32, qm = pos - 4 * hi;
        const unsigned qoff = (unsigned)(pos * PITCH + hi * 8) * 2u;
        bf16x8 qr[8];
#pragma unroll
        for (int d0 = 0; d0 < 8; ++d0) qr[d0] = *(const bf16x8*)((const char*)u.Q + d0 * 32 + qoff);
        float m_reg = -1e30f, l_reg = 0; f32x16 o[4] = {};
        f32x16 pA0, pA1, pB0, pB1; float mnA, mnB, alA, alB, offA, offB; bf16x8 pa0, pa1, pa2, pa3;
        const int nt = own ? (grp >> 1) + 1 : 4;
#define UFIN(P0_, P1_, al_, VB_) do { finishSM(P0_, P1_, al_, l_reg, pa0, pa1, pa2, pa3); pv_tile<VB_>(o, vb0, pa0, pa1, pa2, pa3); } while (0)
        qkt<0>(pA0, pA1, K_lds, r32, hi, qr); UMASK(pA0, pA1, 0, offA); partialSM(pA0, pA1, m_reg, mnA, alA, offA, abh);
        if (nt > 1) qkt<1>(pB0, pB1, K_lds, r32, hi, qr);
        UFIN(pA0, pA1, alA, 0);
        if (nt > 1) {
            UMASK(pB0, pB1, 1, offB); partialSM(pB0, pB1, m_reg, mnB, alB, offB, abh); URESC(alB);
            if (nt > 2) qkt<2>(pA0, pA1, K_lds, r32, hi, qr);
            UFIN(pB0, pB1, alB, 1);
            if (nt > 2) {
                UMASK(pA0, pA1, 2, offA); partialSM(pA0, pA1, m_reg, mnA, alA, offA, abh); URESC(alA);
                if (nt > 3) qkt<3>(pB0, pB1, K_lds, r32, hi, qr);
                UFIN(pA0, pA1, alA, 2);
                if (nt > 3) { UMASK(pB0, pB1, 3, offB); partialSM(pB0, pB1, m_reg, mnB, alB, offB, abh); URESC(alB); UFIN(pB0, pB1, alB, 3); }
            }
        }
#undef UFIN
        if (hi == 0) li_l[r32] = l_reg; asm volatile("s_waitcnt lgkmcnt(0)" ::: "memory");
        float rli[16];
#pragma unroll
        for (int r = 0; r < 16; ++r) rli[r] = __builtin_amdgcn_rcpf(li_l[crow(r, hi)]);
        const unsigned ooff = (unsigned)((grp * 32 + 4 * hi) * OPITCH + r32) * 2u;
#pragma unroll
        for (int r = 0; r < 16; ++r) { const int orc = (r & 3) + 8 * (r >> 2);
#pragma unroll
            for (int d0 = 0; d0 < 4; ++d0) { const float v = o[d0][r] * rli[r];
                const float vn = __shfl_xor(v, 1);
                if ((r32 & 1) == 0) *(unsigned*)((char*)u.O + (size_t)(orc * OPITCH + d0 * 32) * 2 + ooff) = cvtpk(v, vn); } }
        if (hi == 0) { float2 mlv; mlv.x = m_reg; mlv.y = l_reg; *(float2*)(u.ML + (grp * 32 + r32) * 2) = mlv;
            if (rid >= 0) u.LOC[pos * 4 + (rid >> 16)] = u.unit512 + grp * 32 + r32; }
    }
#undef URESC
#undef UMASK
    __syncthreads();
}
#undef ROWP
#undef VMW
#undef VMWN
#undef SLOAD_H
#undef SWRITE_HK
#undef SWRITE_HV
#undef SWRITE_H
#undef KSWZ
#undef SBAR
}

constexpr int NWAVES = 8;
constexpr int RING_OFF = 0, RING_BYTES = 131072;
constexpr int LDSCTL_OFF = RING_BYTES, MISC_OFF = LDSCTL_OFF + 320;
constexpr int LDS_BYTES = 163840;
typedef pg8::bf16_t bf16_t;
typedef short s16x4 __attribute__((ext_vector_type(4)));
typedef unsigned u32x2 __attribute__((ext_vector_type(2)));
typedef unsigned u32x4 __attribute__((ext_vector_type(4)));
constexpr int KSPLIT = 16;

constexpr size_t CTL_BYTES = 65536;
constexpr size_t al256(size_t v) { return (v + 255) & ~(size_t)255; }
constexpr size_t O_ctl = 0;
constexpr size_t O_modp = O_ctl + CTL_BYTES;
constexpr size_t O_shv = O_modp + al256((size_t)KSPLIT * DEPTH * NMOD * 4);
constexpr size_t O_gs = O_shv + al256((size_t)DEPTH * 3 * D * 4);
constexpr size_t O_cres = O_gs + al256((size_t)DEPTH * 3 * D * 4);
constexpr size_t O_bias = O_cres + al256((size_t)DEPTH * 3 * D * 4);
constexpr size_t O_ss = O_bias + al256((size_t)DEPTH * 3 * F2 * 4);
constexpr size_t O_kmp = O_ss + al256((size_t)T * 32 * 4);
constexpr size_t O_sel = O_kmp + al256((size_t)2 * 32 * D * 4);
constexpr size_t O_wgu = O_sel + al256((size_t)T * 16 * 4);
constexpr size_t O_wd = O_wgu + al256((size_t)DEPTH * 2 * F2 * D * 2);
constexpr size_t O_mqkv = O_wd + al256((size_t)DEPTH * 2 * D * F * 2);
constexpr size_t O_mo = O_mqkv + al256((size_t)2 * 3 * D * D * 2);
constexpr size_t O_pw = O_mo + al256((size_t)2 * D * D * 2);
constexpr size_t O_sqkv = O_pw + al256((size_t)D * 512 * 2);
constexpr size_t O_so = O_sqkv + al256((size_t)2560 * D * 2);
constexpr size_t O_x = O_so + al256((size_t)D * D * 2);
constexpr size_t O_ap = O_x + al256((size_t)T * D * 4);
constexpr size_t O_act = O_ap + al256((size_t)T * D * 2);
constexpr size_t O_qb = O_act + al256((size_t)T * F * 2);
constexpr size_t O_kb = O_qb + al256((size_t)T * D * 2);
constexpr size_t O_vb = O_kb + al256((size_t)T * D * 2);
constexpr size_t O_vtb = O_vb + al256((size_t)T * D * 2);
constexpr size_t O_ao = O_vtb + al256((size_t)T * D * 2);
constexpr size_t O_biasp = O_ao + al256((size_t)T * D * 2);
constexpr int MB_MAXUNITS = 16 * (64 + 32);
constexpr size_t O_seg = O_biasp + al256((size_t)32 * DEPTH * 3 * F2 * 4);
constexpr size_t O_cnt = O_seg + al256((size_t)16 * 32 * 32 * 256 * 4);
constexpr size_t O_loc = O_cnt + al256((size_t)16 * 32 * 32 * 4);
constexpr size_t O_ml = O_loc + al256((size_t)16 * T * 4 * 4);
constexpr size_t O_part = O_ml + al256((size_t)MB_MAXUNITS * 512 * 2 * 4);
constexpr size_t WS_NEED = O_part + al256((size_t)MB_MAXUNITS * 512 * 128 * 2);
static_assert(O_kb == O_qb + (size_t)T * D * 2 && O_vb == O_kb + (size_t)T * D * 2, "q | k | v contiguous");
#define W_ctl ((unsigned*)(ws + O_ctl))
#define W_modp ((float*)(ws + O_modp))
#define W_shv ((float*)(ws + O_shv))
#define W_gs ((float*)(ws + O_gs))
#define W_cres ((float*)(ws + O_cres))
#define W_bias ((float*)(ws + O_bias))
#define W_ss ((float*)(ws + O_ss))
#define W_kmp ((float*)(ws + O_kmp))
#define W_sel ((unsigned*)(ws + O_sel))
#define W_wgu ((bf16_t*)(ws + O_wgu))
#define W_wd ((bf16_t*)(ws + O_wd))
#define W_mqkv ((bf16_t*)(ws + O_mqkv))
#define W_mo ((bf16_t*)(ws + O_mo))
#define W_pw ((bf16_t*)(ws + O_pw))
#define W_sqkv ((bf16_t*)(ws + O_sqkv))
#define W_so ((bf16_t*)(ws + O_so))
#define W_x ((bf16_t*)(ws + O_x))
#define XIDX(r_, c_) (((size_t)(((r_) >> 8) * (D / 64) + ((c_) >> 6)) * 256 + ((r_) & 255)) * 64 + ((c_) & 63))
#define W_ap ((bf16_t*)(ws + O_ap))
#define W_act ((bf16_t*)(ws + O_act))
#define W_qb ((bf16_t*)(ws + O_qb))
#define W_kb ((bf16_t*)(ws + O_kb))
#define W_vb ((bf16_t*)(ws + O_vb))
#define W_vtb ((bf16_t*)(ws + O_vtb))
#define W_ao ((bf16_t*)(ws + O_ao))
#define W_biasp ((float*)(ws + O_biasp))
#define W_seg ((int*)(ws + O_seg))
#define W_cnt ((int*)(ws + O_cnt))
#define W_loc ((int*)(ws + O_loc))
#define W_ml ((float*)(ws + O_ml))
#define W_part ((bf16_t*)(ws + O_part))
#define WS_FRESH() GAS unsigned char* wsg_ = (GAS unsigned char*)ws0; asm volatile("" : "+s"(wsg_)); unsigned char* ws = (unsigned char*)wsg_
#define FRESH_TID() int ftid; asm volatile("v_mbcnt_lo_u32_b32 %0, -1, 0\n\tv_mbcnt_hi_u32_b32 %0, -1, %0" : "=v"(ftid)); ftid += (wave << 6); const int flane = ftid & 63; (void)flane
struct Args { const float* in[16]; float* out; unsigned char* ws; };

__device__ __forceinline__ float wave_sum(float v) {
#pragma unroll
    for (int o = 1; o < 64; o <<= 1) v += __shfl_xor(v, o);
    return v;
}
__device__ __forceinline__ float bf2f(unsigned b) { return __builtin_bit_cast(float, b << 16); }

__device__ __forceinline__ void p0_transpose_item(const float* W, int K, int N, bf16_t* WT, int mode, int row_off, LAS float* scr, int item, int lane, const float* sh = nullptr, float* biasp = nullptr) {
    const int nblk = N / 32, kb = item / nblk, nb = item % nblk, k0 = 64 * kb, n0 = 32 * nb;
    const int r0 = mode == 0 ? n0 + row_off : ((n0 >> 7) * 256 + (mode == 2 ? 128 : 0) + (n0 & 127));
    const int hf = lane >> 5, nl = lane & 31;
    float w[32];
    const float* wp = W + (size_t)(k0 + hf) * N + n0 + nl;
#pragma unroll
    for (int i = 0; i < 32; ++i) w[i] = wp[(size_t)(2 * i) * N];
    if (sh) scr[2112 + lane] = sh[k0 + lane];
#pragma unroll
    for (int i = 0; i < 32; ++i) scr[(2 * i + hf) * 33 + nl] = w[i];
    LDS_WAIT(); asm volatile("" ::: "memory");
    if (sh) { float a0 = 0.f, a1 = 0.f;
#pragma unroll
        for (int i = 0; i < 32; i += 2) { a0 += scr[2112 + 2 * i + hf] * w[i]; a1 += scr[2112 + 2 * i + 2 + hf] * w[i + 1]; }
        float a = a0 + a1; a += __shfl_xor(a, 32);
        if (lane < 32) biasp[(size_t)kb * (DEPTH * 3 * F2) + r0 + nl] = a; }
    const int c = lane & 7;
#pragma unroll
    for (int j = 0; j < 4; ++j) { const int n = (lane >> 3) + 8 * j; const LAS float* s = scr + (8 * c) * 33 + n;
        v4u o; o.x = pk2(s[0 * 33], s[1 * 33]); o.y = pk2(s[2 * 33], s[3 * 33]); o.z = pk2(s[4 * 33], s[5 * 33]); o.w = pk2(s[6 * 33], s[7 * 33]);
        *(GAS v4u*)(WT + ((size_t)((r0 >> 8) * (K / 64) + kb) * 256 + ((r0 & 255) + n)) * 64 + 8 * c) = o; }
    LDS_WAIT(); asm volatile("" ::: "memory");
}
constexpr int CVT_GSB = 13312;
struct CvtD { const float* W; bf16_t* WT; const float* sh; float* bp; int N, KT, mode, roff, kb, nb; };
__device__ __forceinline__ void cvt_issue(const CvtD& d, int lane, LAS unsigned char* buf, LAS unsigned char* shb) {
    if (d.sh) {
        __builtin_amdgcn_global_load_lds((const unsigned*)((const char*)(d.sh + 64 * d.kb) + (unsigned)lane * 4u), (LAS unsigned*)shb, 4, 0, 0);
        __builtin_amdgcn_global_load_lds((const unsigned*)((const char*)(d.sh + 64 * d.kb) + (O_gs - O_shv) + (unsigned)lane * 4u), (LAS unsigned*)(shb + CVT_GSB), 4, 0, 0); }
    const float* base = d.W + (size_t)(64 * d.kb) * d.N + 32 * d.nb;
    const unsigned voff = (unsigned)((8 * (lane & 7)) * d.N + 4 * (lane >> 3)) * 4u;
#pragma unroll
    for (int i = 0; i < 8; ++i)
        __builtin_amdgcn_global_load_lds((const unsigned*)((const char*)(base + (size_t)i * d.N) + voff), (LAS unsigned*)(buf + i * 1024), 16, 0, 0);
}
__device__ __forceinline__ void cvt_fin(const CvtD& d, int lane, const LAS unsigned char* buf, const LAS unsigned char* shb) {
    const int n0 = 32 * d.nb, kb = d.kb;
    const int r0 = d.mode == 0 ? n0 + d.roff : ((n0 >> 7) * 256 + (d.mode == 2 ? 128 : 0) + (n0 & 127));
    const int c = lane & 7, nlo = lane >> 3;
    const LAS float* lp = (const LAS float*)buf + ((nlo >> 2) * 32 + c * 4 + (nlo & 3));
    float v[4][8];
#pragma unroll
    for (int j = 0; j < 4; ++j)
#pragma unroll
        for (int e = 0; e < 8; ++e) v[j][e] = lp[e * 256 + j * 64];
    if (d.sh) {
        const f32x4 s0 = *(const LAS f32x4*)(shb + c * 32), s1 = *(const LAS f32x4*)(shb + c * 32 + 16);
        float a[4];
#pragma unroll
        for (int j = 0; j < 4; ++j) { a[j] = ((v[j][0] * s0[0] + v[j][1] * s0[1]) + (v[j][2] * s0[2] + v[j][3] * s0[3])) + ((v[j][4] * s1[0] + v[j][5] * s1[1]) + (v[j][6] * s1[2] + v[j][7] * s1[3]));
            a[j] += __shfl_xor(a[j], 1); a[j] += __shfl_xor(a[j], 2); a[j] += __shfl_xor(a[j], 4); }
        const float av = c == 0 ? a[0] : (c == 1 ? a[1] : (c == 2 ? a[2] : a[3]));
        if (c < 4) d.bp[(size_t)kb * (DEPTH * 3 * F2) + r0 + nlo + 8 * c] = av;
        const f32x4 g0 = *(const LAS f32x4*)(shb + CVT_GSB + c * 32), g1 = *(const LAS f32x4*)(shb + CVT_GSB + c * 32 + 16);
#pragma unroll
        for (int j = 0; j < 4; ++j) { v[j][0] *= g0[0]; v[j][1] *= g0[1]; v[j][2] *= g0[2]; v[j][3] *= g0[3]; v[j][4] *= g1[0]; v[j][5] *= g1[1]; v[j][6] *= g1[2]; v[j][7] *= g1[3]; }
    }
#pragma unroll
    for (int j = 0; j < 4; ++j) {
        v4u o; o.x = pk2(v[j][0], v[j][1]); o.y = pk2(v[j][2], v[j][3]); o.z = pk2(v[j][4], v[j][5]); o.w = pk2(v[j][6], v[j][7]);
        *(GAS v4u*)((GAS char*)(d.WT + ((size_t)((r0 >> 8) * d.KT + kb) * 256 + (r0 & 255) + 8 * j) * 64) + (unsigned)(nlo * 64 + 8 * c) * 2u) = o; }
}
__device__ __forceinline__ void p0_mod_item(const float* c, const float* ada_w, float* modp, int chunk, int l, int ks, int lane) {
    const int j = chunk * 256 + lane * 4, kr = D / KSPLIT, k0 = ks * kr;
    const float* w = ada_w + ((size_t)l * D + k0) * NMOD + j;
    static_assert(D / KSPLIT == 128, "two silu(c) values per lane");
    const float cA = c[k0 + lane], cB = c[k0 + 64 + lane];
    const float sA = cA / (1.f + __expf(-cA)), sB = cB / (1.f + __expf(-cB));
    f32x4 a0 = {0.f, 0.f, 0.f, 0.f}, a1 = a0, a2 = a0, a3 = a0;
#pragma unroll 1
    for (int k = 0; k < kr; k += 16) {
        f32x4 wv[16];
#pragma unroll
        for (int i = 0; i < 16; ++i) wv[i] = *(const f32x4*)(w + (size_t)(k + i) * NMOD);
        const float sv = (k & 64) ? sB : sA;
#pragma unroll
        for (int i = 0; i < 16; i += 4) {
            const int r = (k & 63) + i;
            a0 += wv[i] * __builtin_bit_cast(float, __builtin_amdgcn_readlane(__builtin_bit_cast(int, sv), r)); a1 += wv[i + 1] * __builtin_bit_cast(float, __builtin_amdgcn_readlane(__builtin_bit_cast(int, sv), r + 1));
            a2 += wv[i + 2] * __builtin_bit_cast(float, __builtin_amdgcn_readlane(__builtin_bit_cast(int, sv), r + 2)); a3 += wv[i + 3] * __builtin_bit_cast(float, __builtin_amdgcn_readlane(__builtin_bit_cast(int, sv), r + 3));
        }
    }
    *(f32x4*)(modp + ((size_t)ks * DEPTH + l) * NMOD + j) = (a0 + a1) + (a2 + a3);
}

__device__ __forceinline__ void moba_attn_unit(const bf16_t* __restrict__ Q, const bf16_t* __restrict__ Kb, const bf16_t* __restrict__ VT, const unsigned* __restrict__ sel, bf16_t* __restrict__ O, int gw, int lane) {
    const int lq = lane & 15, quad = lane >> 4;
    const int h = gw & 15, rg = gw >> 4, t0 = rg * 16, qblk = t0 >> 8, tq = t0 + lq;
    const float slope2 = exp2f(-(float)(h + 1) * 0.5f) * LOG2E, sc2 = 0.08838834764831845f * LOG2E;
    bf16x8 qf[4];
#pragma unroll
    for (int kk = 0; kk < 4; ++kk) qf[kk] = *(const bf16x8*)(Q + (size_t)tq * D + h * 128 + kk * 32 + quad * 8);
    const unsigned mymask = sel[tq * 16 + h];
    unsigned um = mymask; um |= __shfl_xor(um, 1); um |= __shfl_xor(um, 2); um |= __shfl_xor(um, 4); um |= __shfl_xor(um, 8);
    um = __builtin_amdgcn_readfirstlane(um) | (1u << qblk);
    float m = -1e30f, l = 0.f; f32x4 o[8];
#pragma unroll
    for (int dt = 0; dt < 8; ++dt) o[dt] = (f32x4){0.f, 0.f, 0.f, 0.f};
    for (int j = 0; j <= qblk; ++j) {
        if (!((um >> j) & 1u)) continue;
        const bool own = (j == qblk), rowsel = own || ((mymask >> j) & 1u);
        const int nsteps = own ? ((t0 + 15 - j * 256) / 32 + 1) : 8;
        for (int st = 0; st < nsteps; ++st) {
            const int kb = j * 256 + st * 32;
            f32x4 s0 = (f32x4){0.f, 0.f, 0.f, 0.f}, s1 = (f32x4){0.f, 0.f, 0.f, 0.f};
#pragma unroll
            for (int kk = 0; kk < 4; ++kk) {
                const bf16x8 a0 = *(const bf16x8*)(Kb + (size_t)(kb + lq) * D + h * 128 + kk * 32 + quad * 8);
                const bf16x8 a1 = *(const bf16x8*)(Kb + (size_t)(kb + 16 + lq) * D + h * 128 + kk * 32 + quad * 8);
                s0 = __builtin_amdgcn_mfma_f32_16x16x32_bf16(a0, qf[kk], s0, 0, 0, 0);
                s1 = __builtin_amdgcn_mfma_f32_16x16x32_bf16(a1, qf[kk], s1, 0, 0, 0);
            }
            float p[8]; float mx = -INFINITY;
#pragma unroll
            for (int i = 0; i < 4; ++i) {
                const int tk0 = kb + quad * 4 + i, tk1 = tk0 + 16;
                float a = s0[i] * sc2 - slope2 * (float)(tq - tk0); if (!rowsel || tk0 > tq) a = -INFINITY;
                float b = s1[i] * sc2 - slope2 * (float)(tq - tk1); if (!rowsel || tk1 > tq) b = -INFINITY;
                p[i] = a; p[4 + i] = b; mx = fmaxf(mx, fmaxf(a, b));
            }
            mx = fmaxf(mx, __shfl_xor(mx, 16)); mx = fmaxf(mx, __shfl_xor(mx, 32));
            const float mn = fmaxf(m, mx), alpha = exp2f(m - mn); m = mn;
            float ps = 0.f;
#pragma unroll
            for (int i = 0; i < 8; ++i) { p[i] = exp2f(p[i] - mn); ps += p[i]; }
            l = l * alpha + ps;
            u32x4 pw; pw.x = pg8::cvt_pk_bf16(p[0], p[1]); pw.y = pg8::cvt_pk_bf16(p[2], p[3]); pw.z = pg8::cvt_pk_bf16(p[4], p[5]); pw.w = pg8::cvt_pk_bf16(p[6], p[7]);
            const bf16x8 pb = __builtin_bit_cast(bf16x8, pw);
#pragma unroll
            for (int dt = 0; dt < 8; ++dt) {
                const bf16_t* vp = VT + (size_t)(h * 128 + dt * 16 + lq) * T + kb + quad * 4;
                const s16x4 x0 = *(const s16x4*)vp, x1 = *(const s16x4*)(vp + 16);
                const bf16x8 va = (bf16x8){x0[0], x0[1], x0[2], x0[3], x1[0], x1[1], x1[2], x1[3]};
                o[dt] = o[dt] * alpha;
                o[dt] = __builtin_amdgcn_mfma_f32_16x16x32_bf16(va, pb, o[dt], 0, 0, 0);
            }
        }
    }
    l += __shfl_xor(l, 16); l += __shfl_xor(l, 32);
    const float inv = 1.0f / l;
#pragma unroll
    for (int dt = 0; dt < 8; ++dt) { u32x2 w; w.x = pg8::cvt_pk_bf16(o[dt][0] * inv, o[dt][1] * inv); w.y = pg8::cvt_pk_bf16(o[dt][2] * inv, o[dt][3] * inv);
        *(u32x2*)(O + (size_t)tq * D + h * 128 + dt * 16 + quad * 4) = w; }
}
__device__ __forceinline__ void swa_attn_unit(const bf16_t* __restrict__ Q, const bf16_t* __restrict__ Kb, const bf16_t* __restrict__ VT, const float* __restrict__ sinks, bf16_t* __restrict__ O, int gw, int lane) {
    const int lq = lane & 15, quad = lane >> 4;
    const int hq = gw & 31, rg = gw >> 5, t0 = rg * 16, hk = hq >> 3, tq = t0 + lq;
    const float slope2 = exp2f(-(float)(hq + 1) * 0.25f) * LOG2E, sc2 = 0.125f * LOG2E, sink2 = sinks[hq] * LOG2E;
    bf16x8 qf[2];
#pragma unroll
    for (int kk = 0; kk < 2; ++kk) qf[kk] = *(const bf16x8*)(Q + (size_t)tq * D + hq * 64 + kk * 32 + quad * 8);
    float p[5][8]; float mx = sink2;
#pragma unroll
    for (int st = 0; st < 5; ++st) {
        const int kb = t0 - 128 + st * 32;
        f32x4 s0 = (f32x4){0.f, 0.f, 0.f, 0.f}, s1 = (f32x4){0.f, 0.f, 0.f, 0.f};
        int r0 = kb + lq, r1 = kb + 16 + lq; r0 = r0 < 0 ? 0 : (r0 > T - 1 ? T - 1 : r0); r1 = r1 < 0 ? 0 : (r1 > T - 1 ? T - 1 : r1);
#pragma unroll
        for (int kk = 0; kk < 2; ++kk) {
            const bf16x8 a0 = *(const bf16x8*)(Kb + (size_t)r0 * 256 + hk * 64 + kk * 32 + quad * 8);
            const bf16x8 a1 = *(const bf16x8*)(Kb + (size_t)r1 * 256 + hk * 64 + kk * 32 + quad * 8);
            s0 = __builtin_amdgcn_mfma_f32_16x16x32_bf16(a0, qf[kk], s0, 0, 0, 0);
            s1 = __builtin_amdgcn_mfma_f32_16x16x32_bf16(a1, qf[kk], s1, 0, 0, 0);
        }
#pragma unroll
        for (int i = 0; i < 4; ++i) {
            const int tk0 = kb + quad * 4 + i, tk1 = tk0 + 16, d0 = tq - tk0, d1 = tq - tk1;
            const float a = (tk0 >= 0 && d0 >= 0 && d0 < 128) ? s0[i] * sc2 - slope2 * (float)d0 : -INFINITY;
            const float b = (tk1 >= 0 && d1 >= 0 && d1 < 128) ? s1[i] * sc2 - slope2 * (float)d1 : -INFINITY;
            p[st][i] = a; p[st][4 + i] = b; mx = fmaxf(mx, fmaxf(a, b));
        }
    }
    mx = fmaxf(mx, __shfl_xor(mx, 16)); mx = fmaxf(mx, __shfl_xor(mx, 32));
    float l = 0.f;
#pragma unroll
    for (int st = 0; st < 5; ++st)
#pragma unroll
        for (int i = 0; i < 8; ++i) { p[st][i] = exp2f(p[st][i] - mx); l += p[st][i]; }
    l += __shfl_xor(l, 16); l += __shfl_xor(l, 32);
    l += exp2f(sink2 - mx);
    f32x4 o[4];
#pragma unroll
    for (int dt = 0; dt < 4; ++dt) o[dt] = (f32x4){0.f, 0.f, 0.f, 0.f};
#pragma unroll
    for (int st = 0; st < 5; ++st) {
        const int kb = t0 - 128 + st * 32;
        u32x4 pw; pw.x = pg8::cvt_pk_bf16(p[st][0], p[st][1]); pw.y = pg8::cvt_pk_bf16(p[st][2], p[st][3]); pw.z = pg8::cvt_pk_bf16(p[st][4], p[st][5]); pw.w = pg8::cvt_pk_bf16(p[st][6], p[st][7]);
        const bf16x8 pb = __builtin_bit_cast(bf16x8, pw);
        int c0 = kb + quad * 4, c1 = c0 + 16; c0 = c0 < 0 ? 0 : (c0 > T - 4 ? T - 4 : c0); c1 = c1 < 0 ? 0 : (c1 > T - 4 ? T - 4 : c1);
#pragma unroll
        for (int dt = 0; dt < 4; ++dt) {
            const bf16_t* vp = VT + (size_t)(hk * 64 + dt * 16 + lq) * T;
            const s16x4 x0 = *(const s16x4*)(vp + c0), x1 = *(const s16x4*)(vp + c1);
            const bf16x8 va = (bf16x8){x0[0], x0[1], x0[2], x0[3], x1[0], x1[1], x1[2], x1[3]};
            o[dt] = __builtin_amdgcn_mfma_f32_16x16x32_bf16(va, pb, o[dt], 0, 0, 0);
        }
    }
    const float inv = 1.0f / l;
#pragma unroll
    for (int dt = 0; dt < 4; ++dt) { u32x2 w; w.x = pg8::cvt_pk_bf16(o[dt][0] * inv, o[dt][1] * inv); w.y = pg8::cvt_pk_bf16(o[dt][2] * inv, o[dt][3] * inv);
        *(u32x2*)(O + (size_t)tq * D + hq * 64 + dt * 16 + quad * 4) = w; }
}

__device__ __forceinline__ void swa_attn_unit2(const bf16_t* __restrict__ Q, const bf16_t* __restrict__ Kb, const bf16_t* __restrict__ VT, const float* __restrict__ sinks, bf16_t* __restrict__ O, int gw0, int gw1, int lane) {
    const int lq = lane & 15, quad = lane >> 4;
    int hq[2], t0[2], hk[2], tq[2]; float slope2[2], sink2[2];
    constexpr float sc2 = 0.125f * LOG2E;
#pragma unroll
    for (int w = 0; w < 2; ++w) { const int gw = w ? gw1 : gw0; hq[w] = gw & 31; t0[w] = (gw >> 5) * 16; hk[w] = hq[w] >> 3; tq[w] = t0[w] + lq;
        slope2[w] = exp2f(-(float)(hq[w] + 1) * 0.25f) * LOG2E; sink2[w] = sinks[hq[w]] * LOG2E; }
    bf16x8 qf[2][2];
#pragma unroll
    for (int w = 0; w < 2; ++w)
#pragma unroll
        for (int kk = 0; kk < 2; ++kk) qf[w][kk] = *(const bf16x8*)(Q + (size_t)tq[w] * D + hq[w] * 64 + kk * 32 + quad * 8);
    float p[2][5][8]; float mx[2] = {sink2[0], sink2[1]};
#pragma unroll
    for (int st = 0; st < 5; ++st) {
        bf16x8 ka[2][2];
        { const int kb = t0[0] - 128 + st * 32;
            int r0 = kb + lq, r1 = kb + 16 + lq; r0 = r0 < 0 ? 0 : (r0 > T - 1 ? T - 1 : r0); r1 = r1 < 0 ? 0 : (r1 > T - 1 ? T - 1 : r1);
#pragma unroll
            for (int kk = 0; kk < 2; ++kk) { ka[kk][0] = *(const bf16x8*)(Kb + (size_t)r0 * 256 + hk[0] * 64 + kk * 32 + quad * 8);
                ka[kk][1] = *(const bf16x8*)(Kb + (size_t)r1 * 256 + hk[0] * 64 + kk * 32 + quad * 8); } }
#pragma unroll
        for (int w = 0; w < 2; ++w) { const int kb = t0[w] - 128 + st * 32;
            f32x4 s0 = (f32x4){0.f, 0.f, 0.f, 0.f}, s1 = (f32x4){0.f, 0.f, 0.f, 0.f};
#pragma unroll
            for (int kk = 0; kk < 2; ++kk) { s0 = __builtin_amdgcn_mfma_f32_16x16x32_bf16(ka[kk][0], qf[w][kk], s0, 0, 0, 0); s1 = __builtin_amdgcn_mfma_f32_16x16x32_bf16(ka[kk][1], qf[w][kk], s1, 0, 0, 0); }
#pragma unroll
            for (int i = 0; i < 4; ++i) {
                const int tk0 = kb + quad * 4 + i, tk1 = tk0 + 16, d0 = tq[w] - tk0, d1 = tq[w] - tk1;
                const float a = (tk0 >= 0 && d0 >= 0 && d0 < 128) ? s0[i] * sc2 - slope2[w] * (float)d0 : -INFINITY;
                const float bq = (tk1 >= 0 && d1 >= 0 && d1 < 128) ? s1[i] * sc2 - slope2[w] * (float)d1 : -INFINITY;
                p[w][st][i] = a; p[w][st][4 + i] = bq; mx[w] = fmaxf(mx[w], fmaxf(a, bq));
            } }
    }
    float l[2];
#pragma unroll
    for (int w = 0; w < 2; ++w) { mx[w] = fmaxf(mx[w], __shfl_xor(mx[w], 16)); mx[w] = fmaxf(mx[w], __shfl_xor(mx[w], 32));
        float ls = 0.f;
#pragma unroll
        for (int st = 0; st < 5; ++st)
#pragma unroll
            for (int i = 0; i < 8; ++i) { p[w][st][i] = exp2f(p[w][st][i] - mx[w]); ls += p[w][st][i]; }
        ls += __shfl_xor(ls, 16); ls += __shfl_xor(ls, 32);
        l[w] = ls + exp2f(sink2[w] - mx[w]); }
    f32x4 o[2][4];
#pragma unroll
    for (int w = 0; w < 2; ++w)
#pragma unroll
        for (int dt = 0; dt < 4; ++dt) o[w][dt] = (f32x4){0.f, 0.f, 0.f, 0.f};
#pragma unroll
    for (int st = 0; st < 5; ++st) {
        s16x4 xv[4][2];
        { const int kb = t0[0] - 128 + st * 32;
            int c0 = kb + quad * 4, c1 = c0 + 16; c0 = c0 < 0 ? 0 : (c0 > T - 4 ? T - 4 : c0); c1 = c1 < 0 ? 0 : (c1 > T - 4 ? T - 4 : c1);
#pragma unroll
            for (int dt = 0; dt < 4; ++dt) { const bf16_t* vp = VT + (size_t)(hk[0] * 64 + dt * 16 + lq) * T; xv[dt][0] = *(const s16x4*)(vp + c0); xv[dt][1] = *(const s16x4*)(vp + c1); } }
#pragma unroll
        for (int w = 0; w < 2; ++w) {
            u32x4 pw; pw.x = pg8::cvt_pk_bf16(p[w][st][0], p[w][st][1]); pw.y = pg8::cvt_pk_bf16(p[w][st][2], p[w][st][3]); pw.z = pg8::cvt_pk_bf16(p[w][st][4], p[w][st][5]); pw.w = pg8::cvt_pk_bf16(p[w][st][6], p[w][st][7]);
            const bf16x8 pb = __builtin_bit_cast(bf16x8, pw);
#pragma unroll
            for (int dt = 0; dt < 4; ++dt) { const s16x4 x0 = xv[dt][0], x1 = xv[dt][1];
                const bf16x8 va = (bf16x8){x0[0], x0[1], x0[2], x0[3], x1[0], x1[1], x1[2], x1[3]};
                o[w][dt] = __builtin_amdgcn_mfma_f32_16x16x32_bf16(va, pb, o[w][dt], 0, 0, 0); } }
    }
#pragma unroll
    for (int w = 0; w < 2; ++w) { const float inv = 1.0f / l[w];
#pragma unroll
        for (int dt = 0; dt < 4; ++dt) { u32x2 wv; wv.x = pg8::cvt_pk_bf16(o[w][dt][0] * inv, o[w][dt][1] * inv); wv.y = pg8::cvt_pk_bf16(o[w][dt][2] * inv, o[w][dt][3] * inv);
            *(u32x2*)(O + (size_t)tq[w] * D + hq[w] * 64 + dt * 16 + quad * 4) = wv; } }
}

__device__ __forceinline__ void swa_attn_unit4(const bf16_t* __restrict__ Q, const bf16_t* __restrict__ Kb, const bf16_t* __restrict__ VT, const float* __restrict__ sinks, bf16_t* __restrict__ O, int gw0, int lane) {
    const int lq = lane & 15, quad = lane >> 4;
    const int hq0 = gw0 & 31, t0 = (gw0 >> 5) * 16, hk = hq0 >> 3, tq = t0 + lq;
    constexpr float sc2 = 0.125f * LOG2E;
    float slope2[4], sink2[4], m[4], l[4]; bf16x8 qf[4][2]; f32x4 o[4][4];
#pragma unroll
    for (int w = 0; w < 4; ++w) { slope2[w] = exp2f(-(float)(hq0 + w + 1) * 0.25f) * LOG2E; sink2[w] = sinks[hq0 + w] * LOG2E; m[w] = sink2[w]; l[w] = 0.f;
#pragma unroll
        for (int kk = 0; kk < 2; ++kk) qf[w][kk] = *(const bf16x8*)(Q + (size_t)tq * D + (hq0 + w) * 64 + kk * 32 + quad * 8);
#pragma unroll
        for (int dt = 0; dt < 4; ++dt) o[w][dt] = (f32x4){0.f, 0.f, 0.f, 0.f}; }
#define SWA4_LOAD(KA, XV, st_) do { const int kb_ = t0 - 128 + (st_) * 32;                                                                                             \
        int r0 = kb_ + lq, r1 = kb_ + 16 + lq; r0 = r0 < 0 ? 0 : (r0 > T - 1 ? T - 1 : r0); r1 = r1 < 0 ? 0 : (r1 > T - 1 ? T - 1 : r1);                                  \
        _Pragma("unroll") for (int kk = 0; kk < 2; ++kk) { KA[kk][0] = *(const bf16x8*)(Kb + (size_t)r0 * 256 + hk * 64 + kk * 32 + quad * 8); KA[kk][1] = *(const bf16x8*)(Kb + (size_t)r1 * 256 + hk * 64 + kk * 32 + quad * 8); } \
        int c0 = kb_ + quad * 4, c1 = c0 + 16; c0 = c0 < 0 ? 0 : (c0 > T - 4 ? T - 4 : c0); c1 = c1 < 0 ? 0 : (c1 > T - 4 ? T - 4 : c1);                                   \
        _Pragma("unroll") for (int dt = 0; dt < 4; ++dt) { const bf16_t* vp = VT + (size_t)(hk * 64 + dt * 16 + lq) * T; XV[dt][0] = *(const s16x4*)(vp + c0); XV[dt][1] = *(const s16x4*)(vp + c1); } } while (0)
    bf16x8 ka[2][2], kan[2][2]; s16x4 xv[4][2], xvn[4][2];
    SWA4_LOAD(ka, xv, 0);
#pragma unroll 1
    for (int st = 0; st < 5; ++st) {
        const int kb = t0 - 128 + st * 32;
        SWA4_LOAD(kan, xvn, st < 4 ? st + 1 : 4);
#pragma unroll
        for (int w = 0; w < 4; ++w) {
            f32x4 s0 = (f32x4){0.f, 0.f, 0.f, 0.f}, s1 = (f32x4){0.f, 0.f, 0.f, 0.f};
#pragma unroll
            for (int kk = 0; kk < 2; ++kk) { s0 = __builtin_amdgcn_mfma_f32_16x16x32_bf16(ka[kk][0], qf[w][kk], s0, 0, 0, 0); s1 = __builtin_amdgcn_mfma_f32_16x16x32_bf16(ka[kk][1], qf[w][kk], s1, 0, 0, 0); }
            float pv[8]; float mloc = -INFINITY;
#pragma unroll
            for (int i = 0; i < 4; ++i) {
                const int tk0 = kb + quad * 4 + i, tk1 = tk0 + 16, d0 = tq - tk0, d1 = tq - tk1;
                pv[i] = (tk0 >= 0 && d0 >= 0 && d0 < 128) ? s0[i] * sc2 - slope2[w] * (float)d0 : -INFINITY;
                pv[4 + i] = (tk1 >= 0 && d1 >= 0 && d1 < 128) ? s1[i] * sc2 - slope2[w] * (float)d1 : -INFINITY;
                mloc = fmaxf(mloc, fmaxf(pv[i], pv[4 + i]));
            }
            mloc = fmaxf(mloc, __shfl_xor(mloc, 16)); mloc = fmaxf(mloc, __shfl_xor(mloc, 32));
            const float mnew = fmaxf(m[w], mloc), alpha = exp2f(m[w] - mnew);
            m[w] = mnew;
            float ps = 0.f;
#pragma unroll
            for (int i = 0; i < 8; ++i) { pv[i] = exp2f(pv[i] - mnew); ps += pv[i]; }
            l[w] = l[w] * alpha + ps;
            u32x4 pw; pw.x = pg8::cvt_pk_bf16(pv[0], pv[1]); pw.y = pg8::cvt_pk_bf16(pv[2], pv[3]); pw.z = pg8::cvt_pk_bf16(pv[4], pv[5]); pw.w = pg8::cvt_pk_bf16(pv[6], pv[7]);
            const bf16x8 pb = __builtin_bit_cast(bf16x8, pw);
#pragma unroll
            for (int dt = 0; dt < 4; ++dt) { const s16x4 x0 = xv[dt][0], x1 = xv[dt][1];
                const bf16x8 va = (bf16x8){x0[0], x0[1], x0[2], x0[3], x1[0], x1[1], x1[2], x1[3]};
                o[w][dt] = __builtin_amdgcn_mfma_f32_16x16x32_bf16(va, pb, o[w][dt] * alpha, 0, 0, 0); }
        }
#pragma unroll
        for (int kk = 0; kk < 2; ++kk) { ka[kk][0] = kan[kk][0]; ka[kk][1] = kan[kk][1]; }
#pragma unroll
        for (int dt = 0; dt < 4; ++dt) { xv[dt][0] = xvn[dt][0]; xv[dt][1] = xvn[dt][1]; }
    }
#undef SWA4_LOAD
#pragma unroll
    for (int w = 0; w < 4; ++w) { float ls = l[w]; ls += __shfl_xor(ls, 16); ls += __shfl_xor(ls, 32); ls += exp2f(sink2[w] - m[w]);
        const float inv = 1.0f / ls;
#pragma unroll
        for (int dt = 0; dt < 4; ++dt) { u32x2 wv; wv.x = pg8::cvt_pk_bf16(o[w][dt][0] * inv, o[w][dt][1] * inv); wv.y = pg8::cvt_pk_bf16(o[w][dt][2] * inv, o[w][dt][3] * inv);
            *(u32x2*)(O + (size_t)tq * D + (hq0 + w) * 64 + dt * 16 + quad * 4) = wv; } }
}

__global__ void __launch_bounds__(NWAVES * 64, 2) mk_fwd(Args args) {
    extern __shared__ __attribute__((aligned(16))) unsigned char lds_raw[];
    LAS unsigned char* lds = (LAS unsigned char*)lds_raw;
    volatile LAS unsigned* MISC = (volatile LAS unsigned*)(lds + MISC_OFF);
    const int tid = threadIdx.x, lane = tid & 63, wave = __builtin_amdgcn_readfirstlane(tid >> 6);
    const int G = gridDim.x, bx = blockIdx.x;
    const int vcu = (G % 8 == 0) ? (bx % 8) * (G / 8) + bx / 8 : bx;
    const int gw = vcu * NWAVES + wave, NGW = G * NWAVES;
    unsigned char* const ws0 = args.ws;
    for (int u = tid; u < (LDS_BYTES - LDSCTL_OFF) / 4; u += NWAVES * 64) ((LAS unsigned*)(lds + LDSCTL_OFF))[u] = 0u;
    __syncthreads();
    XcdBarrier bar; { unsigned char* ws = ws0; bar = xcd_barrier_post(W_ctl + 4096, MISC + 8); }
#define GRID_BAR() do { XcdBarrier b_ = bar; { WS_FRESH(); b_.bar = W_ctl + 4096; b_.x = xb_xcc_id(); } xcd_barrier(b_); } while (0)
    const float* x_in = args.in[0]; const float* c_in = args.in[1]; const float* norm_g = args.in[2]; const float* ada_w = args.in[3]; const float* ada_b = args.in[4];
    const float* w_gate = args.in[5]; const float* w_up = args.in[6]; const float* w_down = args.in[7]; const float* moba_qkv = args.in[8]; const float* moba_o = args.in[9];
    const float* pool_w = args.in[10]; const float* pool_scale = args.in[11]; const float* swa_qkv = args.in[12]; const float* swa_o = args.in[13]; const float* swa_sinks = args.in[14];
    const float* final_g = args.in[15];

    {
        WS_FRESH();
        LAS float* scr = (LAS float*)(lds + RING_OFF + wave * 16384);
        constexpr int I_MOD = KSPLIT * 72, I_FFN = 5632, I_MQ = 32 * 192, I_MO = 32 * 64;
        constexpr int NITEMS = I_MOD + 2 * I_FFN;
        (void)I_MO; (void)I_MQ;
        for (int it = gw; it < NITEMS; it += NGW) {
            int r = it;
            if (r < I_MOD) { p0_mod_item(c_in, ada_w, W_modp, r % 72, 0, r / 72, lane); continue; } r -= I_MOD;
            if (r < I_FFN) p0_transpose_item(w_gate, D, F, W_wgu, 1, 0, scr, r, lane);
            else p0_transpose_item(w_up, D, F, W_wgu, 2, 0, scr, r - I_FFN, lane);
        }
    }
    GRID_BAR();
#define P0B_RANGE(tid_, lo_, hi_) \
    for (int idx = (lo_) * D + (vcu * NWAVES * 64) + (tid_); idx < (hi_) * D; idx += G * NWAVES * 64) { \
        const int c = idx % D, sub = idx / D, l = sub / 3, s = sub % 3; \
        const size_t i0 = (size_t)l * NMOD + (3 * s) * D + c; \
        float sh = ada_b[i0], sc = ada_b[i0 + D], gt = ada_b[i0 + 2 * D]; \
        for (int ks = 0; ks < KSPLIT; ++ks) { const float* mp = W_modp + (size_t)ks * DEPTH * NMOD + i0; sh += mp[0]; sc += mp[D]; gt += mp[2 * D]; } \
        W_shv[idx] = sh; W_gs[idx] = norm_g[idx] * (1.f + sc); \
        float cr = gt * (s == 1 ? 1.f : 0.5f); if (s == 1 && (l % 3) == 1) cr *= pool_scale[(l / 3) * D + c]; \
        W_cres[idx] = cr; }
    { WS_FRESH(); P0B_RANGE(tid, 0, 3) }
    if (false) { WS_FRESH();
    for (int idx = (vcu * NWAVES * 64) + tid; idx < DEPTH * 3 * D; idx += G * NWAVES * 64) {
        const int c = idx % D, sub = idx / D, l = sub / 3, s = sub % 3;
        const size_t i0 = (size_t)l * NMOD + (3 * s) * D + c;
        float sh = ada_b[i0], sc = ada_b[i0 + D], gt = ada_b[i0 + 2 * D];
        for (int ks = 0; ks < KSPLIT; ++ks) { const float* mp = W_modp + (size_t)ks * DEPTH * NMOD + i0; sh += mp[0]; sc += mp[D]; gt += mp[2 * D]; }
        W_shv[idx] = sh; W_gs[idx] = norm_g[idx] * (1.f + sc);
        float cr = gt * (s == 1 ? 1.f : 0.5f); if (s == 1 && (l % 3) == 1) cr *= pool_scale[(l / 3) * D + c];
        W_cres[idx] = cr;
    } }
    GRID_BAR();
    { WS_FRESH();
    for (int sub = 0; sub < 1; ++sub) {
        const int l = sub / 3, s = sub % 3, kind = l % 3, j = l / 3;
        const bf16_t* Wt; int nrows;
        if (s != 1) { Wt = W_wgu + (size_t)(l * 2 + (s >> 1)) * F2 * D; nrows = F2; }
        else if (kind == 0) { Wt = W_mqkv + (size_t)j * 3 * D * D; nrows = 3 * D; }
        else if (kind == 2) { Wt = W_sqkv; nrows = 2560; }
        else { Wt = nullptr; nrows = 0; }
        const float* sh = W_shv + (size_t)sub * D;
        for (int n = gw; n < nrows; n += NGW) {
            float a = 0.f;
#pragma unroll
            for (int k = lane * 8; k < D; k += 512) {
                const bf16x8 wv = *(const bf16x8*)(Wt + ((size_t)((n >> 8) * (D / 64) + (k >> 6)) * 256 + (n & 255)) * 64 + (k & 63)); const f32x4 s0 = *(const f32x4*)(sh + k), s1 = *(const f32x4*)(sh + k + 4);
                a += s0[0] * bf2f((unsigned short)wv[0]) + s0[1] * bf2f((unsigned short)wv[1]) + s0[2] * bf2f((unsigned short)wv[2]) + s0[3] * bf2f((unsigned short)wv[3])
                   + s1[0] * bf2f((unsigned short)wv[4]) + s1[1] * bf2f((unsigned short)wv[5]) + s1[2] * bf2f((unsigned short)wv[6]) + s1[3] * bf2f((unsigned short)wv[7]);
            }
            a = wave_sum(a);
            if (lane == 0) W_bias[(size_t)sub * F2 + n] = a;
        }
    }
    for (int t = gw; t < T; t += NGW) {
        float ssq = 0.f;
#pragma unroll
        for (int c = lane * 4; c < D; c += 256) { const f32x4 v = *(const f32x4*)(x_in + (size_t)t * D + c); const f32x4 g = *(const f32x4*)(W_gs + c);
            ssq += (v[0] * v[0] + v[1] * v[1]) + (v[2] * v[2] + v[3] * v[3]);
            u32x2 o; o.x = pg8::cvt_pk_bf16(v[0] * g[0], v[1] * g[1]); o.y = pg8::cvt_pk_bf16(v[2] * g[2], v[3] * g[3]); *(u32x2*)(W_ap + ((size_t)((t >> 8) * (D / 64) + (c >> 6)) * 256 + (t & 255)) * 64 + (c & 63)) = o;
            u32x2 xo; xo.x = pg8::cvt_pk_bf16(v[0], v[1]); xo.y = pg8::cvt_pk_bf16(v[2], v[3]); *(u32x2*)(W_x + XIDX(t, c)) = xo; }
        ssq = wave_sum(ssq);
        if (lane < 32) W_ss[(size_t)t * 32 + lane] = lane == 0 ? ssq : 0.f;
    } }
    GRID_BAR();

    for (int sub = 0; sub < DEPTH * 3; ++sub) {
        WS_FRESH();
        const int l = sub / 3, s = sub % 3, kind = l % 3, j = l / 3;
        const bool sitesub = (sub == 0 || sub == 2 || sub == 3 || sub == 5 || sub == 6 || sub == 8 || sub == 9);
        const bool hostsub = (G == 256) && sitesub;
        const float* bias = W_bias + (size_t)sub * F2;
        const bf16_t* rA; const bf16_t* rB; int rK, rlda, rgrp, rtile = 0;
        if (s != 1) {
            const size_t wi = (size_t)(l * 2 + (s >> 1));
            const bool convwg = hostsub && bx >= G - 16;
            if (!convwg) {
                pg8::Gemm g{sub == 0 ? W_ap : W_x, W_wgu + wi * F2 * D, T, F2, D, D, 0, 1, 1}; pg8::StaticOrder S; S.init(T, F2, hostsub ? G - 16 : G, bx);
                const float* rtab = (const float*)((char*)lds_raw + LDSCTL_OFF + 8192); const float* btab = rtab + 6 * 256;
                {
                    FRESH_TID();
                    LAS float* rt = (LAS float*)(lds + LDSCTL_OFF + 8192); LAS float* bt = rt + 6 * 256;
                    f32x4 sv[6][4]; float bv[6]; pg8::Unit uu[6]; bool ok[6];
#pragma unroll
                    for (int i = 0; i < 6; ++i) { ok[i] = S.next(i, uu[i]); const int pm_ = ok[i] ? uu[i].pm : 0, pn_ = ok[i] ? uu[i].pn : 0;
                        const f32x4* p = (const f32x4*)(W_ss + ((size_t)pm_ * 256 + (ftid >> 1)) * 32 + (ftid & 1) * 16);
                        sv[i][0] = p[0]; sv[i][1] = p[1]; sv[i][2] = p[2]; sv[i][3] = p[3];
                        bv[i] = bias[pn_ * 256 + (ftid & 255)]; }
                    __syncthreads();
#pragma unroll
                    for (int i = 0; i < 6; ++i) { const f32x4 t4 = (sv[i][0] + sv[i][1]) + (sv[i][2] + sv[i][3]); float s1 = (t4[0] + t4[1]) + (t4[2] + t4[3]); s1 += __shfl_xor(s1, 1);
                        if ((ftid & 1) == 0) rt[i * 256 + (ftid >> 1)] = __builtin_amdgcn_rsqf(s1 * (1.0f / D) + EPS);
                        if (ftid < 256) bt[i * 256 + ftid] = bv[i]; }
                    __syncthreads();
                }
                pg8::EpiGU E{rtab, btab, W_act};
                { FRESH_TID(); pg8::gemm_phase<pg8::EpiGU, pg8::StaticOrder, true>(lds + RING_OFF, g, S, E, ftid); }
            }
            rA = W_act; rB = W_wd + wi * D * F; rK = F; rlda = F; rgrp = 0; rtile = 1;
        } else if (kind == 0 || kind == 2) {
            const bool moba = (kind == 0);
            const bf16_t* Wt = moba ? W_mqkv + (size_t)j * 3 * D * D : W_sqkv; const int N = moba ? 3 * D : 2560;
            pg8::Gemm g{W_x, Wt, T, N, D, D, 0, 1, 1}; pg8::StaticOrder S; S.init(T, N, G, bx);
            pg8::EpiQKV E{W_ss, bias, W_qb, moba ? nullptr : W_vtb, moba ? W_kmp : nullptr, W_ctl + 12288 + j * 64, D, moba ? D : 256, moba ? 1 : 0};
            { FRESH_TID(); pg8::gemm_phase<pg8::EpiQKV, pg8::StaticOrder, true>(lds + RING_OFF, g, S, E, ftid); }
            GRID_BAR();
            if (moba) {
                FRESH_TID();
                LAS float* km = (LAS float*)(lds + RING_OFF + 67584);
                LAS unsigned* picks = (LAS unsigned*)(lds + RING_OFF + 84480);
                int item0 = vcu; asm volatile("" : "+s"(item0));
#pragma unroll 1
                for (int it = item0; it < 256; it += G)
#pragma unroll 1
                    for (int ps = 0; ps < 2; ++ps) {
                        const int h_ = it >> 4, y_ = it & 15, qb_ = ps ? 31 - y_ : y_;
                        const float* kmp_h = W_kmp + h_ * 128;
                        __syncthreads();
                        for (int e = ftid; e < qb_ * 32; e += NWAVES * 64) { const int n = e >> 5, d4 = (e & 31) * 4;
                            const f32x4 a = *(const f32x4*)(kmp_h + (size_t)n * D + d4), bq = *(const f32x4*)(kmp_h + (size_t)(32 + n) * D + d4);
                            *(LAS f32x4*)(km + n * 136 + (d4 >> 6) * 68 + (d4 & 63)) = a + bq; }
                        __syncthreads();
                        const int row = ftid >> 1, half = ftid & 1;
                        float q[64];
                        { const bf16_t* qp = W_qb + ((size_t)h_ * T + qb_ * 256 + row) * 128 + half * 64;
#pragma unroll
                          for (int i = 0; i < 8; ++i) { const bf16x8 v = *(const bf16x8*)(qp + i * 8);
#pragma unroll
                              for (int jj = 0; jj < 8; ++jj) q[i * 8 + jj] = bf2f((unsigned short)v[jj]); } }
                        float v0 = -INFINITY, v1 = -INFINITY, v2 = -INFINITY; int i0 = -1, i1 = -1, i2 = -1;
#pragma unroll 1
                        for (int n = 0; n < qb_; ++n) {
                            const LAS float* kp = km + n * 136 + half * 68;
                            float a0 = 0.f, a1 = 0.f, a2 = 0.f, a3 = 0.f;
#pragma unroll
                            for (int jj = 0; jj < 64; jj += 4) { const f32x4 kv = *(const LAS f32x4*)(kp + jj);
                                a0 += q[jj] * kv[0]; a1 += q[jj + 1] * kv[1]; a2 += q[jj + 2] * kv[2]; a3 += q[jj + 3] * kv[3]; }
                            float gsc = (a0 + a1) + (a2 + a3); gsc += __shfl_xor(gsc, 1);
                            if (gsc > v0) { v2 = v1; i2 = i1; v1 = v0; i1 = i0; v0 = gsc; i0 = n; }
                            else if (gsc > v1) { v2 = v1; i2 = i1; v1 = gsc; i1 = n; }
                            else if (gsc > v2) { v2 = gsc; i2 = n; }
                        }
                        {
                            float l1 = 0.f;
#pragma unroll
                            for (int i = 0; i < 64; ++i) l1 += fabsf(q[i]);
                            l1 += __shfl_xor(l1, 1);
                            const float kmaxv = __uint_as_float(__hip_atomic_load(W_ctl + 12288 + j * 64 + h_, __ATOMIC_RELAXED, __HIP_MEMORY_SCOPE_AGENT));
                            const float Bq = mb::SCALE * l1 * kmaxv * 1.02f, slope = exp2f(-(float)(h_ + 1) * 0.5f);
                            const float Dz = (2.f * Bq + 104.f) / slope, posf = (float)(qb_ * 256 + row - 255);
                            if (i0 >= 0 && posf - (float)(i0 * 256) > Dz) i0 = -1;
                            if (i1 >= 0 && posf - (float)(i1 * 256) > Dz) i1 = -1;
                            if (i2 >= 0 && posf - (float)(i2 * 256) > Dz) i2 = -1;
                        }
                        if (half == 0) { picks[row] = (unsigned)(i0 & 255) | ((unsigned)(i1 & 255) << 8) | ((unsigned)(i2 & 255) << 16);
                            int* lc = W_loc + ((size_t)h_ * T + qb_ * 256 + row) * 4;
                            if (i0 < 0) lc[0] = -1; if (i1 < 0) lc[1] = -1; if (i2 < 0) lc[2] = -1; }
                        __syncthreads();
#pragma unroll 1
                        for (int n = wave; n < qb_; n += NWAVES) {
                            int base = 0; int* sg = W_seg + (size_t)((h_ * 32 + n) * 32 + qb_) * 256;
#pragma unroll 1
                            for (int p4 = 0; p4 < 4; ++p4) { const int r = p4 * 64 + flane; const unsigned pk = picks[r];
                                const int sl = (pk & 255u) == (unsigned)n ? 0 : (((pk >> 8) & 255u) == (unsigned)n ? 1 : (((pk >> 16) & 255u) == (unsigned)n ? 2 : -1));
                                const unsigned long long bal = __ballot(sl >= 0);
                                const int rank = __popcll(bal & ((1ull << flane) - 1ull));
                                if (sl >= 0) sg[base + rank] = (qb_ * 256 + r) | (sl << 16);
                                base += __popcll(bal); }
                            if (flane == 0) W_cnt[(h_ * 32 + n) * 32 + qb_] = base;
                        }
                    }
                GRID_BAR();
            } else {
                FRESH_TID(); const int lane = flane;
#pragma unroll 1
                for (int u = gw; u < (T / 16) * 8; u += NGW) swa_attn_unit4(W_qb, W_kb, W_vtb, swa_sinks, W_ao, 4 * u, lane);
            }
            rA = W_ao; rB = moba ? W_mo + (size_t)j * D * D : W_so; rK = D; rlda = D; rgrp = 0;
        } else {
            const bf16_t* xc = W_x; const float* gsv = W_gs + (size_t)sub * D;
#define XLD4(p_) ({ const u32x2 q_ = *(const u32x2*)(p_); (f32x4){__builtin_bit_cast(float, q_.x << 16), __builtin_bit_cast(float, q_.x & 0xFFFF0000u), __builtin_bit_cast(float, q_.y << 16), __builtin_bit_cast(float, q_.y & 0xFFFF0000u)}; })
            LAS float* rtab = (LAS float*)(lds + RING_OFF);
            FRESH_TID(); const int tid = ftid;
            for (int un = vcu; un < T / 32; un += G) {
                const int r0 = un * 32;
                __syncthreads();
                if (tid < 47) { const int r = r0 - 15 + tid; float sv = 0.f;
                    if (r >= 0) { const f32x4* p = (const f32x4*)(W_ss + (size_t)r * 32);
#pragma unroll
                        for (int q = 0; q < 8; ++q) { const f32x4 v = p[q]; sv += (v[0] + v[1]) + (v[2] + v[3]); } }
                    rtab[tid] = 1.0f / sqrtf(sv * (1.0f / D) + EPS); }
                __syncthreads();
                const int c = tid * 4, wsz = 2 << (c >> 9);
                const f32x4 g4 = *(const f32x4*)(gsv + c);
                f32x4 sum = {0.f, 0.f, 0.f, 0.f};
#pragma unroll 5
                for (int r = r0 - wsz + 1; r < r0; ++r) if (r >= 0) sum += XLD4(xc + XIDX(r, c)) * rtab[r - r0 + 15];
#pragma unroll 1
                for (int rb = r0; rb < r0 + 32; rb += 8) {
                    f32x4 cur8[8], old8[8];
#pragma unroll
                    for (int i = 0; i < 8; ++i) { const int r = rb + i, lo = r - wsz + 1;
                        cur8[i] = XLD4(xc + XIDX(r, c));
                        old8[i] = lo >= 0 ? XLD4(xc + XIDX(lo, c)) : (f32x4){0.f, 0.f, 0.f, 0.f}; }
#pragma unroll
                    for (int i = 0; i < 8; ++i) { const int r = rb + i, lo = r - wsz + 1;
                        const f32x4 cur = cur8[i] * rtab[r - r0 + 15];
                        sum += cur;
                        const float icnt = 1.0f / (float)(lo < 0 ? r + 1 : wsz);
                        const f32x4 pv = g4 * (sum * icnt - cur);
                        u32x2 o; o.x = pg8::cvt_pk_bf16(pv[0], pv[1]); o.y = pg8::cvt_pk_bf16(pv[2], pv[3]); *(u32x2*)(W_ao + (size_t)r * D + c) = o;
                        if (lo >= 0) sum -= old8[i] * rtab[lo - r0 + 15]; }
                }
            }
#undef XLD4
            rA = W_ao; rB = W_pw; rK = 512; rlda = D; rgrp = 1;
        }
        const bool mobasub = (s == 1 && kind == 0);
        const bool hasq = (sub == 1) || (sub == 10);
        const bool roleA = !hasq || (vcu & 1) == 0;
#pragma unroll 1
        for (int st = 0; st < 2; ++st) {
        if (mobasub && ((st == 0) == roleA)) {
            FRESH_TID();
            char* ldsg = (char*)lds_raw + RING_OFF;
            char* ctl = (char*)lds_raw + LDSCTL_OFF;
            int* rowtab = (int*)(ctl + 8192);
            int* cq = (int*)(ctl + 10240);
            LAS int* bc = (LAS int*)(lds + LDSCTL_OFF + 10368);
            LAS int* nrow_t = (LAS int*)(lds + LDSCTL_OFF + 10496);
            LAS int* ist_t = (LAS int*)(lds + LDSCTL_OFF + 12544);
            float* wscr = (float*)(ctl + 14848);
            __syncthreads();
            {
                const int hn = ftid, n = hn & 31; int tot = 0; const int* cp = W_cnt + hn * 32;
#pragma unroll
                for (int qx = 0; qx < 32; ++qx) { const int c = cp[qx]; tot += (qx > n) ? c : 0; }
                nrow_t[hn] = tot; const int nch = (256 + tot + 511) >> 9;
                int sc = nch;
#pragma unroll
                for (int o = 1; o < 64; o <<= 1) { const int v = __shfl_up(sc, o); if (flane >= o) sc += v; }
                if (flane == 63) bc[wave] = sc;
                __syncthreads();
                int woff = 0;
#pragma unroll
                for (int w = 0; w < NWAVES; ++w) woff += (w < wave) ? bc[w] : 0;
                ist_t[hn] = woff + sc - nch;
                if (ftid == NWAVES * 64 - 1) ist_t[512] = woff + sc;
            }
            unsigned* actr = W_ctl + 8192 + 512 + j * 32;
            if (ftid == 0) bc[8] = (int)__hip_atomic_fetch_add(actr, 1u, __ATOMIC_RELAXED, __HIP_MEMORY_SCOPE_AGENT);
            __syncthreads();
            const int NU = __builtin_amdgcn_readfirstlane(ist_t[512]);
#pragma unroll 1
            for (;;) {
                const int unit = __builtin_amdgcn_readfirstlane(bc[8]);
                if (unit >= NU) break;
                int lo = 0, hi = 512;
#pragma unroll 1
                while (hi - lo > 1) { const int mid = (lo + hi) >> 1; if (ist_t[mid] <= unit) lo = mid; else hi = mid; }
                const int hn = __builtin_amdgcn_readfirstlane(lo), c = unit - __builtin_amdgcn_readfirstlane(ist_t[hn]);
                const int h_ = hn >> 5, n_ = hn & 31;
                int pend = NU; if (ftid == 0) pend = (int)__hip_atomic_fetch_add(actr, 1u, __ATOMIC_RELAXED, __HIP_MEMORY_SCOPE_AGENT);
                mb::UnitRef u;
                u.Q = W_qb + (size_t)h_ * T * 128; u.K = W_kb + (size_t)h_ * T * 128; u.V = W_vb + (size_t)h_ * T * 128;
                u.O = W_part + (size_t)unit * 512 * 128; u.ML = W_ml + (size_t)unit * 1024; u.LOC = W_loc + (size_t)h_ * T * 4;
                u.seg = W_seg + (size_t)hn * 32 * 256; u.cnt = W_cnt + hn * 32;
                u.ab = exp2f(-(float)(h_ + 1) * 0.5f) * (1.0f / mb::SCALE); u.n = n_; u.c = c; u.L = __builtin_amdgcn_readfirstlane(nrow_t[hn]); u.unit512 = unit * 512;
                mb::moba_unit(u, ldsg, rowtab, cq, wscr, (int*)(ctl + 10368 + 32), pend, wave);
            }
        }
        if ((st == 0 && sitesub) || (mobasub && hasq && ((st == 0) != roleA))) {
                        constexpr int DQ_MO0 = 2048, DQ_FFN = 21 * 5632, DQ_MQ = 6144, DQ_MO = 2048, DQ_PW = 512, DQ_SQ = 2560, DQ_SO = 2048, DQ_N = DQ_MO0 + DQ_FFN + DQ_MQ + DQ_MO + DQ_PW + DQ_SQ + DQ_SO;
                        static_assert(DQ_N % 8 == 0, "whole chunks");
                        constexpr int DQ_WD0 = 5632, DQ_MQ0 = 6144, DQ_EARLY = DQ_WD0 + DQ_MQ0;
                        constexpr int DQ_LATE = 3 * 5632, DQ_LATE0 = DQ_MO0 + 18 * 5632;
                        static_assert(DQ_LATE % 8 == 0 && (DQ_N - DQ_LATE) % 8 == 0, "whole chunks");
                        constexpr int DQ_F0 = DQ_MO0, DQ_AFT = DQ_MO0 + DQ_FFN;
                        int s0, n0, s1 = 0, n1 = 0;
                        if (sub == 0) { s0 = DQ_N; n0 = DQ_EARLY; }
                        else if (sub == 1) { s0 = 0; n0 = DQ_F0 + 3 * 5632; s1 = DQ_AFT + DQ_MQ + DQ_MO; n1 = DQ_PW; }
                        else if (sub == 2) { s0 = DQ_F0 + 3 * 5632; n0 = 3 * 5632; }
                        else if (sub == 3) { s0 = DQ_F0 + 6 * 5632; n0 = 3 * 5632; }
                        else if (sub == 5) { s0 = DQ_F0 + 9 * 5632; n0 = 3 * 5632; }
                        else if (sub == 6) { s0 = DQ_F0 + 12 * 5632; n0 = 2 * 5632; s1 = DQ_AFT + DQ_MQ + DQ_MO + DQ_PW; n1 = DQ_SQ + DQ_SO; }
                        else if (sub == 8) { s0 = DQ_F0 + 14 * 5632; n0 = 3 * 5632; }
                        else if (sub == 9) { s0 = DQ_F0 + 17 * 5632; n0 = 5632; s1 = DQ_AFT; n1 = DQ_MQ + DQ_MO; }
                        else { s0 = DQ_LATE0; n0 = DQ_LATE; }
                        const int nchunks = (n0 + n1) / 8;
                        unsigned* qctr = W_ctl + 8192 + sub * 32;
                        FRESH_TID(); __syncthreads();
                        if (sub == 1) {
                            unsigned* mctr = W_ctl + 8192 + 12 * 32;
                            for (;;) {
                                int mi = 0; if (flane == 0) mi = (int)__hip_atomic_fetch_add(mctr, 1u, __ATOMIC_RELAXED, __HIP_MEMORY_SCOPE_AGENT);
                                mi = __builtin_amdgcn_readfirstlane(mi);
                                if (mi >= KSPLIT * 3 * 72) break;
                                const int ks_ = mi / 216, rem_ = mi % 216;
                                p0_mod_item(c_in, ada_w, W_modp, rem_ % 72, 1 + rem_ / 72, ks_, flane);
                            }
                        }
                        float* bpp = W_biasp;
                        constexpr int DQ_C = 8;
#define DQ_DESC(Dd, r_) do { int r = (r_); r = r < n0 ? s0 + r : s1 + (r - n0); Dd.sh = nullptr; Dd.bp = bpp; Dd.roff = 0; Dd.mode = 0;                           \
        if (r < DQ_MO0) { Dd.W = moba_o; Dd.WT = W_mo; Dd.N = D; Dd.KT = D / 64; Dd.kb = r / (D / 32); Dd.nb = r % (D / 32); } else { r -= DQ_MO0;                                         \
        if (r < DQ_FFN) { const int mi = r / 5632, ri = r % 5632, wi = 1 + mi / 3, typ = mi % 3; const int sb = (wi >> 1) * 3 + ((wi & 1) ? 2 : 0);                                         \
            if (typ == 2) { Dd.W = w_down + (size_t)wi * F * D; Dd.WT = W_wd + (size_t)wi * D * F; Dd.N = D; Dd.KT = F / 64; Dd.kb = ri / (D / 32); Dd.nb = ri % (D / 32); }                \
            else { Dd.W = (typ == 0 ? w_gate : w_up) + (size_t)wi * D * F; Dd.WT = W_wgu + (size_t)wi * F2 * D; Dd.N = F; Dd.KT = D / 64; Dd.kb = ri / (F / 32); Dd.nb = ri % (F / 32);     \
                   Dd.mode = 1 + typ; Dd.sh = W_shv + (size_t)sb * D; Dd.bp = bpp + (size_t)sb * F2; }                                                                                        \
        } else { r -= DQ_FFN; Dd.KT = D / 64;                                                                                                                                              \
          if (r < DQ_MQ) { Dd.W = moba_qkv + (size_t)D * 3 * D; Dd.WT = W_mqkv + (size_t)3 * D * D; Dd.N = 3 * D; Dd.kb = r / (3 * D / 32); Dd.nb = r % (3 * D / 32); Dd.sh = W_shv + (size_t)10 * D; Dd.bp = bpp + (size_t)10 * F2; } \
          else { r -= DQ_MQ;                                                                                                                                                               \
          if (r < DQ_MO) { Dd.W = moba_o + (size_t)D * D; Dd.WT = W_mo + (size_t)D * D; Dd.N = D; Dd.kb = r / (D / 32); Dd.nb = r % (D / 32); }                                            \
          else { r -= DQ_MO;                                                                                                                                                               \
          if (r < DQ_PW) { const int g = r / 128, ri = r % 128; Dd.W = pool_w + (size_t)g * 512 * 512; Dd.WT = W_pw; Dd.N = 512; Dd.KT = 512 / 64; Dd.roff = g * 512; Dd.kb = ri / 16; Dd.nb = ri % 16; } \
          else { r -= DQ_PW;                                                                                                                                                               \
          if (r < DQ_SQ) { Dd.W = swa_qkv; Dd.WT = W_sqkv; Dd.N = 2560; Dd.kb = r / 80; Dd.nb = r % 80; Dd.sh = W_shv + (size_t)7 * D; Dd.bp = bpp + (size_t)7 * F2; }                      \
          else { r -= DQ_SQ;                                                                                                                                                               \
          if (r < DQ_SO) { Dd.W = swa_o; Dd.WT = W_so; Dd.N = D; Dd.kb = r / (D / 32); Dd.nb = r % (D / 32); }                                                                             \
          else { r -= DQ_SO;                                                                                                                                                               \
          if (r < DQ_WD0) { Dd.W = w_down; Dd.WT = W_wd; Dd.N = D; Dd.KT = F / 64; Dd.kb = r / (D / 32); Dd.nb = r % (D / 32); }                                                           \
          else { r -= DQ_WD0; Dd.W = moba_qkv; Dd.WT = W_mqkv; Dd.N = 3 * D; Dd.kb = r / (3 * D / 32); Dd.nb = r % (3 * D / 32); Dd.sh = W_shv + (size_t)D; Dd.bp = bpp + (size_t)F2; } } } } } } } } } while (0)
                        unsigned zoff = 0u; asm volatile("" : "+v"(zoff));
                        int chunk_v = 0; if (flane == 0) chunk_v = (int)__hip_atomic_fetch_add(qctr + zoff, 1u, __ATOMIC_RELAXED, __HIP_MEMORY_SCOPE_AGENT);
                        int chunk_nx = __builtin_amdgcn_readfirstlane(chunk_v), chunk = 0, k8 = DQ_C; bool pend = false;
#define DQ_NEXT(have_, r_) do { if (k8 == DQ_C) { chunk = chunk_nx; k8 = 0;                                                                                                              \
            if (chunk < nchunks) { if (flane == 0) chunk_v = (int)__hip_atomic_fetch_add(qctr + zoff, 1u, __ATOMIC_RELAXED, __HIP_MEMORY_SCOPE_AGENT); pend = true; } }                    \
        have_ = chunk < nchunks; r_ = chunk * DQ_C + k8; ++k8; } while (0)
#define DQ_CAPTURE() do { if (pend) { chunk_nx = __builtin_amdgcn_readfirstlane(chunk_v); pend = false; } } while (0)
                        bool haveA, haveB; int rA, rB;
                        LAS unsigned char* cb0 = lds + RING_OFF + wave * 16384; LAS unsigned char* cb1 = cb0 + 8192;
                        LAS unsigned char* sb0 = lds + LDSCTL_OFF + 4096 + wave * 512; LAS unsigned char* sb1 = sb0 + 256;
#define DQ_ISSUE(r_, b_, s_) do { int rr_ = __builtin_amdgcn_readfirstlane(r_); asm volatile("" : "+s"(rr_)); CvtD d_; DQ_DESC(d_, rr_); cvt_issue(d_, flane, b_, s_); } while (0)
#define DQ_FIN(r_, b_, s_) do { int rr_ = __builtin_amdgcn_readfirstlane(r_); asm volatile("" : "+s"(rr_)); CvtD d_; DQ_DESC(d_, rr_); cvt_fin(d_, flane, b_, s_); } while (0)
#define DQ_STEP(have_, r_, b_, s_) do { if (have_) { DQ_ISSUE(r_, b_, s_); asm volatile("s_waitcnt vmcnt(8)" ::: "memory"); DQ_CAPTURE(); } else asm volatile("s_waitcnt vmcnt(0)" ::: "memory"); } while (0)
                        DQ_NEXT(haveA, rA);
                        if (haveA) DQ_ISSUE(rA, cb0, sb0);
                        while (haveA) {
                            DQ_NEXT(haveB, rB);
                            DQ_STEP(haveB, rB, cb1, sb1); DQ_FIN(rA, cb0, sb0);
                            if (!haveB) break;
                            DQ_NEXT(haveA, rA);
                            DQ_STEP(haveA, rA, cb0, sb0); DQ_FIN(rB, cb1, sb1);
                        }
#undef DQ_ISSUE
#undef DQ_FIN
#undef DQ_STEP
#undef DQ_CAPTURE
#undef DQ_DESC
#undef DQ_NEXT
        }
        }
        if (mobasub) {
            GRID_BAR();
            FRESH_TID();
            constexpr float C2 = 1.4426950408889634f * mb::SCALE;
            const int l16 = ftid & 15;
#pragma unroll 1
            for (int rb = vcu * 128 + (ftid >> 4); rb < 16 * T; rb += G * 128) {
                u32x4 lc[4];
#pragma unroll
                for (int k = 0; k < 4; ++k) lc[k] = *(const u32x4*)(W_loc + (size_t)(rb + 32 * k) * 4);
                float mm[4][4], ll[4][4]; bf16x8 pv[4][4];
#pragma unroll
                for (int k = 0; k < 4; ++k)
#pragma unroll
                    for (int sl = 0; sl < 4; ++sl) { const int li = (int)lc[k][sl]; const bool ok = li >= 0; const int lx = ok ? li : 0;
                        const float2 ml = *(const float2*)(W_ml + (size_t)lx * 2); mm[k][sl] = ok ? ml.x : -1e30f; ll[k][sl] = ok ? ml.y : 0.f;
                        const bf16x8 pl = *(const bf16x8*)(W_part + (size_t)lx * 128 + l16 * 8); pv[k][sl] = ok ? pl : (bf16x8){0, 0, 0, 0, 0, 0, 0, 0}; }
#pragma unroll
                for (int k = 0; k < 4; ++k) {
                    const int rix = rb + 32 * k, h_ = rix >> 13, t = rix & (T - 1);
                    const float M = fmaxf(fmaxf(mm[k][0], mm[k][1]), fmaxf(mm[k][2], mm[k][3]));
                    float w[4], den = 0.f;
#pragma unroll
                    for (int sl = 0; sl < 4; ++sl) { w[sl] = ll[k][sl] * __builtin_amdgcn_exp2f((mm[k][sl] - M) * C2); den += w[sl]; }
                    const float inv = 1.0f / den;
                    float o[8];
#pragma unroll
                    for (int e = 0; e < 8; ++e) o[e] = ((w[0] * bf2f((unsigned short)pv[k][0][e]) + w[1] * bf2f((unsigned short)pv[k][1][e])) + (w[2] * bf2f((unsigned short)pv[k][2][e]) + w[3] * bf2f((unsigned short)pv[k][3][e]))) * inv;
                    u32x4 ov; ov.x = pg8::cvt_pk_bf16(o[0], o[1]); ov.y = pg8::cvt_pk_bf16(o[2], o[3]); ov.z = pg8::cvt_pk_bf16(o[4], o[5]); ov.w = pg8::cvt_pk_bf16(o[6], o[7]);
                    *(u32x4*)(W_ao + (size_t)t * D + h_ * 128 + l16 * 8) = ov;
                }
            }
        }
        GRID_BAR();
        if (sub == 1) { FRESH_TID(); P0B_RANGE(ftid, 3, DEPTH * 3) }
        if (sub <= 3 || sub == 5 || sub == 6 || sub == 8 || sub == 9 || sub == 10) {
            FRESH_TID();
            int sb0, nsb;
            if (sub == 0) { sb0 = 1; nsb = 1; } else if (sub == 1) { sb0 = 2; nsb = 1; } else if (sub == 2) { sb0 = 3; nsb = 1; } else if (sub == 3) { sb0 = 5; nsb = 1; }
            else if (sub == 5) { sb0 = 6; nsb = 1; } else if (sub == 6) { sb0 = 7; nsb = 2; } else if (sub == 8) { sb0 = 9; nsb = 1; } else if (sub == 9) { sb0 = 10; nsb = 1; } else { sb0 = 11; nsb = 1; }
            for (int idx = vcu * (NWAVES * 64) + ftid; idx < nsb * F2; idx += G * (NWAVES * 64)) {
                const int sb = sb0 + idx / F2, n = idx % F2, s_ = sb % 3, kind_ = (sb / 3) % 3;
                const int nrows = s_ != 1 ? F2 : (kind_ == 0 ? 3 * D : (kind_ == 2 ? 2560 : 0));
                if (n < nrows) { float a = 0.f;
#pragma unroll 8
                    for (int kb = 0; kb < 32; ++kb) a += W_biasp[(size_t)kb * (DEPTH * 3 * F2) + (size_t)sb * F2 + n];
                    W_bias[(size_t)sb * F2 + n] = a; }
            }
        }
        {
            pg8::Gemm g{rA, rB, T, D, rK, rlda, rgrp, rtile, 1}; pg8::StaticOrder S; S.init(T, D, G, bx);
            pg8::EpiRes E{W_x, W_cres + (size_t)sub * D, W_ss};
            { FRESH_TID(); pg8::gemm_phase<pg8::EpiRes, pg8::StaticOrder, true>(lds + RING_OFF, g, S, E, ftid); }
        }
        GRID_BAR();
    }
    { WS_FRESH(); FRESH_TID(); const int lane = flane;
    for (int t = gw; t < T; t += NGW) {
        float sv = lane < 32 ? W_ss[(size_t)t * 32 + lane] : 0.f; sv = wave_sum(sv);
        const float rstd = 1.0f / sqrtf(sv * (1.0f / D) + EPS);
#pragma unroll
        for (int c = lane * 4; c < D; c += 256) { const u32x2 q_ = *(const u32x2*)(W_x + XIDX(t, c)); const f32x4 g = *(const f32x4*)(final_g + c);
            const f32x4 v = {__builtin_bit_cast(float, q_.x << 16), __builtin_bit_cast(float, q_.x & 0xFFFF0000u), __builtin_bit_cast(float, q_.y << 16), __builtin_bit_cast(float, q_.y & 0xFFFF0000u)};
            *(f32x4*)(args.out + (size_t)t * D + c) = v * rstd * g; }
    } }
#undef GRID_BAR
}

extern "C" void kernel_launch(void* const* d_in, const int* in_sizes, int n_in, void* d_out, int out_size, void* d_ws, size_t ws_size, hipStream_t stream) {
    static int grid = 0;
    Args a{};
    const size_t need = WS_NEED;
    if (grid == 0) {
        if (n_in != 16 || in_sizes[0] != T * D || out_size != T * D || ws_size < need) { fprintf(stderr, "kernel_launch: unexpected shapes / workspace (need %zu, have %zu)\n", need, ws_size); grid = -1; return; }
        int dev = 0, cus = 0, per_cu = 0;
        if (hipGetDevice(&dev) != hipSuccess || hipDeviceGetAttribute(&cus, hipDeviceAttributeMultiprocessorCount, dev) != hipSuccess) { grid = -1; return; }
        if (hipFuncSetAttribute((const void*)mk_fwd, hipFuncAttributeMaxDynamicSharedMemorySize, LDS_BYTES) != hipSuccess) { fprintf(stderr, "kernel_launch: hipFuncSetAttribute failed\n"); grid = -1; return; }
        if (hipOccupancyMaxActiveBlocksPerMultiprocessor(&per_cu, (const void*)mk_fwd, NWAVES * 64, LDS_BYTES) != hipSuccess || per_cu < 1) { fprintf(stderr, "kernel_launch: occupancy query reports %d\n", per_cu); }
        (void)hipGetLastError();
        grid = cus;
    }
    if (grid < 0) return;
    (void)hipMemsetAsync((unsigned char*)d_ws + O_ctl, 0, CTL_BYTES, stream);
    for (int i = 0; i < 16; ++i) a.in[i] = (const float*)d_in[i];
    a.out = (float*)d_out; a.ws = (unsigned char*)d_ws;
    hipLaunchKernelGGL(mk_fwd, dim3(grid), dim3(NWAVES * 64), LDS_BYTES, stream, a);
}
```
